# Optimizing an MI355X kernel written in HIP

```python
import jax, jax.numpy as jnp
from jax import lax
import numpy as np

D_MODEL = 1024
BATCH = 32
SEQ = 2048
DEPTH = 2
DEC_BATCH = 16
DEC_SEQ = 64
PAST_LEN = 2048

CHUNK = 64
N_MIXERS = 2
N_POOL_LAYERS = (DEPTH + 1) // 2
N_ATTN_LAYERS = DEPTH // 2
POOL_WINDOWS = (2, 4, 8, 16)
N_POOL_GROUPS = 4
POOL_GROUP = D_MODEL // N_POOL_GROUPS
POOL_STATE = max(POOL_WINDOWS) - 1
N_HEADS = 16
HEAD_DIM = D_MODEL // N_HEADS
N_KV_HEADS = 4
KV_GROUP = N_HEADS // N_KV_HEADS
N_IDX_HEADS = 8
IDX_DIM = 64
TOPK_MAX = 256
Q_BLOCK = 128
ROPE_THETA = 10000.0
D_FF = 4 * D_MODEL
EPS = 1e-6
NEG = -1e30
Q_W = N_HEADS * HEAD_DIM
KV_W = N_KV_HEADS * HEAD_DIM
QI_W = N_IDX_HEADS * IDX_DIM
PROJ_W = Q_W + 2 * KV_W + QI_W + IDX_DIM + N_IDX_HEADS

kernel_name = "pool_dsa_hybrid_stream_step"


def _rmsnorm(x, g):
    xf = x.astype(jnp.float32)
    xf = xf * lax.rsqrt(jnp.mean(xf * xf, axis=-1, keepdims=True) + EPS)
    return (xf * g.astype(jnp.float32)).astype(x.dtype)


def _rope(x, pos):
    d = x.shape[-1]
    inv_freq = 1.0 / (ROPE_THETA ** (jnp.arange(0, d, 2, dtype=jnp.float32) / d))
    ang = pos.astype(jnp.float32)[:, None] * inv_freq[None, :]
    c = jnp.cos(ang)[None, :, None, :]
    s = jnp.sin(ang)[None, :, None, :]
    xf = x.astype(jnp.float32)
    x1, x2 = xf[..., : d // 2], xf[..., d // 2:]
    return jnp.concatenate([x1 * c - x2 * s, x2 * c + x1 * s], axis=-1).astype(x.dtype)


def _pool_mixer(h, pos, past, w, scale):
    B, T, D = h.shape
    if past is None:
        past = jnp.zeros((B, POOL_STATE, D), h.dtype)
    padded = jnp.concatenate([past.astype(h.dtype), h], axis=1)
    cs = jnp.cumsum(padded.astype(jnp.float32), axis=1)
    cs0 = jnp.concatenate([jnp.zeros((B, 1, D), jnp.float32), cs], axis=1)
    P = POOL_STATE
    hf = h.astype(jnp.float32)
    outs = []
    for g, win in enumerate(POOL_WINDOWS):
        sl = slice(g * POOL_GROUP, (g + 1) * POOL_GROUP)
        wsum = cs0[:, P + 1: P + 1 + T, sl] - cs0[:, P + 1 - win: P + 1 - win + T, sl]
        cnt = jnp.minimum(pos + 1, win).astype(jnp.float32)[None, :, None]
        diff = (wsum / cnt - hf[..., sl]).astype(h.dtype)
        outs.append(diff @ w[g])
    y = jnp.concatenate(outs, axis=-1) * scale
    return y, padded[:, -POOL_STATE:]


def _dsa_attend(q, qi, wi, qpos, k, v, kidx, kpos, n_sel):
    B, T = q.shape[0], q.shape[1]
    logits = jnp.einsum('bthd,bsd->bths', qi.astype(jnp.float32), kidx.astype(jnp.float32)) * (IDX_DIM ** -0.5)
    score = jnp.einsum('bths,bth->bts', jax.nn.relu(logits), wi.astype(jnp.float32))
    qchunk = qpos // CHUNK
    adm = (kpos[None, :] // CHUNK) <= qchunk[:, None]
    score = jnp.where(adm[None], score, NEG)
    _, idx = lax.top_k(score, n_sel)
    valid = (kpos[idx] // CHUNK) <= qchunk[None, :, None]
    gather = jax.vmap(lambda a, i: a[i])
    kg = gather(k, idx)
    vg = gather(v, idx)
    qg = q.reshape(B, T, N_KV_HEADS, KV_GROUP, HEAD_DIM)
    s = jnp.einsum('btgrd,btkgd->btgrk', qg, kg).astype(jnp.float32) * (HEAD_DIM ** -0.5)
    s = jnp.where(valid[:, :, None, None, :], s, NEG)
    p = jax.nn.softmax(s, axis=-1).astype(v.dtype)
    o = jnp.einsum('btgrk,btkgd->btgrd', p, vg)
    return o.reshape(B, T, N_HEADS * HEAD_DIM)


def _attn_mixer(h, pos, past, w_in, w_o):
    B, T, _ = h.shape
    p = h @ w_in
    o0 = 0
    q = p[..., o0:o0 + Q_W].reshape(B, T, N_HEADS, HEAD_DIM); o0 += Q_W
    k = p[..., o0:o0 + KV_W].reshape(B, T, N_KV_HEADS, HEAD_DIM); o0 += KV_W
    v = p[..., o0:o0 + KV_W].reshape(B, T, N_KV_HEADS, HEAD_DIM); o0 += KV_W
    qi = p[..., o0:o0 + QI_W].reshape(B, T, N_IDX_HEADS, IDX_DIM); o0 += QI_W
    ki = p[..., o0:o0 + IDX_DIM].reshape(B, T, 1, IDX_DIM); o0 += IDX_DIM
    wi = p[..., o0:o0 + N_IDX_HEADS] * (N_IDX_HEADS ** -0.5)
    q = _rope(q, pos)
    k = _rope(k, pos)
    qi = _rope(qi, pos)
    ki = _rope(ki, pos)[:, :, 0]
    if past is None:
        k_all, v_all, ki_all = k, v, ki
    else:
        kc, vc, kic = past
        k_all = jnp.concatenate([kc, k.astype(kc.dtype)], axis=1)
        v_all = jnp.concatenate([vc, v.astype(vc.dtype)], axis=1)
        ki_all = jnp.concatenate([kic, ki.astype(kic.dtype)], axis=1)
    L = k_all.shape[1]
    kpos = jnp.arange(L, dtype=jnp.int32)
    n_sel = min(TOPK_MAX, L // 4)
    if T % Q_BLOCK == 0:
        nb = T // Q_BLOCK
        to_blocks = lambda a: jnp.moveaxis(a.reshape(B, nb, Q_BLOCK, *a.shape[2:]), 1, 0)
        xs = (to_blocks(q), to_blocks(qi), to_blocks(wi), pos.reshape(nb, Q_BLOCK))
        ob = lax.map(lambda a: _dsa_attend(a[0], a[1], a[2], a[3], k_all, v_all, ki_all, kpos, n_sel), xs)
        o = jnp.moveaxis(ob, 0, 1).reshape(B, T, N_HEADS * HEAD_DIM)
    else:
        o = _dsa_attend(q, qi, wi, pos, k_all, v_all, ki_all, kpos, n_sel)
    return o @ w_o, (k, v, ki)


def _mlp(h, w_up, w_down):
    u = jax.nn.relu(h @ w_up)
    return (u * u) @ w_down


def _trunk(x, pos, pool_past, attn_past, norm_mix, norm_mlp, norm_final, pool_w, pool_scale,
           attn_w_in, attn_w_o, mlp_w_up, mlp_w_down):
    pool_new, k_new, v_new, ki_new = [], [], [], []
    for i in range(DEPTH):
        h = _rmsnorm(x, norm_mix[i])
        j = i // N_MIXERS
        if i % N_MIXERS == 0:
            past = None if pool_past is None else pool_past[j]
            y, st = _pool_mixer(h, pos, past, pool_w[j], pool_scale[j])
            pool_new.append(st)
        else:
            past = None if attn_past is None else (attn_past[0][j], attn_past[1][j], attn_past[2][j])
            y, (kn, vn, kin) = _attn_mixer(h, pos, past, attn_w_in[j], attn_w_o[j])
            k_new.append(kn); v_new.append(vn); ki_new.append(kin)
        x = x + y.astype(x.dtype)
        x = x + _mlp(_rmsnorm(x, norm_mlp[i]), mlp_w_up[i], mlp_w_down[i]).astype(x.dtype)
    return (_rmsnorm(x, norm_final), jnp.stack(pool_new), jnp.stack(k_new), jnp.stack(v_new), jnp.stack(ki_new))


def setup_inputs(seed: int = 0) -> dict:
    key = jax.random.key(seed)
    ks = jax.random.split(key, 16)
    f32 = jnp.float32
    nrm = lambda k, shape, s: jax.random.normal(k, shape, f32) * s
    return {
        "x_prompt": nrm(ks[0], (BATCH, SEQ, D_MODEL), 1.0),
        "x_sample": nrm(ks[1], (DEC_BATCH, DEC_SEQ, D_MODEL), 1.0),
        "state_pool": nrm(ks[2], (N_POOL_LAYERS, DEC_BATCH, POOL_STATE, D_MODEL), 1.0),
        "cache_k": nrm(ks[3], (N_ATTN_LAYERS, DEC_BATCH, PAST_LEN, N_KV_HEADS, HEAD_DIM), 1.0),
        "cache_v": nrm(ks[4], (N_ATTN_LAYERS, DEC_BATCH, PAST_LEN, N_KV_HEADS, HEAD_DIM), 1.0),
        "cache_kidx": nrm(ks[5], (N_ATTN_LAYERS, DEC_BATCH, PAST_LEN, IDX_DIM), 1.0),
        "norm_mix": 1.0 + nrm(ks[6], (DEPTH, D_MODEL), 0.02),
        "norm_mlp": 1.0 + nrm(ks[7], (DEPTH, D_MODEL), 0.02),
        "norm_final": 1.0 + nrm(ks[8], (D_MODEL,), 0.02),
        "pool_w": nrm(ks[9], (N_POOL_LAYERS, N_POOL_GROUPS, POOL_GROUP, POOL_GROUP), POOL_GROUP ** -0.5),
        "pool_scale": 1.0 + nrm(ks[10], (N_POOL_LAYERS, D_MODEL), 0.02),
        "attn_w_in": nrm(ks[11], (N_ATTN_LAYERS, D_MODEL, PROJ_W), D_MODEL ** -0.5),
        "attn_w_o": nrm(ks[12], (N_ATTN_LAYERS, Q_W, D_MODEL), Q_W ** -0.5),
        "mlp_w_up": nrm(ks[13], (DEPTH, D_MODEL, D_FF), D_MODEL ** -0.5),
        "mlp_w_down": nrm(ks[14], (DEPTH, D_FF, D_MODEL), D_FF ** -0.5),
    }


def reference(x_prompt, x_sample, state_pool, cache_k, cache_v, cache_kidx, norm_mix, norm_mlp, norm_final,
              pool_w, pool_scale, attn_w_in, attn_w_o, mlp_w_up, mlp_w_down):
    T_p = x_prompt.shape[1]
    T_s = x_sample.shape[1]
    past_len = cache_k.shape[2]
    pos_p = jnp.arange(T_p, dtype=jnp.int32)
    pos_s = past_len + jnp.arange(T_s, dtype=jnp.int32)
    y_prompt, pool_p, k_p, v_p, ki_p = _trunk(
        x_prompt, pos_p, None, None, norm_mix, norm_mlp, norm_final, pool_w, pool_scale,
        attn_w_in, attn_w_o, mlp_w_up, mlp_w_down)
    y_sample, pool_s, k_s, v_s, ki_s = _trunk(
        x_sample, pos_s, state_pool, (cache_k, cache_v, cache_kidx), norm_mix, norm_mlp, norm_final,
        pool_w, pool_scale, attn_w_in, attn_w_o, mlp_w_up, mlp_w_down)
    return (y_prompt, y_sample, pool_p, pool_s, k_p, v_p, ki_p, k_s, v_s, ki_s)
```

```cpp
#include <hip/hip_runtime.h>
#include <hip/hip_cooperative_groups.h>
#include <cstdio>
#include <cstdint>
namespace cg = cooperative_groups;

#define LAS __attribute__((address_space(3)))
#define DI __device__ __forceinline__
typedef unsigned short bf16_t;
typedef short bf16x8 __attribute__((ext_vector_type(8)));
typedef float f32x2 __attribute__((ext_vector_type(2)));
typedef float f32x4 __attribute__((ext_vector_type(4)));
typedef float f32x16 __attribute__((ext_vector_type(16)));
typedef unsigned u32x2 __attribute__((ext_vector_type(2)));
typedef unsigned u32x4 __attribute__((ext_vector_type(4)));
typedef __bf16 bfv2 __attribute__((ext_vector_type(2)));

constexpr int D = 1024, NP = 65536, NS = 1024, NR = NP + NS, TP = 2048, TS = 64, LS = 2112, DFF = 4096;
constexpr int NWIN = 2304;
constexpr int MASKW = 68;
constexpr float EPS = 1e-6f;
constexpr size_t O_Y = 0, O_POOLP = 68157440, O_POOLS = 68648960, O_KP = 68894720, O_VP = 85671936, O_KIP = 102449152,
                 O_KS = 106643456, O_VS = 106905600, O_KIS = 107167744;
constexpr size_t WS_WPOOL = 0;
constexpr size_t WS_WIN = WS_WPOOL + 524288;
constexpr size_t WS_WO = WS_WIN + (size_t)NWIN * 1024 * 2;
constexpr size_t WS_WUP0 = WS_WO + 2097152;
constexpr size_t WS_WUP1 = WS_WUP0 + 8388608;
constexpr size_t WS_WDN0 = WS_WUP1 + 8388608;
constexpr size_t WS_WDN1 = WS_WDN0 + 8388608;
constexpr size_t WS_ROPE = WS_WDN1 + 8388608;
constexpr size_t WS_SS0 = WS_ROPE + 540672;
constexpr size_t WS_SS1 = WS_SS0 + (size_t)NR * 64;
constexpr size_t WS_KS = WS_SS1 + (size_t)NR * 64;
constexpr size_t WS_VTS = WS_KS + (size_t)16 * 4 * LS * 64 * 2;
constexpr size_t WS_KIS = WS_VTS + (size_t)16 * 4 * LS * 64 * 2;
constexpr size_t WS_HA = WS_KIS + (size_t)16 * LS * 64 * 2;
constexpr size_t WS_HB = WS_HA + (size_t)NR * 1024 * 2;
constexpr size_t WS_U = WS_HB + (size_t)NR * 1024 * 2;
constexpr size_t WS_BAR = WS_U + (size_t)NR * 4096 * 2;
constexpr size_t WS_END = WS_BAR + 16384;
constexpr size_t WS_Q = WS_U;
constexpr size_t WS_QI = WS_Q + (size_t)NR * 1024 * 2;
constexpr size_t WS_KP = WS_QI + (size_t)NR * 512 * 2;
constexpr size_t WS_VTP = WS_KP + (size_t)32 * 4 * 2048 * 64 * 2;
constexpr size_t WS_KIP = WS_VTP + (size_t)32 * 4 * 2048 * 64 * 2;
constexpr size_t WS_WI = WS_KIP + (size_t)32 * 2048 * 64 * 2;
constexpr size_t WS_MASK = WS_WI + (size_t)NR * 8 * 4;
constexpr size_t WS_ALIAS_END = WS_MASK + (size_t)NR * MASKW * 4;
static_assert(WS_ALIAS_END <= WS_BAR, "alias overflow");

constexpr int LDS_PHASE = 141312;
constexpr int LDS_BYTES = LDS_PHASE + 16;

struct Args {
    const float* in[15];
    float* out;
    unsigned char* ws;
    int ph_lo, ph_hi;
};

DI unsigned pk2(float lo, float hi) { f32x2 v = {lo, hi}; bfv2 b = __builtin_convertvector(v, bfv2); return __builtin_bit_cast(unsigned, b); }
DI float bf2f(bf16_t b) { return __uint_as_float(((unsigned)b) << 16); }
DI float xhalf_max(float x) {
    auto r = __builtin_amdgcn_permlane32_swap(__float_as_uint(x), __float_as_uint(x), false, false);
    return fmaxf(__uint_as_float(r[0]), __uint_as_float(r[1]));
}
DI float xhalf_sum(float x) {
    auto r = __builtin_amdgcn_permlane32_swap(__float_as_uint(x), __float_as_uint(x), false, false);
    return __uint_as_float(r[0]) + __uint_as_float(r[1]);
}

namespace pg8 {
constexpr int BM = 256, BK = 64, HALF = 128, HTB = HALF * BK * 2, STAGE_BYTES = 8 * HTB, NXCD = 8, WGM = 8;
DI int lds_byte(int r, int c) { const int st = (r >> 4) * 2 + (c >> 5), rr = r & 15, cc = c & 31, ob = rr * 64 + cc * 2; return st * 1024 + (ob ^ (((ob >> 9) & 1) << 5)); }
DI void stage_rc(int b, int& R, int& C) { const int st = b / 1024, sb = b % 1024, swz = sb ^ (((sb >> 9) & 1) << 5); R = (st >> 1) * 16 + swz / 64; C = (st & 1) * 32 + (swz % 64) / 2; }
DI int perm32(int rho) { const int n = rho >> 4, i = rho & 15; return 8 * (i >> 2) + 4 * n + (i & 3); }
struct Unit { int pm, pn; };
struct Gemm { const bf16_t* A; const bf16_t* Bt; int M, N, K, lda, ldb, a_pn_bytes; };
struct StaticOrder {
    int nM, nN, nwg, G, c;
    DI void init(int M, int N, int G_, int c_) { nM = M / BM; nN = N / BM; nwg = nM * nN; G = G_; c = c_; }
    DI bool next(int i, Unit& u) const {
        const long L = (long)i * G + c; if (L >= nwg) return false;
        int wgid = (int)L; { const int q = nwg / NXCD, r = nwg % NXCD, xcd = wgid % NXCD, off = wgid / NXCD; wgid = (xcd < r ? xcd * (q + 1) : r * (q + 1) + (xcd - r) * q) + off; }
        const int nig = WGM * nN, gid = wgid / nig, fm = gid * WGM, gsz = (nM - fm) < WGM ? (nM - fm) : WGM;
        u.pm = fm + ((wgid % nig) % gsz); u.pn = (wgid % nig) / gsz; return true;
    }
};

template <class Epi>
DI void gemm_phase(LAS unsigned char* lds, const Gemm g, const StaticOrder& S, const Epi& E) {
    const int tid = threadIdx.x, wid = __builtin_amdgcn_readfirstlane(tid >> 6), lane = tid & 63, wr = wid >> 2, wc = wid & 3, fr = lane & 15, fq = lane >> 4;
    const int K = g.K, nt = K / BK;
    unsigned voffA[2], voffB[2];
#pragma unroll
    for (int i = 0; i < 2; ++i) { int R, C; stage_rc(tid * 16 + i * 8192, R, C); const int Rb = (R & ~31) + perm32(R & 31);
        voffA[i] = (unsigned)(R * g.lda + C) * 2u; voffB[i] = (unsigned)(Rb * g.ldb + C) * 2u; }
    const size_t kstep = (size_t)(BK * 2);
    const size_t hstepA = (size_t)HALF * g.lda * 2, hstepB = (size_t)HALF * g.ldb * 2;
    const size_t tstepA = 2 * hstepA, tstepB = 2 * hstepB;
    const unsigned ldsw = (unsigned)wid * 1024u;
    const int aoff = lds_byte(wr * 64 + fr, fq * 8), boff = lds_byte(wc * 32 + fr, fq * 8);
#define PG8_SA(b, h) (((b) * 2 + (h)) * HTB)
#define PG8_SB(b, h) ((4 + (b) * 2 + (h)) * HTB)
#define PG8_STAGE(bufoff, gbase, voff) do { _Pragma("unroll") for (int _i = 0; _i < 2; ++_i) \
        __builtin_amdgcn_global_load_lds((const unsigned*)((const char*)(gbase) + (voff)[_i]), (LAS unsigned*)(lds + (bufoff) + ldsw + _i * 8192), 16, 0, 0); } while (0)
#define PG8_LDA(dst, b, h) do { _Pragma("unroll") for (int m = 0; m < 4; ++m) _Pragma("unroll") for (int k = 0; k < 2; ++k) dst[m][k] = *(const LAS bf16x8*)(lds + PG8_SA(b, h) + aoff + m * 2048 + k * 1024); } while (0)
#define PG8_LDB(dst, b, h) do { _Pragma("unroll") for (int n = 0; n < 2; ++n) _Pragma("unroll") for (int k = 0; k < 2; ++k) dst[n][k] = *(const LAS bf16x8*)(lds + PG8_SB(b, h) + boff + n * 2048 + k * 1024); } while (0)
#define PG8_MMA(ai, bj, At, Bt) do { __builtin_amdgcn_s_setprio(1); _Pragma("unroll") for (int m = 0; m < 4; ++m) _Pragma("unroll") for (int n = 0; n < 2; ++n) _Pragma("unroll") for (int k = 0; k < 2; ++k) \
        acc[ai][bj][m][n] = __builtin_amdgcn_mfma_f32_16x16x32_bf16(Bt[n][k], At[m][k], acc[ai][bj][m][n], 0, 0, 0); __builtin_amdgcn_s_setprio(0); } while (0)
#define PG8_WAIT_V(n) asm volatile("s_waitcnt vmcnt(" #n ")" ::: "memory")
#define PG8_WAIT_L(n) asm volatile("s_waitcnt lgkmcnt(" #n ")" ::: "memory")
#define PG8_BAR __builtin_amdgcn_s_barrier()
#define PG8_SCHED __builtin_amdgcn_sched_barrier(0)
    Unit cur, nxt; int ui = 0;
    if (!S.next(0, cur)) return;
    f32x4 acc[2][2][4][2];
#pragma unroll
    for (int a = 0; a < 2; ++a)
#pragma unroll
        for (int b = 0; b < 2; ++b)
#pragma unroll
            for (int m = 0; m < 4; ++m)
#pragma unroll
                for (int n = 0; n < 2; ++n) acc[a][b][m][n] = (f32x4){0.f, 0.f, 0.f, 0.f};
    bf16x8 At[4][2], B0[2][2], B1[2][2];
    const char* cA = (const char*)g.A + (size_t)cur.pm * tstepA + (size_t)cur.pn * g.a_pn_bytes; const char* cB = (const char*)g.Bt + (size_t)cur.pn * tstepB;
    PG8_STAGE(PG8_SB(0, 0), cB, voffB); PG8_STAGE(PG8_SA(0, 0), cA, voffA); PG8_STAGE(PG8_SB(0, 1), cB + hstepB, voffB); PG8_STAGE(PG8_SA(0, 1), cA + hstepA, voffA);
    if (wr == 1) PG8_BAR;
    PG8_WAIT_V(4); PG8_BAR;
    PG8_STAGE(PG8_SB(1, 0), cB + kstep, voffB); PG8_STAGE(PG8_SA(1, 0), cA + kstep, voffA); PG8_STAGE(PG8_SB(1, 1), cB + hstepB + kstep, voffB);
    PG8_WAIT_V(6); PG8_BAR;
    for (;;) {
        const bool has_next = S.next(ui + 1, nxt);
        const char* nA = has_next ? (const char*)g.A + (size_t)nxt.pm * tstepA + (size_t)nxt.pn * g.a_pn_bytes : cA; const char* nB = has_next ? (const char*)g.Bt + (size_t)nxt.pn * tstepB : cB;
#pragma unroll 1
        for (int t = 0; t < nt; t += 2) {
            const bool last = (t == nt - 2);
            const char* a1 = cA + (size_t)(t + 1) * kstep;
            const char* a2 = last ? nA : cA + (size_t)(t + 2) * kstep; const char* b2 = last ? nB : cB + (size_t)(t + 2) * kstep;
            const char* a3 = a2 + kstep; const char* b3 = b2 + kstep;
            PG8_LDB(B0, 0, 0); PG8_SCHED; PG8_LDA(At, 0, 0); PG8_STAGE(PG8_SA(1, 1), a1 + hstepA, voffA);
            PG8_WAIT_L(8); PG8_BAR; PG8_WAIT_L(0); PG8_MMA(0, 0, At, B0); PG8_BAR; PG8_SCHED;
            PG8_LDB(B1, 0, 1); PG8_STAGE(PG8_SB(0, 0), b2, voffB);
            PG8_BAR; PG8_WAIT_L(0); PG8_MMA(0, 1, At, B1); PG8_BAR;
            PG8_LDA(At, 0, 1); PG8_STAGE(PG8_SA(0, 0), a2, voffA);
            PG8_BAR; PG8_WAIT_L(0); PG8_MMA(1, 0, At, B0); PG8_BAR; PG8_SCHED;
            PG8_STAGE(PG8_SB(0, 1), b2 + hstepB, voffB);
            PG8_WAIT_V(6); PG8_BAR; PG8_MMA(1, 1, At, B1); PG8_BAR;
            PG8_LDB(B0, 1, 0); PG8_SCHED; PG8_LDA(At, 1, 0); PG8_STAGE(PG8_SA(0, 1), a2 + hstepA, voffA);
            PG8_WAIT_L(8); PG8_BAR; PG8_WAIT_L(0); PG8_MMA(0, 0, At, B0); PG8_BAR; PG8_SCHED;
            PG8_LDB(B1, 1, 1); PG8_STAGE(PG8_SB(1, 0), b3, voffB);
            PG8_BAR; PG8_WAIT_L(0); PG8_MMA(0, 1, At, B1); PG8_BAR;
            PG8_LDA(At, 1, 1); PG8_STAGE(PG8_SA(1, 0), a3, voffA);
            PG8_BAR; PG8_WAIT_L(0); PG8_MMA(1, 0, At, B0); PG8_BAR; PG8_SCHED;
            PG8_STAGE(PG8_SB(1, 1), b3 + hstepB, voffB);
            PG8_WAIT_V(6); PG8_BAR; PG8_MMA(1, 1, At, B1); PG8_BAR;
        }
        E(acc, cur, wr, wc, fr, fq);
        if (!has_next) break;
#pragma unroll
        for (int a = 0; a < 2; ++a)
#pragma unroll
            for (int b = 0; b < 2; ++b)
#pragma unroll
                for (int m = 0; m < 4; ++m)
#pragma unroll
                    for (int n = 0; n < 2; ++n) acc[a][b][m][n] = (f32x4){0.f, 0.f, 0.f, 0.f};
        cur = nxt; cA = nA; cB = nB; ++ui;
    }
    PG8_WAIT_V(0);
    if (wr == 0) PG8_BAR;
    PG8_BAR;
#undef PG8_SA
#undef PG8_SB
#undef PG8_STAGE
#undef PG8_LDA
#undef PG8_LDB
#undef PG8_MMA
#undef PG8_WAIT_V
#undef PG8_WAIT_L
#undef PG8_BAR
#undef PG8_SCHED
}
}
using pg8::Unit;

DI float row_rstd(const float* ss, int row) {
    const f32x4* p = (const f32x4*)(ss + (size_t)row * 16);
    f32x4 a = p[0], b = p[1], c = p[2], d = p[3];
    const float s = ((a.x + a.y) + (a.z + a.w)) + ((b.x + b.y) + (b.z + b.w)) + ((c.x + c.y) + (c.z + c.w)) + ((d.x + d.y) + (d.z + d.w));
    return __builtin_amdgcn_rsqf(s * (1.0f / 1024.0f) + EPS);
}

template <bool HAS_SCALE, bool IN_F32>
struct EpiRes {
    const float* xin_p; const float* xin_s; bf16_t* X; const float* colscale; float* ss;
    DI void operator()(const f32x4 (&acc)[2][2][4][2], const Unit& u, int wr, int wc, int fr, int fq) const {
        const int col0 = u.pn * 256 + wc * 32 + 8 * fq;
        float sq[2][4];
#pragma unroll
        for (int ai = 0; ai < 2; ++ai)
#pragma unroll
            for (int m = 0; m < 4; ++m) sq[ai][m] = 0.f;
#pragma unroll
        for (int bj = 0; bj < 2; ++bj) {
            const int col = col0 + bj * 128;
            f32x4 sc0, sc1;
            if (HAS_SCALE) { sc0 = *(const f32x4*)(colscale + col); sc1 = *(const f32x4*)(colscale + col + 4); }
#pragma unroll
            for (int ai = 0; ai < 2; ++ai)
#pragma unroll
                for (int m = 0; m < 4; ++m) {
                    const int row = u.pm * 256 + ai * 128 + wr * 64 + m * 16 + fr;
                    bf16_t* xb = X + (size_t)row * D + col;
                    f32x4 x0, x1;
                    if (IN_F32) {
                        const float* xr = (row < NP) ? xin_p + (size_t)row * D : xin_s + (size_t)(row - NP) * D;
                        x0 = *(const f32x4*)(xr + col); x1 = *(const f32x4*)(xr + col + 4);
                    } else {
                        const u32x4 h = *(const u32x4*)xb;
                        x0 = (f32x4){__uint_as_float(h.x << 16), __uint_as_float(h.x & 0xffff0000u), __uint_as_float(h.y << 16), __uint_as_float(h.y & 0xffff0000u)};
                        x1 = (f32x4){__uint_as_float(h.z << 16), __uint_as_float(h.z & 0xffff0000u), __uint_as_float(h.w << 16), __uint_as_float(h.w & 0xffff0000u)};
                    }
                    f32x4 y0 = acc[ai][bj][m][0], y1 = acc[ai][bj][m][1];
                    if (HAS_SCALE) { y0 = y0 * sc0; y1 = y1 * sc1; }
                    x0 = x0 + y0; x1 = x1 + y1;
                    sq[ai][m] += (x0.x * x0.x + x0.y * x0.y) + (x0.z * x0.z + x0.w * x0.w) + (x1.x * x1.x + x1.y * x1.y) + (x1.z * x1.z + x1.w * x1.w);
                    u32x4 o; o.x = pk2(x0.x, x0.y); o.y = pk2(x0.z, x0.w); o.z = pk2(x1.x, x1.y); o.w = pk2(x1.z, x1.w);
                    *(u32x4*)xb = o;
                }
        }
#pragma unroll
        for (int ai = 0; ai < 2; ++ai)
#pragma unroll
            for (int m = 0; m < 4; ++m) {
                const int row = u.pm * 256 + ai * 128 + wr * 64 + m * 16 + fr;
                float q = sq[ai][m];
                q += __shfl_xor(q, 16); q += __shfl_xor(q, 32);
                if (fq == 0) ss[(size_t)row * 16 + u.pn * 4 + wc] = q;
            }
    }
};

struct EpiUp {
    const float* ss; bf16_t* U;
    DI void operator()(const f32x4 (&acc)[2][2][4][2], const Unit& u, int wr, int wc, int fr, int fq) const {
        const int col0 = u.pn * 256 + wc * 32 + 8 * fq;
#pragma unroll
        for (int ai = 0; ai < 2; ++ai)
#pragma unroll
            for (int m = 0; m < 4; ++m) {
                const int row = u.pm * 256 + ai * 128 + wr * 64 + m * 16 + fr;
                const float rstd = row_rstd(ss, row);
#pragma unroll
                for (int bj = 0; bj < 2; ++bj) {
                    f32x4 v0 = acc[ai][bj][m][0] * rstd, v1 = acc[ai][bj][m][1] * rstd;
                    float e[8] = {v0.x, v0.y, v0.z, v0.w, v1.x, v1.y, v1.z, v1.w};
#pragma unroll
                    for (int i = 0; i < 8; ++i) { const float r = fmaxf(e[i], 0.f); e[i] = r * r; }
                    u32x4 o; o.x = pk2(e[0], e[1]); o.y = pk2(e[2], e[3]); o.z = pk2(e[4], e[5]); o.w = pk2(e[6], e[7]);
                    *(u32x4*)(U + (size_t)row * DFF + col0 + bj * 128) = o;
                }
            }
    }
};

struct EpiWin {
    const float* ss; const float* rope;
    bf16_t *Q, *QI, *KP, *VTP, *KIP, *KS, *VTS, *KIS; float* WI; float* out;
    DI void operator()(const f32x4 (&acc)[2][2][4][2], const Unit& u, int wr, int wc, int fr, int fq) const {
        const int q8 = (wc & 1) * 4 + fq;
        const bool smp = u.pm >= 256;
#pragma unroll
        for (int ai = 0; ai < 2; ++ai)
#pragma unroll
            for (int m = 0; m < 4; ++m) {
                const int row = u.pm * 256 + ai * 128 + wr * 64 + m * 16 + fr;
                const float rstd = row_rstd(ss, row);
                int b, pos, L; size_t rl;
                if (smp) { const int rs = row - NP; b = rs >> 6; pos = 2048 + (rs & 63); L = LS; rl = rs; } else { b = row >> 11; pos = row & 2047; L = 2048; rl = row; }
                const f32x4 cs0 = *(const f32x4*)(rope + ((size_t)pos * 32 + 4 * q8) * 2), cs1 = *(const f32x4*)(rope + ((size_t)pos * 32 + 4 * q8) * 2 + 4);
                const float cc[4] = {cs0.x, cs0.z, cs1.x, cs1.z}, sn[4] = {cs0.y, cs0.w, cs1.y, cs1.w};
#pragma unroll
                for (int bj = 0; bj < 2; ++bj) {
                    const int blk = u.pn * 4 + bj * 2 + (wc >> 1);
                    const f32x4 v0 = acc[ai][bj][m][0] * rstd, v1 = acc[ai][bj][m][1] * rstd;
                    const float a0[4] = {v0.x, v0.y, v0.z, v0.w}, a1[4] = {v1.x, v1.y, v1.z, v1.w};
                    float r1[4], r2[4];
#pragma unroll
                    for (int i = 0; i < 4; ++i) { r1[i] = a0[i] * cc[i] - a1[i] * sn[i]; r2[i] = a1[i] * cc[i] + a0[i] * sn[i]; }
                    if (blk < 16) {
                        bf16_t* p = Q + (size_t)row * 1024 + blk * 64 + 4 * q8;
                        u32x2 lo = {pk2(r1[0] * 0.125f, r1[1] * 0.125f), pk2(r1[2] * 0.125f, r1[3] * 0.125f)}, hi = {pk2(r2[0] * 0.125f, r2[1] * 0.125f), pk2(r2[2] * 0.125f, r2[3] * 0.125f)};
                        *(u32x2*)p = lo; *(u32x2*)(p + 32) = hi;
                    } else if (blk < 20) {
                        const int g = blk - 16;
                        float* po = out + (smp ? O_KS : O_KP) + rl * 256 + g * 64 + 4 * q8;
                        *(f32x4*)po = (f32x4){r1[0], r1[1], r1[2], r1[3]}; *(f32x4*)(po + 32) = (f32x4){r2[0], r2[1], r2[2], r2[3]};
                        bf16_t* p = (smp ? KS : KP) + (((size_t)b * 4 + g) * L + pos) * 64 + 4 * q8;
                        u32x2 lo = {pk2(r1[0], r1[1]), pk2(r1[2], r1[3])}, hi = {pk2(r2[0], r2[1]), pk2(r2[2], r2[3])};
                        *(u32x2*)p = lo; *(u32x2*)(p + 32) = hi;
                    } else if (blk < 24) {
                        const int g = blk - 20;
                        float* po = out + (smp ? O_VS : O_VP) + rl * 256 + g * 64 + 8 * q8;
                        *(f32x4*)po = v0; *(f32x4*)(po + 4) = v1;
                        bf16_t* p = (smp ? VTS : VTP) + (((size_t)b * 4 + g) * 64 + 8 * q8) * L + pos;
                        const unsigned w0 = pk2(a0[0], a0[1]), w1 = pk2(a0[2], a0[3]), w2 = pk2(a1[0], a1[1]), w3 = pk2(a1[2], a1[3]);
                        p[0] = (bf16_t)w0; p[(size_t)L] = (bf16_t)(w0 >> 16); p[(size_t)2 * L] = (bf16_t)w1; p[(size_t)3 * L] = (bf16_t)(w1 >> 16);
                        p[(size_t)4 * L] = (bf16_t)w2; p[(size_t)5 * L] = (bf16_t)(w2 >> 16); p[(size_t)6 * L] = (bf16_t)w3; p[(size_t)7 * L] = (bf16_t)(w3 >> 16);
                    } else if (blk < 32) {
                        bf16_t* p = QI + (size_t)row * 512 + (blk - 24) * 64 + 4 * q8;
                        u32x2 lo = {pk2(r1[0] * 0.125f, r1[1] * 0.125f), pk2(r1[2] * 0.125f, r1[3] * 0.125f)}, hi = {pk2(r2[0] * 0.125f, r2[1] * 0.125f), pk2(r2[2] * 0.125f, r2[3] * 0.125f)};
                        *(u32x2*)p = lo; *(u32x2*)(p + 32) = hi;
                    } else if (blk == 32) {
                        float* po = out + (smp ? O_KIS : O_KIP) + rl * 64 + 4 * q8;
                        *(f32x4*)po = (f32x4){r1[0], r1[1], r1[2], r1[3]}; *(f32x4*)(po + 32) = (f32x4){r2[0], r2[1], r2[2], r2[3]};
                        bf16_t* p = (smp ? KIS : KIP) + ((size_t)b * L + pos) * 64 + 4 * q8;
                        u32x2 lo = {pk2(r1[0], r1[1]), pk2(r1[2], r1[3])}, hi = {pk2(r2[0], r2[1]), pk2(r2[2], r2[3])};
                        *(u32x2*)p = lo; *(u32x2*)(p + 32) = hi;
                    } else if (blk == 33 && q8 == 0) {
                        const float s = 0.35355339059327373f;
                        float* p = WI + (size_t)row * 8;
                        *(f32x4*)p = v0 * s; *(f32x4*)(p + 4) = v1 * s;
                    }
                }
            }
    }
};

DI int win_rowmap(int n) {
    const bool roped = (n < 1280) || (n >= 1536 && n < 2112);
    if (!roped) return n;
    const int j = n & 63, base = n & ~63;
    return base + (j < 32 ? 8 * (j >> 2) + (j & 3) : 8 * ((j - 32) >> 2) + 4 + (j & 3));
}
template <bool WINMAP>
DI void transpose_item(const float* W, int K, int N, bf16_t* WT, LAS float* scr, int item, int lane, const float* gk = nullptr) {
    const int nblk = (N + 31) / 32, kb = item / nblk, nb = item % nblk, k0 = 64 * kb, n0 = 32 * nb;
    const int ncol = n0 + (lane & 31);
#pragma unroll 8
    for (int i = 0; i < 32; ++i) { const int kk = 2 * i + (lane >> 5); float v = (ncol < N) ? W[(size_t)(k0 + kk) * N + ncol] : 0.f; if (gk) v *= gk[k0 + kk]; scr[kk * 33 + (lane & 31)] = v; }
    asm volatile("s_waitcnt lgkmcnt(0)" ::: "memory");
    const int c = lane & 7;
#pragma unroll
    for (int j = 0; j < 4; ++j) {
        const int nl = (lane >> 3) + 8 * j, n = n0 + nl;
        const LAS float* s = scr + (8 * c) * 33 + nl;
        u32x4 o; o.x = pk2(s[0], s[33]); o.y = pk2(s[2 * 33], s[3 * 33]); o.z = pk2(s[4 * 33], s[5 * 33]); o.w = pk2(s[6 * 33], s[7 * 33]);
        if (n < N) { const int rowo = WINMAP ? win_rowmap(n) : n; *(u32x4*)(WT + (size_t)rowo * K + k0 + 8 * c) = o; }
    }
    asm volatile("s_waitcnt lgkmcnt(0)" ::: "memory");
}

DI void phase0(const Args& a, LAS unsigned char* lds, int part, int vb, int VG) {
    const int tid = threadIdx.x, wave = tid >> 6, lane = tid & 63, G = VG;
    LAS float* scr = (LAS float*)(lds + wave * 8448);
    unsigned char* ws = a.ws;
    const int gw = vb * 8 + wave, NGW = G * 8;
    const bool pa = part & 1, pb = part & 2, pc = part & 4;
    constexpr int I_POOL = 4 * 4 * 8, I_WIN = 16 * 67, I_WO = 16 * 32, I_UP = 16 * 128, I_DN = 64 * 32;
    constexpr int NITEMS = I_POOL + I_WIN + I_WO + 2 * I_UP + 2 * I_DN;
    for (int it = gw; it < NITEMS; it += NGW) {
        int r = it;
        if (r < I_POOL) { if (!pa) continue; const int g = r >> 5; transpose_item<false>(a.in[9] + (size_t)g * 65536, 256, 256, (bf16_t*)(ws + WS_WPOOL) + (size_t)g * 65536, scr, r & 31, lane); continue; } r -= I_POOL;
        if (r < I_WIN) { if (!pb) continue; transpose_item<true>(a.in[11], 1024, 2120, (bf16_t*)(ws + WS_WIN), scr, r, lane, a.in[6] + D); continue; } r -= I_WIN;
        if (r < I_WO) { if (!pb) continue; transpose_item<false>(a.in[12], 1024, 1024, (bf16_t*)(ws + WS_WO), scr, r, lane); continue; } r -= I_WO;
        if (r < 2 * I_UP) { const int l = r / I_UP; if (!(l ? pb : pc)) continue; transpose_item<false>(a.in[13] + (size_t)l * 4194304, 1024, 4096, (bf16_t*)(ws + (l ? WS_WUP1 : WS_WUP0)), scr, r % I_UP, lane, a.in[7] + (size_t)l * D); continue; } r -= 2 * I_UP;
        { const int l = r / I_DN; if (!(l ? pb : pc)) continue; transpose_item<false>(a.in[14] + (size_t)l * 4194304, 4096, 1024, (bf16_t*)(ws + (l ? WS_WDN1 : WS_WDN0)), scr, r % I_DN, lane); }
    }
    if (!pb) return;
    const int gt = vb * 512 + tid, NGT = G * 512;
    { u32x4* z = (u32x4*)((bf16_t*)(ws + WS_WIN) + (size_t)2120 * 1024); const int n16 = (NWIN - 2120) * 1024 * 2 / 16;
      for (int i = gt; i < n16; i += NGT) z[i] = (u32x4){0u, 0u, 0u, 0u}; }
    { float* rt = (float*)(ws + WS_ROPE);
      for (int i = gt; i < LS * 32; i += NGT) {
          const int pos = i >> 5, f = i & 31;
          double inv = 1.0; for (int k = 0; k < f; ++k) inv *= 0.7498942093324559;
          double rev = (double)pos * inv * 0.15915494309189535; rev -= __builtin_rint(rev);
          const float fr = (float)rev;
          rt[2 * i] = __builtin_amdgcn_cosf(fr); rt[2 * i + 1] = __builtin_amdgcn_sinf(fr);
      } }
    { const float* src = a.in[5]; bf16_t* dst = (bf16_t*)(ws + WS_KIS);
      for (int i = gt; i < 16 * 2048 * 8; i += NGT) {
          const int b = i >> 14, s = (i >> 3) & 2047, d8 = i & 7;
          const f32x4 v0 = *(const f32x4*)(src + (size_t)i * 8), v1 = *(const f32x4*)(src + (size_t)i * 8 + 4);
          u32x4 o = {pk2(v0.x, v0.y), pk2(v0.z, v0.w), pk2(v1.x, v1.y), pk2(v1.z, v1.w)};
          *(u32x4*)(dst + ((size_t)b * LS + s) * 64 + d8 * 8) = o;
      } }
    { const float* src = a.in[3]; bf16_t* dst = (bf16_t*)(ws + WS_KS);
      for (int i = gt; i < 16 * 2048 * 4 * 8; i += NGT) {
          const int d8 = i & 7, g = (i >> 3) & 3, s = (i >> 5) & 2047, b = i >> 16;
          const f32x4 v0 = *(const f32x4*)(src + (size_t)i * 8), v1 = *(const f32x4*)(src + (size_t)i * 8 + 4);
          u32x4 o = {pk2(v0.x, v0.y), pk2(v0.z, v0.w), pk2(v1.x, v1.y), pk2(v1.z, v1.w)};
          *(u32x4*)(dst + (((size_t)b * 4 + g) * LS + s) * 64 + d8 * 8) = o;
      } }
    { const float* src = a.in[4]; bf16_t* dst = (bf16_t*)(ws + WS_VTS);
      for (int i = gt; i < 16 * 4 * 256 * 64; i += NGT) {
          const int d = i & 63, s8 = (i >> 6) & 255, g = (i >> 14) & 3, b = i >> 16;
          const float* p = src + (((size_t)b * 2048 + s8 * 8) * 4 + g) * 64 + d;
          float v[8];
#pragma unroll
          for (int j = 0; j < 8; ++j) v[j] = p[(size_t)j * 256];
          u32x4 o = {pk2(v[0], v[1]), pk2(v[2], v[3]), pk2(v[4], v[5]), pk2(v[6], v[7])};
          *(u32x4*)(dst + (((size_t)b * 4 + g) * 64 + d) * LS + s8 * 8) = o;
      } }
}

DI void phase1(const Args& a, LAS unsigned char* lds) {
    const int tid = threadIdx.x, half = tid >> 8, ht = tid & 255, wv = ht >> 6, lane = tid & 63, G = gridDim.x;
    LAS float* rs = (LAS float*)(lds) + half * 64;
    const float* gmix = a.in[6];
    bf16_t* Dout = (bf16_t*)(a.ws + WS_HA);
    const int c = 4 * ht;
    const f32x4 gq = *(const f32x4*)(gmix + c);
    const int win = 2 << wv;
    for (int base = blockIdx.x * 2; base < 2080; base += 2 * G) {
        const int it = base + half;
        const bool smp = it >= 2048;
        int b, t0, T; const float* xs; size_t rowbase;
        if (smp) { b = (it - 2048) >> 1; t0 = ((it - 2048) & 1) * 32; T = TS; xs = a.in[1] + (size_t)b * TS * D; rowbase = (size_t)NP + b * TS; }
        else { b = it >> 6; t0 = (it & 63) * 32; T = TP; xs = a.in[0] + (size_t)b * TP * D; rowbase = (size_t)b * TP; }
        const float* past = a.in[2] + (size_t)b * 15 * D;
        __syncthreads();
        for (int i = wv; i < 47; i += 4) {
            const int t = t0 + i - 15;
            if (t >= 0) {
                const f32x4* xr = (const f32x4*)(xs + (size_t)t * D) + lane;
                float s = 0.f;
#pragma unroll
                for (int j = 0; j < 4; ++j) { const f32x4 v = xr[64 * j]; s += (v.x * v.x + v.y * v.y) + (v.z * v.z + v.w * v.w); }
#pragma unroll
                for (int o = 1; o < 64; o <<= 1) s += __shfl_xor(s, o);
                if (lane == 0) rs[i] = __builtin_amdgcn_rsqf(s * (1.0f / 1024.0f) + EPS);
            }
        }
        __syncthreads();
        auto hrow = [&](int r) -> f32x4 {
            const int t = t0 + r;
            if (t < 0) { if (smp) return *(const f32x4*)(past + (size_t)(15 + t) * D + c); return (f32x4){0.f, 0.f, 0.f, 0.f}; }
            const f32x4 v = *(const f32x4*)(xs + (size_t)t * D + c);
            return v * rs[r + 15] * gq;
        };
        f32x4 S = {0.f, 0.f, 0.f, 0.f};
        for (int j = 1; j < win; ++j) S = S + hrow(-j);
        float* pout = a.out + (smp ? O_POOLS : O_POOLP) + (size_t)b * 15 * D + c;
#pragma unroll 4
        for (int r = 0; r < 32; ++r) {
            const f32x4 hv = hrow(r);
            S = S + hv;
            const int t = t0 + r;
            const int cnt = smp ? win : (t + 1 < win ? t + 1 : win);
            const float inv = 1.0f / (float)cnt;
            const f32x4 dv = S * inv - hv;
            u32x2 o = {pk2(dv.x, dv.y), pk2(dv.z, dv.w)};
            *(u32x2*)(Dout + (rowbase + t) * D + c) = o;
            if (t >= T - 15) *(f32x4*)(pout + (size_t)(t - (T - 15)) * D) = hv;
            S = S - hrow(r - win + 1);
        }
    }
}

DI unsigned fkey(float s) { s = s + 0.0f; const unsigned u = __float_as_uint(s); return (u & 0x80000000u) ? ~u : (u | 0x80000000u); }
DI unsigned row16_sum(unsigned v) {
    v += (unsigned)__builtin_amdgcn_update_dpp(0, (int)v, 0xB1, 0xf, 0xf, false);
    v += (unsigned)__builtin_amdgcn_update_dpp(0, (int)v, 0x4E, 0xf, 0xf, false);
    v += (unsigned)__builtin_amdgcn_update_dpp(0, (int)v, 0x124, 0xf, 0xf, false);
    v += (unsigned)__builtin_amdgcn_update_dpp(0, (int)v, 0x128, 0xf, 0xf, false);
    return v;
}
DI unsigned row16_max(unsigned v) {
    v = max(v, (unsigned)__builtin_amdgcn_update_dpp(0, (int)v, 0xB1, 0xf, 0xf, false));
    v = max(v, (unsigned)__builtin_amdgcn_update_dpp(0, (int)v, 0x4E, 0xf, 0xf, false));
    v = max(v, (unsigned)__builtin_amdgcn_update_dpp(0, (int)v, 0x124, 0xf, 0xf, false));
    v = max(v, (unsigned)__builtin_amdgcn_update_dpp(0, (int)v, 0x128, 0xf, 0xf, false));
    return v;
}
DI float unkey(unsigned k) { return __uint_as_float((k & 0x80000000u) ? (k & 0x7fffffffu) : ~k); }
DI unsigned count_ge(const unsigned (&kk)[66], unsigned c) {
    unsigned cnt = 0u;
#pragma unroll
    for (int t = 0; t < 66; ++t) asm volatile("v_cmp_ge_u32 vcc, %1, %2\n\tv_addc_co_u32 %0, vcc, 0, %0, vcc" : "+v"(cnt) : "v"(kk[t]), "v"(c) : "vcc");
    return cnt;
}
DI void select_write(const unsigned (&kk)[66], int nk, int hf, int j32, unsigned* mr) {
    unsigned mxk = 0u, mnk = 0xffffffffu;
#pragma unroll
    for (int t = 0; t < 66; ++t) { mxk = max(mxk, kk[t]); mnk = min(mnk, kk[t] - 1u); }
    mxk = row16_max(mxk); mnk = ~row16_max(~mnk);
    { const unsigned m0 = max((unsigned)__builtin_amdgcn_readlane((int)mxk, 0), (unsigned)__builtin_amdgcn_readlane((int)mxk, 16));
      const unsigned m1 = max((unsigned)__builtin_amdgcn_readlane((int)mxk, 32), (unsigned)__builtin_amdgcn_readlane((int)mxk, 48));
      mxk = hf ? m1 : m0;
      const unsigned n0 = min((unsigned)__builtin_amdgcn_readlane((int)mnk, 0), (unsigned)__builtin_amdgcn_readlane((int)mnk, 16));
      const unsigned n1 = min((unsigned)__builtin_amdgcn_readlane((int)mnk, 32), (unsigned)__builtin_amdgcn_readlane((int)mnk, 48));
      mnk = (hf ? n1 : n0) + 1u; }
    unsigned lo = mnk, hi = mxk + 1u;
    unsigned tau = 0u, thr = 0u; bool done = false;
    for (int it = 0; it < 80; ++it) {
        const unsigned span = hi - lo;
        unsigned c = (it < 16) ? fkey(0.5f * unkey(lo) + 0.5f * unkey(hi - 1u)) : lo + (span >> 1);
        c = max(c, lo + 1u); c = min(c, hi - 1u);
        if (done || span < 2u) c = lo;
        unsigned cnt = row16_sum(count_ge(kk, c));
        const unsigned nlo = (unsigned)__builtin_amdgcn_readlane((int)cnt, 0) + (unsigned)__builtin_amdgcn_readlane((int)cnt, 16);
        const unsigned nhi = (unsigned)__builtin_amdgcn_readlane((int)cnt, 32) + (unsigned)__builtin_amdgcn_readlane((int)cnt, 48);
        const unsigned n = hf ? nhi : nlo;
        if (!done) {
            if (span < 2u) { done = true; tau = lo; thr = 0u; }
            else if (n == 256u) { done = true; thr = c; tau = c; }
            else if (n > 256u) lo = c;
            else hi = c;
        }
        if (__ballot(!done) == 0ull) break;
    }
    done = thr != 0u;
    unsigned w[3] = {0u, 0u, 0u};
    if (__ballot(!done) == 0ull) {
#pragma unroll
        for (int t = 0; t < 66; ++t) {
            const unsigned long long bs = __ballot(kk[t] >= thr);
            const unsigned sw = hf ? (unsigned)(bs >> 32) : (unsigned)bs;
            if (j32 == (t & 31)) w[t >> 5] = sw;
        }
    } else {
        unsigned glo = 0u, ghi = 0u;
#pragma unroll
        for (int t = 0; t < 66; ++t) { const unsigned long long b = __ballot(kk[t] > tau); glo += __popc((unsigned)b); ghi += __popc((unsigned)(b >> 32)); }
        const unsigned r0 = 256u - (hf ? ghi : glo);
        unsigned tk = 0u;
        const unsigned below_mask = (1u << j32) - 1u;
#pragma unroll
        for (int t = 0; t < 66; ++t) {
            if (t < nk) {
                const bool eq = kk[t] == tau;
                const unsigned long long be = __ballot(eq);
                const unsigned e = hf ? (unsigned)(be >> 32) : (unsigned)be;
                const bool take = eq && (tk + __popc(e & below_mask) < r0);
                tk += __popc(e);
                const unsigned long long bs = __ballot((kk[t] > tau) || take);
                const unsigned sw = hf ? (unsigned)(bs >> 32) : (unsigned)bs;
                if (j32 == (t & 31)) w[t >> 5] = sw;
            }
        }
    }
    mr[j32] = w[0]; mr[32 + j32] = w[1];
    if (j32 < 2) mr[64 + j32] = w[2];
}
DI void phase_index(const Args& a, LAS unsigned char* lds) {
    const int tid = threadIdx.x, wave = __builtin_amdgcn_readfirstlane(tid >> 6), lane = tid & 63, hf = lane >> 5, j32 = lane & 31, G = gridDim.x;
    const bf16_t* QI = (const bf16_t*)(a.ws + WS_QI); const float* WI = (const float*)(a.ws + WS_WI);
    unsigned* MASK = (unsigned*)(a.ws + WS_MASK);
    LAS unsigned* lk = (LAS unsigned*)(lds + wave * 16896) + lane;
    constexpr int NIT = 32 + 2048;
    for (int base = 0, rnd = 0; base < NIT; base += G, ++rnd) {
        const int idx = (rnd & 1) ? (G - 1 - (int)blockIdx.x) : (int)blockIdx.x;
        const int pos = base + idx;
        if (pos >= NIT) continue;
        int nkt, rowbase; const bf16_t* KI;
        if (pos < 32) { const int b = pos >> 1; nkt = 66; rowbase = NP + b * 64 + (pos & 1) * 32; KI = (const bf16_t*)(a.ws + WS_KIS) + (size_t)b * LS * 64; }
        else { const int p = pos - 32, c = 31 - (p >> 6), b = (p & 63) >> 1; nkt = 2 * (c + 1); rowbase = b * 2048 + c * 64 + (p & 1) * 32; KI = (const bf16_t*)(a.ws + WS_KIP) + (size_t)b * 2048 * 64; }
        const int row0 = rowbase + wave * 4;
        unsigned* mr0 = MASK + (size_t)(row0 + hf) * MASKW; unsigned* mr1 = MASK + (size_t)(row0 + 2 + hf) * MASKW;
        if (nkt <= 8) {
            const unsigned w = (j32 < nkt) ? 0xffffffffu : 0u;
            mr0[j32] = w; mr0[32 + j32] = 0u; mr1[j32] = w; mr1[32 + j32] = 0u;
            if (j32 < 2) { mr0[64 + j32] = 0u; mr1[64 + j32] = 0u; }
            continue;
        }
        int nk = nkt; asm volatile("" : "+s"(nk));
        const int qq = 2 * (j32 >> 4) + ((j32 >> 2) & 1), hh = 4 * ((j32 >> 3) & 1) + (j32 & 3);
        bf16x8 aq[4];
        { const bf16_t* p = QI + (size_t)(row0 + qq) * 512 + hh * 64 + 8 * hf;
#pragma unroll
          for (int jj = 0; jj < 4; ++jj) aq[jj] = *(const bf16x8*)(p + 16 * jj); }
        float wv0[8], wv1[8];
        { const float* p0 = WI + (size_t)(row0 + hf) * 8; const float* p1 = WI + (size_t)(row0 + 2 + hf) * 8;
          const f32x4 x0 = *(const f32x4*)p0, x1 = *(const f32x4*)(p0 + 4), y0 = *(const f32x4*)p1, y1 = *(const f32x4*)(p1 + 4);
          wv0[0] = x0.x; wv0[1] = x0.y; wv0[2] = x0.z; wv0[3] = x0.w; wv0[4] = x1.x; wv0[5] = x1.y; wv0[6] = x1.z; wv0[7] = x1.w;
          wv1[0] = y0.x; wv1[1] = y0.y; wv1[2] = y0.z; wv1[3] = y0.w; wv1[4] = y1.x; wv1[5] = y1.y; wv1[6] = y1.z; wv1[7] = y1.w; }
        const char* kbase = (const char*)KI;
        const unsigned koff = (unsigned)(j32 * 64 + 8 * hf) * 2u;
        unsigned kk[66];
#pragma unroll
        for (int g = 0; g < 17; ++g) {
#pragma unroll
            for (int u = 0; u < 4; ++u) if (4 * g + u < 66) kk[4 * g + u] = 0u;
            if (4 * g < nk) {
                bf16x8 bt[4][4];
#pragma unroll
                for (int u = 0; u < 4; ++u) { const int tt = (4 * g + u < nk) ? 4 * g + u : nk - 1; const char* p = kbase + (size_t)tt * 4096 + koff;
#pragma unroll
                    for (int jj = 0; jj < 4; ++jj) bt[u][jj] = *(const bf16x8*)(p + 32 * jj); }
#pragma unroll
                for (int u = 0; u < 4; ++u) {
                    const int t = 4 * g + u;
                    if (t < 66) {
                        f32x16 acc;
#pragma unroll
                        for (int i = 0; i < 16; ++i) acc[i] = 0.f;
#pragma unroll
                        for (int jj = 0; jj < 4; ++jj) acc = __builtin_amdgcn_mfma_f32_32x32x16_bf16(aq[jj], bt[u][jj], acc, 0, 0, 0);
                        float s0 = 0.f, s1 = 0.f;
#pragma unroll
                        for (int i = 0; i < 8; ++i) {
                            s0 = __builtin_fmaf(__int_as_float(max(__float_as_int(acc[i]), 0)), wv0[i], s0);
                            s1 = __builtin_fmaf(__int_as_float(max(__float_as_int(acc[8 + i]), 0)), wv1[i], s1);
                        }
                        const bool live = t < nk;
                        kk[t] = live ? fkey(s0) : 0u;
                        lk[t * 64] = live ? fkey(s1) : 0u;
                    }
                }
            } else {
#pragma unroll
                for (int u = 0; u < 4; ++u) if (4 * g + u < 66) lk[(4 * g + u) * 64] = 0u;
            }
            __builtin_amdgcn_sched_barrier(0);
        }
        select_write(kk, nk, hf, j32, mr0);
#pragma unroll
        for (int t = 0; t < 66; ++t) kk[t] = lk[t * 64];
        select_write(kk, nk, hf, j32, mr1);
    }
}

DI void phase_attn(const Args& a, LAS unsigned char* lds) {
    const int tid = threadIdx.x, wave = __builtin_amdgcn_readfirstlane(tid >> 6), lane = tid & 63, hf = lane >> 5, j32 = lane & 31, G = gridDim.x;
    const bf16_t* Q = (const bf16_t*)(a.ws + WS_Q);
    const unsigned* MASK = (const unsigned*)(a.ws + WS_MASK);
    bf16_t* O = (bf16_t*)(a.ws + WS_HA);
    constexpr int NIT = 64 + 4096;
    constexpr float LOG2E = 1.4426950408889634f;
    constexpr int RS = 144, RSV = 528, KREG = 256 * RS, BUFB = KREG + 64 * RSV;
    const int th = wave >> 2, hd = wave & 3;
    const int pik = (j32 & 0x13) | ((j32 & 8) >> 1) | ((j32 & 4) << 1);
    const bf16x8 ones = {0x3f80, 0x3f80, 0x3f80, 0x3f80, 0x3f80, 0x3f80, 0x3f80, 0x3f80};
    const unsigned kread = (unsigned)(pik * RS + 16 * hf), vread = (unsigned)(KREG + j32 * RSV + 16 * hf);
    for (int base = 0, rnd = 0; base < NIT; base += G, ++rnd) {
        const int idx = (rnd & 1) ? (G - 1 - (int)blockIdx.x) : (int)blockIdx.x;
        const int pos = base + idx;
        if (pos >= NIT) continue;
        int nst, rowbase, L, g; const bf16_t *Kb, *Vt;
        if (pos < 64) { const int b = pos >> 2; g = pos & 3; nst = 33; L = LS; rowbase = NP + b * 64;
            Kb = (const bf16_t*)(a.ws + WS_KS) + ((size_t)b * 4 + g) * LS * 64; Vt = (const bf16_t*)(a.ws + WS_VTS) + ((size_t)b * 4 + g) * 64 * LS; }
        else { const int p = pos - 64, c = 31 - (p >> 7), b = (p & 127) >> 2; g = p & 3; nst = c + 1; L = 2048; rowbase = b * 2048 + c * 64;
            Kb = (const bf16_t*)(a.ws + WS_KP) + ((size_t)b * 4 + g) * 2048 * 64; Vt = (const bf16_t*)(a.ws + WS_VTP) + ((size_t)b * 4 + g) * 64 * 2048; }
        const int nbig = (nst + 3) >> 2;
        const int row = rowbase + th * 32 + j32, head = 4 * g + hd;
        bf16x8 qf[4];
        { const bf16_t* p = Q + (size_t)row * 1024 + head * 64 + 8 * hf;
#pragma unroll
          for (int jj = 0; jj < 4; ++jj) qf[jj] = *(const bf16x8*)(p + 16 * jj); }
        const unsigned* mrow = MASK + (size_t)row * MASKW;
        u32x4 kr[4], vr[4];
        auto stage_load = [&](int bs) __attribute__((always_inline)) {
#pragma unroll
            for (int i = 0; i < 4; ++i) {
                const int cid = tid + 512 * i;
                int kr_row = bs * 256 + (cid >> 3); kr_row = kr_row < L ? kr_row : L - 1;
                kr[i] = *(const u32x4*)(Kb + (size_t)kr_row * 64 + (cid & 7) * 8);
                int vcol = bs * 256 + (cid & 31) * 8; vcol = vcol < L - 8 ? vcol : L - 8;
                vr[i] = *(const u32x4*)(Vt + (size_t)(cid >> 5) * L + vcol);
            }
        };
        auto stage_store = [&](LAS unsigned char* buf) __attribute__((always_inline)) {
#pragma unroll
            for (int i = 0; i < 4; ++i) {
                const int cid = tid + 512 * i;
                *(LAS u32x4*)(buf + (cid >> 3) * RS + (cid & 7) * 16) = kr[i];
                *(LAS u32x4*)(buf + KREG + (cid >> 5) * RSV + (cid & 31) * 16) = vr[i];
            }
        };
        stage_load(0);
        f32x16 o0, o1, lacc;
#pragma unroll
        for (int i = 0; i < 16; ++i) { o0[i] = 0.f; o1[i] = 0.f; lacc[i] = 0.f; }
        float mrun = -1e30f;
        u32x4 mwa = *(const u32x4*)mrow, mwb = *(const u32x4*)(mrow + 4);
        __syncthreads();
        stage_store(lds);
        __syncthreads();
        for (int bs = 0; bs < nbig; ++bs) {
            LAS unsigned char* cur = lds + (bs & 1) * BUFB;
            const bool more = bs + 1 < nbig;
            if (more) stage_load(bs + 1);
            const unsigned mw8[8] = {mwa.x, mwa.y, mwa.z, mwa.w, mwb.x, mwb.y, mwb.z, mwb.w};
            if (more) { mwa = *(const u32x4*)(mrow + 8 * (bs + 1)); mwb = *(const u32x4*)(mrow + 8 * (bs + 1) + 4); }
            const int nv = (nst - 4 * bs) < 4 ? (nst - 4 * bs) : 4;
#pragma unroll
            for (int j = 0; j < 4; ++j) {
                if (j < nv) {
                    f32x16 sc[2];
#pragma unroll
                    for (int tt = 0; tt < 2; ++tt) {
#pragma unroll
                        for (int i = 0; i < 16; ++i) sc[tt][i] = 0.f;
#pragma unroll
                        for (int jj = 0; jj < 4; ++jj) {
                            const bf16x8 kf = *(const LAS bf16x8*)(cur + kread + (j * 64 + tt * 32) * RS + 32 * jj);
                            sc[tt] = __builtin_amdgcn_mfma_f32_32x32x16_bf16(kf, qf[jj], sc[tt], 0, 0, 0);
                        }
                    }
                    float mx = __builtin_fmaxf(sc[0][0], sc[1][0]);
#pragma unroll
                    for (int i = 1; i < 16; ++i) mx = __builtin_fmaxf(__builtin_fmaxf(mx, sc[0][i]), sc[1][i]);
                    mx = xhalf_max(mx);
                    if (__ballot(mx > mrun + 8.0f) != 0ull) {
                        const float mnew = fmaxf(mrun, mx);
                        const float alpha = __builtin_amdgcn_exp2f((mrun - mnew) * LOG2E);
                        mrun = mnew;
#pragma unroll
                        for (int i = 0; i < 16; ++i) { o0[i] *= alpha; o1[i] *= alpha; lacc[i] *= alpha; }
                    }
                    const float nm = -mrun * LOG2E;
#pragma unroll
                    for (int tt = 0; tt < 2; ++tt) {
                        const unsigned mw = mw8[2 * j + tt] >> (8 * hf);
                        float p[16];
#pragma unroll
                        for (int i = 0; i < 16; ++i) {
                            const float e = __builtin_amdgcn_exp2f(__builtin_fmaf(sc[tt][i], LOG2E, nm));
                            const unsigned msk = (unsigned)__builtin_amdgcn_sbfe((int)mw, (i & 7) + 16 * (i >> 3), 1);
                            p[i] = __uint_as_float(__float_as_uint(e) & msk);
                        }
#pragma unroll
                        for (int s2 = 0; s2 < 2; ++s2) {
                            u32x4 pw = {pk2(p[8 * s2], p[8 * s2 + 1]), pk2(p[8 * s2 + 2], p[8 * s2 + 3]), pk2(p[8 * s2 + 4], p[8 * s2 + 5]), pk2(p[8 * s2 + 6], p[8 * s2 + 7])};
                            const bf16x8 pf = __builtin_bit_cast(bf16x8, pw);
                            const bf16x8 v0 = *(const LAS bf16x8*)(cur + vread + (j * 64 + tt * 32 + 16 * s2) * 2);
                            const bf16x8 v1 = *(const LAS bf16x8*)(cur + vread + 32 * RSV + (j * 64 + tt * 32 + 16 * s2) * 2);
                            o0 = __builtin_amdgcn_mfma_f32_32x32x16_bf16(v0, pf, o0, 0, 0, 0);
                            o1 = __builtin_amdgcn_mfma_f32_32x32x16_bf16(v1, pf, o1, 0, 0, 0);
                            lacc = __builtin_amdgcn_mfma_f32_32x32x16_bf16(ones, pf, lacc, 0, 0, 0);
                        }
                    }
                }
            }
            if (more) stage_store(lds + ((bs & 1) ^ 1) * BUFB);
            __syncthreads();
        }
        const float inv = 1.0f / lacc[0];
        bf16_t* op = O + (size_t)row * 1024 + head * 64 + 4 * hf;
#pragma unroll
        for (int q = 0; q < 4; ++q) {
            u32x2 x0 = {pk2(o0[4 * q] * inv, o0[4 * q + 1] * inv), pk2(o0[4 * q + 2] * inv, o0[4 * q + 3] * inv)};
            u32x2 x1 = {pk2(o1[4 * q] * inv, o1[4 * q + 1] * inv), pk2(o1[4 * q + 2] * inv, o1[4 * q + 3] * inv)};
            *(u32x2*)(op + 8 * q) = x0; *(u32x2*)(op + 32 + 8 * q) = x1;
        }
    }
}

DI void phase_final(const Args& a) {
    const int tid = threadIdx.x, wave = tid >> 6, lane = tid & 63, G = gridDim.x;
    const float* ss = (const float*)(a.ws + WS_SS1);
    const bf16_t* Xb = (const bf16_t*)(a.ws + WS_HB);
    const float* gf = a.in[8];
    f32x4 g0[2], g1[2];
#pragma unroll
    for (int j = 0; j < 2; ++j) { g0[j] = *(const f32x4*)(gf + (lane + 64 * j) * 8); g1[j] = *(const f32x4*)(gf + (lane + 64 * j) * 8 + 4); }
    for (int row = blockIdx.x * 8 + wave; row < NR; row += G * 8) {
        float s = ss[(size_t)row * 16 + (lane & 15)];
        s += __shfl_xor(s, 1); s += __shfl_xor(s, 2); s += __shfl_xor(s, 4); s += __shfl_xor(s, 8);
        const float rstd = __builtin_amdgcn_rsqf(s * (1.0f / 1024.0f) + EPS);
        const u32x4* hr = (const u32x4*)(Xb + (size_t)row * D) + lane;
        f32x4* yr = (f32x4*)(a.out + (size_t)row * D) + 2 * lane;
#pragma unroll
        for (int j = 0; j < 2; ++j) {
            const u32x4 h = hr[64 * j];
            f32x4 y0 = {__uint_as_float(h.x << 16), __uint_as_float(h.x & 0xffff0000u), __uint_as_float(h.y << 16), __uint_as_float(h.y & 0xffff0000u)};
            f32x4 y1 = {__uint_as_float(h.z << 16), __uint_as_float(h.z & 0xffff0000u), __uint_as_float(h.w << 16), __uint_as_float(h.w & 0xffff0000u)};
            yr[128 * j] = y0 * rstd * g0[j]; yr[128 * j + 1] = y1 * rstd * g1[j];
        }
    }
}

#define XB_TMO      128
#define XB_XCNT(j)  (256  + 64 * (j))
#define XB_XSUB(j)  (1280 + 64 * (j))
#define XB_XGEN(j)  (2304 + 64 * (j))
#define XB_TOP      3328
#define XB_TOPGEN   3392
#define XCD_BAR_WORDS 3456
#define XB_SPIN_CAP (1u << 20)
DI unsigned xb_ld(unsigned* p)              { return __hip_atomic_load(p, __ATOMIC_RELAXED, __HIP_MEMORY_SCOPE_AGENT); }
DI unsigned xb_add(unsigned* p, unsigned v) { return __hip_atomic_fetch_add(p, v, __ATOMIC_RELAXED, __HIP_MEMORY_SCOPE_AGENT); }
DI unsigned xb_xcc_id() { return (unsigned)__builtin_amdgcn_s_getreg((3 << 11) | 20) & 0xFu; }
#define XB_SPIN(cond, bar) do { unsigned _sp = 0; while (cond) { __builtin_amdgcn_s_sleep(1); \
    if ((++_sp & 255u) == 0u) { if (xb_ld(&(bar)[XB_TMO])) break; if (_sp > XB_SPIN_CAP) { atomicAdd(&(bar)[XB_TMO], 1u); break; } } } } while (0)
struct XcdBarrier { unsigned* bar; unsigned x; volatile LAS unsigned* st; };
DI XcdBarrier xcd_barrier_post(unsigned* bar, volatile LAS unsigned* st) {
    XcdBarrier b; b.bar = bar; b.x = xb_xcc_id(); b.st = st;
    if (threadIdx.x == 0) (void)xb_add(&bar[XB_XCNT(b.x)], 1u);
    return b;
}
DI void xcd_barrier_complete(unsigned* bar, unsigned x, unsigned& nloc, unsigned& nx) {
    const unsigned G = gridDim.x * gridDim.y * gridDim.z;
    unsigned sum, cnt, mine, sp = 0u;
    for (;;) {
        sum = 0u; cnt = 0u; mine = 0u;
#pragma unroll
        for (unsigned j = 0; j < 16; ++j) { const unsigned c = xb_ld(&bar[XB_XCNT(j)]); sum += c; cnt += (c > 0u) ? 1u : 0u; mine = (j == x) ? c : mine; }
        if (sum == G) break;
        __builtin_amdgcn_s_sleep(1);
        if ((++sp & 255u) == 0u) { if (xb_ld(&bar[XB_TMO])) break; if (sp > XB_SPIN_CAP) { atomicAdd(&bar[XB_TMO], 1u); break; } }
    }
    nloc = mine > 0u ? mine : 1u; nx = cnt > 0u ? cnt : 1u;
}
DI void xcd_barrier(const XcdBarrier& b) {
    asm volatile("s_waitcnt vmcnt(0)" ::: "memory");
    __syncthreads();
    if (threadIdx.x == 0) {
        unsigned* bar = b.bar;
        __builtin_amdgcn_s_waitcnt(0);
        unsigned nloc = b.st[0], nx = b.st[1];
        if (nloc == 0u) { xcd_barrier_complete(bar, b.x, nloc, nx); b.st[0] = nloc; b.st[1] = nx; }
        const unsigned old = xb_add(&bar[XB_XSUB(b.x)], 1u);
        const unsigned gen = old / nloc;
        if (old + 1u == (gen + 1u) * nloc) {
            __builtin_amdgcn_fence(__ATOMIC_RELEASE, "agent");
            asm volatile("s_waitcnt vmcnt(0)" ::: "memory");
            const unsigned og = xb_add(&bar[XB_TOP], 1u);
            const unsigned tg = og / nx;
            if (og + 1u == (tg + 1u) * nx) xb_add(&bar[XB_TOPGEN], 1u);
            else XB_SPIN(xb_ld(&bar[XB_TOPGEN]) == tg, bar);
            __builtin_amdgcn_fence(__ATOMIC_ACQUIRE, "agent");
            xb_add(&bar[XB_XGEN(b.x)], 1u);
            asm volatile("s_waitcnt vmcnt(0)" ::: "memory");
        } else {
            XB_SPIN(xb_ld(&bar[XB_XGEN(b.x)]) == gen, bar);
            __builtin_amdgcn_fence(__ATOMIC_ACQUIRE, "agent");
            asm volatile("s_waitcnt vmcnt(0)" ::: "memory");
        }
    }
    __syncthreads();
}

__global__ void __launch_bounds__(512, 2) fwd_kernel(Args a) {
    extern __shared__ __attribute__((aligned(16))) unsigned char lds_raw[];
    LAS unsigned char* lds = (LAS unsigned char*)lds_raw;
    cg::grid_group grid = cg::this_grid();
    volatile LAS unsigned* xst = (volatile LAS unsigned*)(lds + LDS_PHASE);
    if (threadIdx.x == 0) { xst[0] = 0u; xst[1] = 0u; }
    __syncthreads();
    const XcdBarrier xb = xcd_barrier_post((unsigned*)(a.ws + WS_BAR), xst);
    unsigned char* ws = a.ws;
    const int G = gridDim.x;
    pg8::StaticOrder S;
    float* ss0 = (float*)(ws + WS_SS0); float* ss1 = (float*)(ws + WS_SS1);
    bf16_t* HA = (bf16_t*)(ws + WS_HA); bf16_t* Xb = (bf16_t*)(ws + WS_HB); bf16_t* U = (bf16_t*)(ws + WS_U);
#ifndef PHMASK
#define PHMASK 0xfff
#endif
#ifndef PROBE_REP
#define PROBE_REP 0x0
#endif
#define PHASE(k) if (((PHMASK >> (k)) & 1) && (k) >= a.ph_lo && (k) < a.ph_hi)
#define SEAM(k) do { if ((k) >= a.ph_lo && (k) + 1 < a.ph_hi) { if ((k) == 0) grid.sync(); else xcd_barrier(xb); } } while (0)
    const bool defer0 = (G == 256);
    PHASE(0) { phase0(a, lds, defer0 ? 1 : 7, blockIdx.x, G); phase1(a, lds); }
#if PROBE_REP & 0x1
    grid.sync(); phase0(a, lds, 7, blockIdx.x, G); phase1(a, lds);
#endif
    SEAM(0);
    PHASE(1) {
        pg8::Gemm g{HA, (const bf16_t*)(ws + WS_WPOOL), NR, 1024, 256, 1024, 256, 512};
        S.init(NR, 1024, G, blockIdx.x);
        EpiRes<true, true> E{a.in[0], a.in[1], Xb, a.in[10], ss0};
        pg8::gemm_phase(lds, g, S, E);
        if (defer0 && blockIdx.x >= 16) phase0(a, lds, 4, blockIdx.x - 16, 240);
    }
    SEAM(1);
    PHASE(2) {
        pg8::Gemm g{Xb, (const bf16_t*)(ws + WS_WUP0), NR, DFF, 1024, 1024, 1024, 0};
        S.init(NR, DFF, G, blockIdx.x);
        EpiUp E{ss0, U};
        pg8::gemm_phase(lds, g, S, E);
    }
    SEAM(2);
    PHASE(3) {
        pg8::Gemm g{U, (const bf16_t*)(ws + WS_WDN0), NR, 1024, DFF, DFF, DFF, 0};
        S.init(NR, 1024, G, blockIdx.x);
        EpiRes<false, false> E{nullptr, nullptr, Xb, nullptr, ss1};
        pg8::gemm_phase(lds, g, S, E);
        if (defer0 && blockIdx.x >= 16) phase0(a, lds, 2, blockIdx.x - 16, 240);
    }
    SEAM(3);
    PHASE(4) {
        pg8::Gemm g{Xb, (const bf16_t*)(ws + WS_WIN), NR, NWIN, 1024, 1024, 1024, 0};
        S.init(NR, NWIN, G, blockIdx.x);
        EpiWin E{ss1, (const float*)(ws + WS_ROPE), (bf16_t*)(ws + WS_Q), (bf16_t*)(ws + WS_QI), (bf16_t*)(ws + WS_KP), (bf16_t*)(ws + WS_VTP), (bf16_t*)(ws + WS_KIP),
                 (bf16_t*)(ws + WS_KS), (bf16_t*)(ws + WS_VTS), (bf16_t*)(ws + WS_KIS), (float*)(ws + WS_WI), a.out};
        pg8::gemm_phase(lds, g, S, E);
    }
    SEAM(4);
    PHASE(5) { phase_index(a, lds); }
    SEAM(5);
    PHASE(6) { phase_attn(a, lds); }
    SEAM(6);
    PHASE(7) {
        pg8::Gemm g{HA, (const bf16_t*)(ws + WS_WO), NR, 1024, 1024, 1024, 1024, 0};
        S.init(NR, 1024, G, blockIdx.x);
        EpiRes<false, false> E{nullptr, nullptr, Xb, nullptr, ss0};
        pg8::gemm_phase(lds, g, S, E);
    }
    SEAM(7);
    PHASE(8) {
        pg8::Gemm g{Xb, (const bf16_t*)(ws + WS_WUP1), NR, DFF, 1024, 1024, 1024, 0};
        S.init(NR, DFF, G, blockIdx.x);
        EpiUp E{ss0, U};
        pg8::gemm_phase(lds, g, S, E);
    }
    SEAM(8);
    PHASE(9) {
        pg8::Gemm g{U, (const bf16_t*)(ws + WS_WDN1), NR, 1024, DFF, DFF, DFF, 0};
        S.init(NR, 1024, G, blockIdx.x);
        EpiRes<false, false> E{nullptr, nullptr, Xb, nullptr, ss1};
        pg8::gemm_phase(lds, g, S, E);
    }
    SEAM(9);
    PHASE(10) { phase_final(a); }
}

#ifndef N_LAUNCHES
#define N_LAUNCHES 1
#endif
extern "C" void kernel_launch(void* const* d_in, const int* in_sizes, int n_in, void* d_out, int out_size, void* d_ws, size_t ws_size, hipStream_t stream) {
    static int grid = 0;
    if (grid == 0) {
        if (n_in != 15 || out_size != 107233280 || ws_size < WS_END) { fprintf(stderr, "kernel_launch: unexpected shapes (n_in %d out %d ws %zu need %zu)\n", n_in, out_size, ws_size, (size_t)WS_END); grid = -1; return; }
        int dev = 0, cus = 0, per_cu = 0;
        hipGetDevice(&dev); hipDeviceGetAttribute(&cus, hipDeviceAttributeMultiprocessorCount, dev);
        if (hipFuncSetAttribute((const void*)fwd_kernel, hipFuncAttributeMaxDynamicSharedMemorySize, LDS_BYTES) != hipSuccess) { fprintf(stderr, "kernel_launch: hipFuncSetAttribute failed\n"); grid = -1; return; }
        hipOccupancyMaxActiveBlocksPerMultiprocessor(&per_cu, (const void*)fwd_kernel, 512, LDS_BYTES);
        if (per_cu < 1) { fprintf(stderr, "kernel_launch: occupancy query says %d\n", per_cu); per_cu = 1; }
        (void)hipGetLastError();
        grid = cus;
    }
    if (grid < 0) return;
    if (hipMemsetAsync((char*)d_ws + WS_BAR, 0, XCD_BAR_WORDS * 4, stream) != hipSuccess) { fprintf(stderr, "kernel_launch: memset of the barrier words failed\n"); return; }
    Args a{};
    for (int i = 0; i < 15; ++i) a.in[i] = (const float*)d_in[i];
    a.out = (float*)d_out; a.ws = (unsigned char*)d_ws;
#if N_LAUNCHES == 1
    a.ph_lo = 0; a.ph_hi = 11;
    void* args[] = {&a};
    hipError_t e = hipLaunchCooperativeKernel((const void*)fwd_kernel, dim3(grid), dim3(512), args, LDS_BYTES, stream);
    if (e != hipSuccess) fprintf(stderr, "cooperative launch failed: %s (grid %d)\n", hipGetErrorString(e), grid);
#else
    for (int ph = 0; ph < 11; ++ph) { a.ph_lo = ph; a.ph_hi = ph + 1; hipLaunchKernelGGL(fwd_kernel, dim3(grid), dim3(512), LDS_BYTES, stream, a); }
#endif
}
```

```cpp
#include <hip/hip_runtime.h>
#include <hip/hip_cooperative_groups.h>
#include <cstdio>
#include <cstdint>
namespace cg = cooperative_groups;

#define LAS __attribute__((address_space(3)))
#define DI __device__ __forceinline__
typedef unsigned short bf16_t;
typedef short bf16x8 __attribute__((ext_vector_type(8)));
typedef float f32x2 __attribute__((ext_vector_type(2)));
typedef float f32x4 __attribute__((ext_vector_type(4)));
typedef float f32x16 __attribute__((ext_vector_type(16)));
typedef unsigned u32x2 __attribute__((ext_vector_type(2)));
typedef unsigned u32x4 __attribute__((ext_vector_type(4)));
typedef __bf16 bfv2 __attribute__((ext_vector_type(2)));

constexpr int D = 1024, NP = 65536, NS = 1024, NR = NP + NS, TP = 2048, TS = 64, LS = 2112, DFF = 4096;
constexpr int NWIN = 2304;
constexpr int MASKW = 68;
constexpr float EPS = 1e-6f;
constexpr size_t O_Y = 0, O_POOLP = 68157440, O_POOLS = 68648960, O_KP = 68894720, O_VP = 85671936, O_KIP = 102449152,
                 O_KS = 106643456, O_VS = 106905600, O_KIS = 107167744;
constexpr size_t WS_WPOOL = 0;
constexpr size_t WS_WIN = WS_WPOOL + 524288;
constexpr size_t WS_WO = WS_WIN + (size_t)NWIN * 1024 * 2;
constexpr size_t WS_WUP0 = WS_WO + 2097152;
constexpr size_t WS_WUP1 = WS_WUP0 + 8388608;
constexpr size_t WS_WDN0 = WS_WUP1 + 8388608;
constexpr size_t WS_WDN1 = WS_WDN0 + 8388608;
constexpr size_t WS_ROPE = WS_WDN1 + 8388608;
constexpr size_t WS_SS0 = WS_ROPE + 540672;
constexpr size_t WS_SS1 = WS_SS0 + (size_t)NR * 64;
constexpr size_t WS_KS = WS_SS1 + (size_t)NR * 64;
constexpr size_t WS_VTS = WS_KS + (size_t)16 * 4 * LS * 64 * 2;
constexpr size_t WS_KIS = WS_VTS + (size_t)16 * 4 * LS * 64 * 2;
constexpr size_t WS_HA = WS_KIS + (size_t)16 * LS * 64 * 2;
constexpr size_t WS_HB = WS_HA + (size_t)NR * 1024 * 2;
constexpr size_t WS_U = WS_HB + (size_t)NR * 1024 * 2;
constexpr size_t WS_BAR = WS_U + (size_t)NR * 4096 * 2;
constexpr size_t WS_END = WS_BAR + 16384;
constexpr size_t WS_Q = WS_U;
constexpr size_t WS_QI = WS_Q + (size_t)NR * 1024 * 2;
constexpr size_t WS_KP = WS_QI + (size_t)NR * 512 * 2;
constexpr size_t WS_VTP = WS_KP + (size_t)32 * 4 * 2048 * 64 * 2;
constexpr size_t WS_KIP = WS_VTP + (size_t)32 * 4 * 2048 * 64 * 2;
constexpr size_t WS_WI = WS_KIP + (size_t)32 * 2048 * 64 * 2;
constexpr size_t WS_MASK = WS_WI + (size_t)NR * 8 * 4;
constexpr size_t WS_ALIAS_END = WS_MASK + (size_t)NR * MASKW * 4;
static_assert(WS_ALIAS_END <= WS_BAR, "alias overflow");

constexpr int LDS_PHASE = 141312;
constexpr int LDS_BYTES = LDS_PHASE + 16;

struct Args {
    const float* in[15];
    float* out;
    unsigned char* ws;
    int ph_lo, ph_hi;
};

DI unsigned pk2(float lo, float hi) { f32x2 v = {lo, hi}; bfv2 b = __builtin_convertvector(v, bfv2); return __builtin_bit_cast(unsigned, b); }
DI float bf2f(bf16_t b) { return __uint_as_float(((unsigned)b) << 16); }
DI float xhalf_max(float x) {
    auto r = __builtin_amdgcn_permlane32_swap(__float_as_uint(x), __float_as_uint(x), false, false);
    return fmaxf(__uint_as_float(r[0]), __uint_as_float(r[1]));
}
DI float xhalf_sum(float x) {
    auto r = __builtin_amdgcn_permlane32_swap(__float_as_uint(x), __float_as_uint(x), false, false);
    return __uint_as_float(r[0]) + __uint_as_float(r[1]);
}

namespace pg8 {
constexpr int BM = 256, BK = 64, HALF = 128, HTB = HALF * BK * 2, STAGE_BYTES = 8 * HTB, NXCD = 8, WGM = 8;
DI int lds_byte(int r, int c) { const int st = (r >> 4) * 2 + (c >> 5), rr = r & 15, cc = c & 31, ob = rr * 64 + cc * 2; return st * 1024 + (ob ^ (((ob >> 9) & 1) << 5)); }
DI void stage_rc(int b, int& R, int& C) { const int st = b / 1024, sb = b % 1024, swz = sb ^ (((sb >> 9) & 1) << 5); R = (st >> 1) * 16 + swz / 64; C = (st & 1) * 32 + (swz % 64) / 2; }
DI int perm32(int rho) { const int n = rho >> 4, i = rho & 15; return 8 * (i >> 2) + 4 * n + (i & 3); }
struct Unit { int pm, pn; };
struct Gemm { const bf16_t* A; const bf16_t* Bt; int M, N, K, lda, ldb, a_pn_bytes; };
struct StaticOrder {
    int nM, nN, nwg, G, c;
    DI void init(int M, int N, int G_, int c_) { nM = M / BM; nN = N / BM; nwg = nM * nN; G = G_; c = c_; }
    DI bool next(int i, Unit& u) const {
        const long L = (long)i * G + c; if (L >= nwg) return false;
        int wgid = (int)L; { const int q = nwg / NXCD, r = nwg % NXCD, xcd = wgid % NXCD, off = wgid / NXCD; wgid = (xcd < r ? xcd * (q + 1) : r * (q + 1) + (xcd - r) * q) + off; }
        const int nig = WGM * nN, gid = wgid / nig, fm = gid * WGM, gsz = (nM - fm) < WGM ? (nM - fm) : WGM;
        u.pm = fm + ((wgid % nig) % gsz); u.pn = (wgid % nig) / gsz; return true;
    }
};

template <class Epi>
DI void gemm_phase(LAS unsigned char* lds, const Gemm g, const StaticOrder& S, const Epi& E) {
    const int tid = threadIdx.x, wid = __builtin_amdgcn_readfirstlane(tid >> 6), lane = tid & 63, wr = wid >> 2, wc = wid & 3, fr = lane & 15, fq = lane >> 4;
    const int K = g.K, nt = K / BK;
    unsigned voffA[2], voffB[2];
#pragma unroll
    for (int i = 0; i < 2; ++i) { int R, C; stage_rc(tid * 16 + i * 8192, R, C); const int Rb = (R & ~31) + perm32(R & 31);
        voffA[i] = (unsigned)(R * g.lda + C) * 2u; voffB[i] = (unsigned)(Rb * g.ldb + C) * 2u; }
    const size_t kstep = (size_t)(BK * 2);
    const size_t hstepA = (size_t)HALF * g.lda * 2, hstepB = (size_t)HALF * g.ldb * 2;
    const size_t tstepA = 2 * hstepA, tstepB = 2 * hstepB;
    const unsigned ldsw = (unsigned)wid * 1024u;
    const int aoff = lds_byte(wr * 64 + fr, fq * 8), boff = lds_byte(wc * 32 + fr, fq * 8);
#define PG8_SA(b, h) (((b) * 2 + (h)) * HTB)
#define PG8_SB(b, h) ((4 + (b) * 2 + (h)) * HTB)
#define PG8_STAGE(bufoff, gbase, voff) do { _Pragma("unroll") for (int _i = 0; _i < 2; ++_i) \
        __builtin_amdgcn_global_load_lds((const unsigned*)((const char*)(gbase) + (voff)[_i]), (LAS unsigned*)(lds + (bufoff) + ldsw + _i * 8192), 16, 0, 0); } while (0)
#define PG8_LDA(dst, b, h) do { _Pragma("unroll") for (int m = 0; m < 4; ++m) _Pragma("unroll") for (int k = 0; k < 2; ++k) dst[m][k] = *(const LAS bf16x8*)(lds + PG8_SA(b, h) + aoff + m * 2048 + k * 1024); } while (0)
#define PG8_LDB(dst, b, h) do { _Pragma("unroll") for (int n = 0; n < 2; ++n) _Pragma("unroll") for (int k = 0; k < 2; ++k) dst[n][k] = *(const LAS bf16x8*)(lds + PG8_SB(b, h) + boff + n * 2048 + k * 1024); } while (0)
#define PG8_MMA(ai, bj, At, Bt) do { __builtin_amdgcn_s_setprio(1); _Pragma("unroll") for (int m = 0; m < 4; ++m) _Pragma("unroll") for (int n = 0; n < 2; ++n) _Pragma("unroll") for (int k = 0; k < 2; ++k) \
        acc[ai][bj][m][n] = __builtin_amdgcn_mfma_f32_16x16x32_bf16(Bt[n][k], At[m][k], acc[ai][bj][m][n], 0, 0, 0); __builtin_amdgcn_s_setprio(0); } while (0)
#define PG8_WAIT_V(n) asm volatile("s_waitcnt vmcnt(" #n ")" ::: "memory")
#define PG8_WAIT_L(n) asm volatile("s_waitcnt lgkmcnt(" #n ")" ::: "memory")
#define PG8_BAR __builtin_amdgcn_s_barrier()
#define PG8_SCHED __builtin_amdgcn_sched_barrier(0)
    Unit cur, nxt; int ui = 0;
    if (!S.next(0, cur)) return;
    f32x4 acc[2][2][4][2];
#pragma unroll
    for (int a = 0; a < 2; ++a)
#pragma unroll
        for (int b = 0; b < 2; ++b)
#pragma unroll
            for (int m = 0; m < 4; ++m)
#pragma unroll
                for (int n = 0; n < 2; ++n) acc[a][b][m][n] = (f32x4){0.f, 0.f, 0.f, 0.f};
    bf16x8 At[4][2], B0[2][2], B1[2][2];
    const char* cA = (const char*)g.A + (size_t)cur.pm * tstepA + (size_t)cur.pn * g.a_pn_bytes; const char* cB = (const char*)g.Bt + (size_t)cur.pn * tstepB;
    PG8_STAGE(PG8_SB(0, 0), cB, voffB); PG8_STAGE(PG8_SA(0, 0), cA, voffA); PG8_STAGE(PG8_SB(0, 1), cB + hstepB, voffB); PG8_STAGE(PG8_SA(0, 1), cA + hstepA, voffA);
    if (wr == 1) PG8_BAR;
    PG8_WAIT_V(4); PG8_BAR;
    PG8_STAGE(PG8_SB(1, 0), cB + kstep, voffB); PG8_STAGE(PG8_SA(1, 0), cA + kstep, voffA); PG8_STAGE(PG8_SB(1, 1), cB + hstepB + kstep, voffB);
    PG8_WAIT_V(6); PG8_BAR;
    for (;;) {
        const bool has_next = S.next(ui + 1, nxt);
        const char* nA = has_next ? (const char*)g.A + (size_t)nxt.pm * tstepA + (size_t)nxt.pn * g.a_pn_bytes : cA; const char* nB = has_next ? (const char*)g.Bt + (size_t)nxt.pn * tstepB : cB;
#pragma unroll 1
        for (int t = 0; t < nt; t += 2) {
            const bool last = (t == nt - 2);
            const char* a1 = cA + (size_t)(t + 1) * kstep;
            const char* a2 = last ? nA : cA + (size_t)(t + 2) * kstep; const char* b2 = last ? nB : cB + (size_t)(t + 2) * kstep;
            const char* a3 = a2 + kstep; const char* b3 = b2 + kstep;
            PG8_LDB(B0, 0, 0); PG8_SCHED; PG8_LDA(At, 0, 0); PG8_STAGE(PG8_SA(1, 1), a1 + hstepA, voffA);
            PG8_WAIT_L(8); PG8_BAR; PG8_WAIT_L(0); PG8_MMA(0, 0, At, B0); PG8_BAR; PG8_SCHED;
            PG8_LDB(B1, 0, 1); PG8_STAGE(PG8_SB(0, 0), b2, voffB);
            PG8_BAR; PG8_WAIT_L(0); PG8_MMA(0, 1, At, B1); PG8_BAR;
            PG8_LDA(At, 0, 1); PG8_STAGE(PG8_SA(0, 0), a2, voffA);
            PG8_BAR; PG8_WAIT_L(0); PG8_MMA(1, 0, At, B0); PG8_BAR; PG8_SCHED;
            PG8_STAGE(PG8_SB(0, 1), b2 + hstepB, voffB);
            PG8_WAIT_V(6); PG8_BAR; PG8_MMA(1, 1, At, B1); PG8_BAR;
            PG8_LDB(B0, 1, 0); PG8_SCHED; PG8_LDA(At, 1, 0); PG8_STAGE(PG8_SA(0, 1), a2 + hstepA, voffA);
            PG8_WAIT_L(8); PG8_BAR; PG8_WAIT_L(0); PG8_MMA(0, 0, At, B0); PG8_BAR; PG8_SCHED;
            PG8_LDB(B1, 1, 1); PG8_STAGE(PG8_SB(1, 0), b3, voffB);
            PG8_BAR; PG8_WAIT_L(0); PG8_MMA(0, 1, At, B1); PG8_BAR;
            PG8_LDA(At, 1, 1); PG8_STAGE(PG8_SA(1, 0), a3, voffA);
            PG8_BAR; PG8_WAIT_L(0); PG8_MMA(1, 0, At, B0); PG8_BAR; PG8_SCHED;
            PG8_STAGE(PG8_SB(1, 1), b3 + hstepB, voffB);
            PG8_WAIT_V(6); PG8_BAR; PG8_MMA(1, 1, At, B1); PG8_BAR;
        }
        E(acc, cur, wr, wc, fr, fq);
        if (!has_next) break;
#pragma unroll
        for (int a = 0; a < 2; ++a)
#pragma unroll
            for (int b = 0; b < 2; ++b)
#pragma unroll
                for (int m = 0; m < 4; ++m)
#pragma unroll
                    for (int n = 0; n < 2; ++n) acc[a][b][m][n] = (f32x4){0.f, 0.f, 0.f, 0.f};
        cur = nxt; cA = nA; cB = nB; ++ui;
    }
    PG8_WAIT_V(0);
    if (wr == 0) PG8_BAR;
    PG8_BAR;
#undef PG8_SA
#undef PG8_SB
#undef PG8_STAGE
#undef PG8_LDA
#undef PG8_LDB
#undef PG8_MMA
#undef PG8_WAIT_V
#undef PG8_WAIT_L
#undef PG8_BAR
#undef PG8_SCHED
}
}
using pg8::Unit;

DI float row_rstd(const float* ss, int row) {
    const f32x4* p = (const f32x4*)(ss + (size_t)row * 16);
    f32x4 a = p[0], b = p[1], c = p[2], d = p[3];
    const float s = ((a.x + a.y) + (a.z + a.w)) + ((b.x + b.y) + (b.z + b.w)) + ((c.x + c.y) + (c.z + c.w)) + ((d.x + d.y) + (d.z + d.w));
    return __builtin_amdgcn_rsqf(s * (1.0f / 1024.0f) + EPS);
}

template <bool HAS_SCALE, bool IN_F32>
struct EpiRes {
    const float* xin_p; const float* xin_s; bf16_t* X; const float* colscale; float* ss;
    DI void operator()(const f32x4 (&acc)[2][2][4][2], const Unit& u, int wr, int wc, int fr, int fq) const {
        const int col0 = u.pn * 256 + wc * 32 + 8 * fq;
        float sq[2][4];
#pragma unroll
        for (int ai = 0; ai < 2; ++ai)
#pragma unroll
            for (int m = 0; m < 4; ++m) sq[ai][m] = 0.f;
#pragma unroll
        for (int bj = 0; bj < 2; ++bj) {
            const int col = col0 + bj * 128;
            f32x4 sc0, sc1;
            if (HAS_SCALE) { sc0 = *(const f32x4*)(colscale + col); sc1 = *(const f32x4*)(colscale + col + 4); }
#pragma unroll
            for (int ai = 0; ai < 2; ++ai)
#pragma unroll
                for (int m = 0; m < 4; ++m) {
                    const int row = u.pm * 256 + ai * 128 + wr * 64 + m * 16 + fr;
                    bf16_t* xb = X + (size_t)row * D + col;
                    f32x4 x0, x1;
                    if (IN_F32) {
                        const float* xr = (row < NP) ? xin_p + (size_t)row * D : xin_s + (size_t)(row - NP) * D;
                        x0 = *(const f32x4*)(xr + col); x1 = *(const f32x4*)(xr + col + 4);
                    } else {
                        const u32x4 h = *(const u32x4*)xb;
                        x0 = (f32x4){__uint_as_float(h.x << 16), __uint_as_float(h.x & 0xffff0000u), __uint_as_float(h.y << 16), __uint_as_float(h.y & 0xffff0000u)};
                        x1 = (f32x4){__uint_as_float(h.z << 16), __uint_as_float(h.z & 0xffff0000u), __uint_as_float(h.w << 16), __uint_as_float(h.w & 0xffff0000u)};
                    }
                    f32x4 y0 = acc[ai][bj][m][0], y1 = acc[ai][bj][m][1];
                    if (HAS_SCALE) { y0 = y0 * sc0; y1 = y1 * sc1; }
                    x0 = x0 + y0; x1 = x1 + y1;
                    sq[ai][m] += (x0.x * x0.x + x0.y * x0.y) + (x0.z * x0.z + x0.w * x0.w) + (x1.x * x1.x + x1.y * x1.y) + (x1.z * x1.z + x1.w * x1.w);
                    u32x4 o; o.x = pk2(x0.x, x0.y); o.y = pk2(x0.z, x0.w); o.z = pk2(x1.x, x1.y); o.w = pk2(x1.z, x1.w);
                    *(u32x4*)xb = o;
                }
        }
#pragma unroll
        for (int ai = 0; ai < 2; ++ai)
#pragma unroll
            for (int m = 0; m < 4; ++m) {
                const int row = u.pm * 256 + ai * 128 + wr * 64 + m * 16 + fr;
                float q = sq[ai][m];
                q += __shfl_xor(q, 16); q += __shfl_xor(q, 32);
                if (fq == 0) ss[(size_t)row * 16 + u.pn * 4 + wc] = q;
            }
    }
};

struct EpiUp {
    const float* ss; bf16_t* U;
    DI void operator()(const f32x4 (&acc)[2][2][4][2], const Unit& u, int wr, int wc, int fr, int fq) const {
        const int col0 = u.pn * 256 + wc * 32 + 8 * fq;
#pragma unroll
        for (int ai = 0; ai < 2; ++ai)
#pragma unroll
            for (int m = 0; m < 4; ++m) {
                const int row = u.pm * 256 + ai * 128 + wr * 64 + m * 16 + fr;
                const float rstd = row_rstd(ss, row);
#pragma unroll
                for (int bj = 0; bj < 2; ++bj) {
                    f32x4 v0 = acc[ai][bj][m][0] * rstd, v1 = acc[ai][bj][m][1] * rstd;
                    float e[8] = {v0.x, v0.y, v0.z, v0.w, v1.x, v1.y, v1.z, v1.w};
#pragma unroll
                    for (int i = 0; i < 8; ++i) { const float r = fmaxf(e[i], 0.f); e[i] = r * r; }
                    u32x4 o; o.x = pk2(e[0], e[1]); o.y = pk2(e[2], e[3]); o.z = pk2(e[4], e[5]); o.w = pk2(e[6], e[7]);
                    *(u32x4*)(U + (size_t)row * DFF + col0 + bj * 128) = o;
                }
            }
    }
};

struct EpiWin {
    const float* ss; const float* rope;
    bf16_t *Q, *QI, *KP, *VTP, *KIP, *KS, *VTS, *KIS; float* WI; float* out;
    DI void operator()(const f32x4 (&acc)[2][2][4][2], const Unit& u, int wr, int wc, int fr, int fq) const {
        const int q8 = (wc & 1) * 4 + fq;
        const bool smp = u.pm >= 256;
#pragma unroll
        for (int ai = 0; ai < 2; ++ai)
#pragma unroll
            for (int m = 0; m < 4; ++m) {
                const int row = u.pm * 256 + ai * 128 + wr * 64 + m * 16 + fr;
                const float rstd = row_rstd(ss, row);
                int b, pos, L; size_t rl;
                if (smp) { const int rs = row - NP; b = rs >> 6; pos = 2048 + (rs & 63); L = LS; rl = rs; } else { b = row >> 11; pos = row & 2047; L = 2048; rl = row; }
                const f32x4 cs0 = *(const f32x4*)(rope + ((size_t)pos * 32 + 4 * q8) * 2), cs1 = *(const f32x4*)(rope + ((size_t)pos * 32 + 4 * q8) * 2 + 4);
                const float cc[4] = {cs0.x, cs0.z, cs1.x, cs1.z}, sn[4] = {cs0.y, cs0.w, cs1.y, cs1.w};
#pragma unroll
                for (int bj = 0; bj < 2; ++bj) {
                    const int blk = u.pn * 4 + bj * 2 + (wc >> 1);
                    const f32x4 v0 = acc[ai][bj][m][0] * rstd, v1 = acc[ai][bj][m][1] * rstd;
                    const float a0[4] = {v0.x, v0.y, v0.z, v0.w}, a1[4] = {v1.x, v1.y, v1.z, v1.w};
                    float r1[4], r2[4];
#pragma unroll
                    for (int i = 0; i < 4; ++i) { r1[i] = a0[i] * cc[i] - a1[i] * sn[i]; r2[i] = a1[i] * cc[i] + a0[i] * sn[i]; }
                    if (blk < 16) {
                        bf16_t* p = Q + (size_t)row * 1024 + blk * 64 + 4 * q8;
                        u32x2 lo = {pk2(r1[0] * 0.125f, r1[1] * 0.125f), pk2(r1[2] * 0.125f, r1[3] * 0.125f)}, hi = {pk2(r2[0] * 0.125f, r2[1] * 0.125f), pk2(r2[2] * 0.125f, r2[3] * 0.125f)};
                        *(u32x2*)p = lo; *(u32x2*)(p + 32) = hi;
                    } else if (blk < 20) {
                        const int g = blk - 16;
                        float* po = out + (smp ? O_KS : O_KP) + rl * 256 + g * 64 + 4 * q8;
                        *(f32x4*)po = (f32x4){r1[0], r1[1], r1[2], r1[3]}; *(f32x4*)(po + 32) = (f32x4){r2[0], r2[1], r2[2], r2[3]};
                        bf16_t* p = (smp ? KS : KP) + (((size_t)b * 4 + g) * L + pos) * 64 + 4 * q8;
                        u32x2 lo = {pk2(r1[0], r1[1]), pk2(r1[2], r1[3])}, hi = {pk2(r2[0], r2[1]), pk2(r2[2], r2[3])};
                        *(u32x2*)p = lo; *(u32x2*)(p + 32) = hi;
                    } else if (blk < 24) {
                        const int g = blk - 20;
                        float* po = out + (smp ? O_VS : O_VP) + rl * 256 + g * 64 + 8 * q8;
                        *(f32x4*)po = v0; *(f32x4*)(po + 4) = v1;
                        bf16_t* p = (smp ? VTS : VTP) + (((size_t)b * 4 + g) * 64 + 8 * q8) * L + pos;
                        const unsigned w0 = pk2(a0[0], a0[1]), w1 = pk2(a0[2], a0[3]), w2 = pk2(a1[0], a1[1]), w3 = pk2(a1[2], a1[3]);
                        p[0] = (bf16_t)w0; p[(size_t)L] = (bf16_t)(w0 >> 16); p[(size_t)2 * L] = (bf16_t)w1; p[(size_t)3 * L] = (bf16_t)(w1 >> 16);
                        p[(size_t)4 * L] = (bf16_t)w2; p[(size_t)5 * L] = (bf16_t)(w2 >> 16); p[(size_t)6 * L] = (bf16_t)w3; p[(size_t)7 * L] = (bf16_t)(w3 >> 16);
                    } else if (blk < 32) {
                        bf16_t* p = QI + (size_t)row * 512 + (blk - 24) * 64 + 4 * q8;
                        u32x2 lo = {pk2(r1[0] * 0.125f, r1[1] * 0.125f), pk2(r1[2] * 0.125f, r1[3] * 0.125f)}, hi = {pk2(r2[0] * 0.125f, r2[1] * 0.125f), pk2(r2[2] * 0.125f, r2[3] * 0.125f)};
                        *(u32x2*)p = lo; *(u32x2*)(p + 32) = hi;
                    } else if (blk == 32) {
                        float* po = out + (smp ? O_KIS : O_KIP) + rl * 64 + 4 * q8;
                        *(f32x4*)po = (f32x4){r1[0], r1[1], r1[2], r1[3]}; *(f32x4*)(po + 32) = (f32x4){r2[0], r2[1], r2[2], r2[3]};
                        bf16_t* p = (smp ? KIS : KIP) + ((size_t)b * L + pos) * 64 + 4 * q8;
                        u32x2 lo = {pk2(r1[0], r1[1]), pk2(r1[2], r1[3])}, hi = {pk2(r2[0], r2[1]), pk2(r2[2], r2[3])};
                        *(u32x2*)p = lo; *(u32x2*)(p + 32) = hi;
                    } else if (blk == 33 && q8 == 0) {
                        const float s = 0.35355339059327373f;
                        float* p = WI + (size_t)row * 8;
                        *(f32x4*)p = v0 * s; *(f32x4*)(p + 4) = v1 * s;
                    }
                }
            }
    }
};

DI int win_rowmap(int n) {
    const bool roped = (n < 1280) || (n >= 1536 && n < 2112);
    if (!roped) return n;
    const int j = n & 63, base = n & ~63;
    return base + (j < 32 ? 8 * (j >> 2) + (j & 3) : 8 * ((j - 32) >> 2) + 4 + (j & 3));
}
template <bool WINMAP>
DI void transpose_item(const float* W, int K, int N, bf16_t* WT, LAS float* scr, int item, int lane, const float* gk = nullptr) {
    const int nblk = (N + 31) / 32, kb = item / nblk, nb = item % nblk, k0 = 64 * kb, n0 = 32 * nb;
    const int ncol = n0 + (lane & 31);
#pragma unroll 8
    for (int i = 0; i < 32; ++i) { const int kk = 2 * i + (lane >> 5); float v = (ncol < N) ? W[(size_t)(k0 + kk) * N + ncol] : 0.f; if (gk) v *= gk[k0 + kk]; scr[kk * 33 + (lane & 31)] = v; }
    asm volatile("s_waitcnt lgkmcnt(0)" ::: "memory");
    const int c = lane & 7;
#pragma unroll
    for (int j = 0; j < 4; ++j) {
        const int nl = (lane >> 3) + 8 * j, n = n0 + nl;
        const LAS float* s = scr + (8 * c) * 33 + nl;
        u32x4 o; o.x = pk2(s[0], s[33]); o.y = pk2(s[2 * 33], s[3 * 33]); o.z = pk2(s[4 * 33], s[5 * 33]); o.w = pk2(s[6 * 33], s[7 * 33]);
        if (n < N) { const int rowo = WINMAP ? win_rowmap(n) : n; *(u32x4*)(WT + (size_t)rowo * K + k0 + 8 * c) = o; }
    }
    asm volatile("s_waitcnt lgkmcnt(0)" ::: "memory");
}

DI void phase0(const Args& a, LAS unsigned char* lds, int part, int vb, int VG) {
    const int tid = threadIdx.x, wave = tid >> 6, lane = tid & 63, G = VG;
    LAS float* scr = (LAS float*)(lds + wave * 8448);
    unsigned char* ws = a.ws;
    const int gw = vb * 8 + wave, NGW = G * 8;
    const bool pa = part & 1, pb = part & 2, pc = part & 4;
    constexpr int I_POOL = 4 * 4 * 8, I_WIN = 16 * 67, I_WO = 16 * 32, I_UP = 16 * 128, I_DN = 64 * 32;
    constexpr int NITEMS = I_POOL + I_WIN + I_WO + 2 * I_UP + 2 * I_DN;
    for (int it = gw; it < NITEMS; it += NGW) {
        int r = it;
        if (r < I_POOL) { if (!pa) continue; const int g = r >> 5; transpose_item<false>(a.in[9] + (size_t)g * 65536, 256, 256, (bf16_t*)(ws + WS_WPOOL) + (size_t)g * 65536, scr, r & 31, lane); continue; } r -= I_POOL;
        if (r < I_WIN) { if (!pb) continue; transpose_item<true>(a.in[11], 1024, 2120, (bf16_t*)(ws + WS_WIN), scr, r, lane, a.in[6] + D); continue; } r -= I_WIN;
        if (r < I_WO) { if (!pb) continue; transpose_item<false>(a.in[12], 1024, 1024, (bf16_t*)(ws + WS_WO), scr, r, lane); continue; } r -= I_WO;
        if (r < 2 * I_UP) { const int l = r / I_UP; if (!(l ? pb : pc)) continue; transpose_item<false>(a.in[13] + (size_t)l * 4194304, 1024, 4096, (bf16_t*)(ws + (l ? WS_WUP1 : WS_WUP0)), scr, r % I_UP, lane, a.in[7] + (size_t)l * D); continue; } r -= 2 * I_UP;
        { const int l = r / I_DN; if (!(l ? pb : pc)) continue; transpose_item<false>(a.in[14] + (size_t)l * 4194304, 4096, 1024, (bf16_t*)(ws + (l ? WS_WDN1 : WS_WDN0)), scr, r % I_DN, lane); }
    }
    if (!pb) return;
    const int gt = vb * 512 + tid, NGT = G * 512;
    { u32x4* z = (u32x4*)((bf16_t*)(ws + WS_WIN) + (size_t)2120 * 1024); const int n16 = (NWIN - 2120) * 1024 * 2 / 16;
      for (int i = gt; i < n16; i += NGT) z[i] = (u32x4){0u, 0u, 0u, 0u}; }
    { float* rt = (float*)(ws + WS_ROPE);
      for (int i = gt; i < LS * 32; i += NGT) {
          const int pos = i >> 5, f = i & 31;
          double inv = 1.0; for (int k = 0; k < f; ++k) inv *= 0.7498942093324559;
          double rev = (double)pos * inv * 0.15915494309189535; rev -= __builtin_rint(rev);
          const float fr = (float)rev;
          rt[2 * i] = __builtin_amdgcn_cosf(fr); rt[2 * i + 1] = __builtin_amdgcn_sinf(fr);
      } }
    { const float* src = a.in[5]; bf16_t* dst = (bf16_t*)(ws + WS_KIS);
      for (int i = gt; i < 16 * 2048 * 8; i += NGT) {
          const int b = i >> 14, s = (i >> 3) & 2047, d8 = i & 7;
          const f32x4 v0 = *(const f32x4*)(src + (size_t)i * 8), v1 = *(const f32x4*)(src + (size_t)i * 8 + 4);
          u32x4 o = {pk2(v0.x, v0.y), pk2(v0.z, v0.w), pk2(v1.x, v1.y), pk2(v1.z, v1.w)};
          *(u32x4*)(dst + ((size_t)b * LS + s) * 64 + d8 * 8) = o;
      } }
    { const float* src = a.in[3]; bf16_t* dst = (bf16_t*)(ws + WS_KS);
      for (int i = gt; i < 16 * 2048 * 4 * 8; i += NGT) {
          const int d8 = i & 7, g = (i >> 3) & 3, s = (i >> 5) & 2047, b = i >> 16;
          const f32x4 v0 = *(const f32x4*)(src + (size_t)i * 8), v1 = *(const f32x4*)(src + (size_t)i * 8 + 4);
          u32x4 o = {pk2(v0.x, v0.y), pk2(v0.z, v0.w), pk2(v1.x, v1.y), pk2(v1.z, v1.w)};
          *(u32x4*)(dst + (((size_t)b * 4 + g) * LS + s) * 64 + d8 * 8) = o;
      } }
    { const float* src = a.in[4]; bf16_t* dst = (bf16_t*)(ws + WS_VTS);
      for (int i = gt; i < 16 * 4 * 256 * 64; i += NGT) {
          const int d = i & 63, s8 = (i >> 6) & 255, g = (i >> 14) & 3, b = i >> 16;
          const float* p = src + (((size_t)b * 2048 + s8 * 8) * 4 + g) * 64 + d;
          float v[8];
#pragma unroll
          for (int j = 0; j < 8; ++j) v[j] = p[(size_t)j * 256];
          u32x4 o = {pk2(v[0], v[1]), pk2(v[2], v[3]), pk2(v[4], v[5]), pk2(v[6], v[7])};
          *(u32x4*)(dst + (((size_t)b * 4 + g) * 64 + d) * LS + s8 * 8) = o;
      } }
}

DI void phase1(const Args& a, LAS unsigned char* lds) {
    const int tid = threadIdx.x, half = tid >> 8, ht = tid & 255, wv = ht >> 6, lane = tid & 63, G = gridDim.x;
    LAS float* rs = (LAS float*)(lds) + half * 64;
    const float* gmix = a.in[6];
    bf16_t* Dout = (bf16_t*)(a.ws + WS_HA);
    const int c = 4 * ht;
    const f32x4 gq = *(const f32x4*)(gmix + c);
    const int win = 2 << wv;
    for (int base = blockIdx.x * 2; base < 2080; base += 2 * G) {
        const int it = base + half;
        const bool smp = it >= 2048;
        int b, t0, T; const float* xs; size_t rowbase;
        if (smp) { b = (it - 2048) >> 1; t0 = ((it - 2048) & 1) * 32; T = TS; xs = a.in[1] + (size_t)b * TS * D; rowbase = (size_t)NP + b * TS; }
        else { b = it >> 6; t0 = (it & 63) * 32; T = TP; xs = a.in[0] + (size_t)b * TP * D; rowbase = (size_t)b * TP; }
        const float* past = a.in[2] + (size_t)b * 15 * D;
        __syncthreads();
        for (int i = wv; i < 47; i += 4) {
            const int t = t0 + i - 15;
            if (t >= 0) {
                const f32x4* xr = (const f32x4*)(xs + (size_t)t * D) + lane;
                float s = 0.f;
#pragma unroll
                for (int j = 0; j < 4; ++j) { const f32x4 v = xr[64 * j]; s += (v.x * v.x + v.y * v.y) + (v.z * v.z + v.w * v.w); }
#pragma unroll
                for (int o = 1; o < 64; o <<= 1) s += __shfl_xor(s, o);
                if (lane == 0) rs[i] = __builtin_amdgcn_rsqf(s * (1.0f / 1024.0f) + EPS);
            }
        }
        __syncthreads();
        auto hrow = [&](int r) -> f32x4 {
            const int t = t0 + r;
            if (t < 0) { if (smp) return *(const f32x4*)(past + (size_t)(15 + t) * D + c); return (f32x4){0.f, 0.f, 0.f, 0.f}; }
            const f32x4 v = *(const f32x4*)(xs + (size_t)t * D + c);
            return v * rs[r + 15] * gq;
        };
        f32x4 S = {0.f, 0.f, 0.f, 0.f};
        for (int j = 1; j < win; ++j) S = S + hrow(-j);
        float* pout = a.out + (smp ? O_POOLS : O_POOLP) + (size_t)b * 15 * D + c;
#pragma unroll 4
        for (int r = 0; r < 32; ++r) {
            const f32x4 hv = hrow(r);
            S = S + hv;
            const int t = t0 + r;
            const int cnt = smp ? win : (t + 1 < win ? t + 1 : win);
            const float inv = 1.0f / (float)cnt;
            const f32x4 dv = S * inv - hv;
            u32x2 o = {pk2(dv.x, dv.y), pk2(dv.z, dv.w)};
            *(u32x2*)(Dout + (rowbase + t) * D + c) = o;
            if (t >= T - 15) *(f32x4*)(pout + (size_t)(t - (T - 15)) * D) = hv;
            S = S - hrow(r - win + 1);
        }
    }
}

DI unsigned fkey(float s) { s = s + 0.0f; const unsigned u = __float_as_uint(s); return (u & 0x80000000u) ? ~u : (u | 0x80000000u); }
DI unsigned row16_sum(unsigned v) {
    v += (unsigned)__builtin_amdgcn_update_dpp(0, (int)v, 0xB1, 0xf, 0xf, false);
    v += (unsigned)__builtin_amdgcn_update_dpp(0, (int)v, 0x4E, 0xf, 0xf, false);
    v += (unsigned)__builtin_amdgcn_update_dpp(0, (int)v, 0x124, 0xf, 0xf, false);
    v += (unsigned)__builtin_amdgcn_update_dpp(0, (int)v, 0x128, 0xf, 0xf, false);
    return v;
}
DI unsigned row16_max(unsigned v) {
    v = max(v, (unsigned)__builtin_amdgcn_update_dpp(0, (int)v, 0xB1, 0xf, 0xf, false));
    v = max(v, (unsigned)__builtin_amdgcn_update_dpp(0, (int)v, 0x4E, 0xf, 0xf, false));
    v = max(v, (unsigned)__builtin_amdgcn_update_dpp(0, (int)v, 0x124, 0xf, 0xf, false));
    v = max(v, (unsigned)__builtin_amdgcn_update_dpp(0, (int)v, 0x128, 0xf, 0xf, false));
    return v;
}
DI float unkey(unsigned k) { return __uint_as_float((k & 0x80000000u) ? (k & 0x7fffffffu) : ~k); }
DI unsigned count_ge(const unsigned (&kk)[66], unsigned c) {
    unsigned cnt = 0u;
#pragma unroll
    for (int t = 0; t < 66; ++t) asm volatile("v_cmp_ge_u32 vcc, %1, %2\n\tv_addc_co_u32 %0, vcc, 0, %0, vcc" : "+v"(cnt) : "v"(kk[t]), "v"(c) : "vcc");
    return cnt;
}
DI void select_write(const unsigned (&kk)[66], int nk, int hf, int j32, unsigned* mr) {
    unsigned mxk = 0u, mnk = 0xffffffffu;
#pragma unroll
    for (int t = 0; t < 66; ++t) { mxk = max(mxk, kk[t]); mnk = min(mnk, kk[t] - 1u); }
    mxk = row16_max(mxk); mnk = ~row16_max(~mnk);
    { const unsigned m0 = max((unsigned)__builtin_amdgcn_readlane((int)mxk, 0), (unsigned)__builtin_amdgcn_readlane((int)mxk, 16));
      const unsigned m1 = max((unsigned)__builtin_amdgcn_readlane((int)mxk, 32), (unsigned)__builtin_amdgcn_readlane((int)mxk, 48));
      mxk = hf ? m1 : m0;
      const unsigned n0 = min((unsigned)__builtin_amdgcn_readlane((int)mnk, 0), (unsigned)__builtin_amdgcn_readlane((int)mnk, 16));
      const unsigned n1 = min((unsigned)__builtin_amdgcn_readlane((int)mnk, 32), (unsigned)__builtin_amdgcn_readlane((int)mnk, 48));
      mnk = (hf ? n1 : n0) + 1u; }
    unsigned lo = mnk, hi = mxk + 1u;
    unsigned tau = 0u, thr = 0u; bool done = false;
    for (int it = 0; it < 80; ++it) {
        const unsigned span = hi - lo;
        unsigned c = (it < 16) ? fkey(0.5f * unkey(lo) + 0.5f * unkey(hi - 1u)) : lo + (span >> 1);
        c = max(c, lo + 1u); c = min(c, hi - 1u);
        if (done || span < 2u) c = lo;
        unsigned cnt = row16_sum(count_ge(kk, c));
        const unsigned nlo = (unsigned)__builtin_amdgcn_readlane((int)cnt, 0) + (unsigned)__builtin_amdgcn_readlane((int)cnt, 16);
        const unsigned nhi = (unsigned)__builtin_amdgcn_readlane((int)cnt, 32) + (unsigned)__builtin_amdgcn_readlane((int)cnt, 48);
        const unsigned n = hf ? nhi : nlo;
        if (!done) {
            if (span < 2u) { done = true; tau = lo; thr = 0u; }
            else if (n == 256u) { done = true; thr = c; tau = c; }
            else if (n > 256u) lo = c;
            else hi = c;
        }
        if (__ballot(!done) == 0ull) break;
    }
    done = thr != 0u;
    unsigned w[3] = {0u, 0u, 0u};
    if (__ballot(!done) == 0ull) {
#pragma unroll
        for (int t = 0; t < 66; ++t) {
            const unsigned long long bs = __ballot(kk[t] >= thr);
            const unsigned sw = hf ? (unsigned)(bs >> 32) : (unsigned)bs;
            if (j32 == (t & 31)) w[t >> 5] = sw;
        }
    } else {
        unsigned glo = 0u, ghi = 0u;
#pragma unroll
        for (int t = 0; t < 66; ++t) { const unsigned long long b = __ballot(kk[t] > tau); glo += __popc((unsigned)b); ghi += __popc((unsigned)(b >> 32)); }
        const unsigned r0 = 256u - (hf ? ghi : glo);
        unsigned tk = 0u;
        const unsigned below_mask = (1u << j32) - 1u;
#pragma unroll
        for (int t = 0; t < 66; ++t) {
            if (t < nk) {
                const bool eq = kk[t] == tau;
                const unsigned long long be = __ballot(eq);
                const unsigned e = hf ? (unsigned)(be >> 32) : (unsigned)be;
                const bool take = eq && (tk + __popc(e & below_mask) < r0);
                tk += __popc(e);
                const unsigned long long bs = __ballot((kk[t] > tau) || take);
                const unsigned sw = hf ? (unsigned)(bs >> 32) : (unsigned)bs;
                if (j32 == (t & 31)) w[t >> 5] = sw;
            }
        }
    }
    mr[j32] = w[0]; mr[32 + j32] = w[1];
    if (j32 < 2) mr[64 + j32] = w[2];
}
DI void phase_index(const Args& a, LAS unsigned char* lds) {
    const int tid = threadIdx.x, wave = __builtin_amdgcn_readfirstlane(tid >> 6), lane = tid & 63, hf = lane >> 5, j32 = lane & 31, G = gridDim.x;
    const bf16_t* QI = (const bf16_t*)(a.ws + WS_QI); const float* WI = (const float*)(a.ws + WS_WI);
    unsigned* MASK = (unsigned*)(a.ws + WS_MASK);
    LAS unsigned* lk = (LAS unsigned*)(lds + wave * 16896) + lane;
    constexpr int NIT = 32 + 2048;
    for (int base = 0, rnd = 0; base < NIT; base += G, ++rnd) {
        const int idx = (rnd & 1) ? (G - 1 - (int)blockIdx.x) : (int)blockIdx.x;
        const int pos = base + idx;
        if (pos >= NIT) continue;
        int nkt, rowbase; const bf16_t* KI;
        if (pos < 32) { const int b = pos >> 1; nkt = 66; rowbase = NP + b * 64 + (pos & 1) * 32; KI = (const bf16_t*)(a.ws + WS_KIS) + (size_t)b * LS * 64; }
        else { const int p = pos - 32, c = 31 - (p >> 6), b = (p & 63) >> 1; nkt = 2 * (c + 1); rowbase = b * 2048 + c * 64 + (p & 1) * 32; KI = (const bf16_t*)(a.ws + WS_KIP) + (size_t)b * 2048 * 64; }
        const int row0 = rowbase + wave * 4;
        unsigned* mr0 = MASK + (size_t)(row0 + hf) * MASKW; unsigned* mr1 = MASK + (size_t)(row0 + 2 + hf) * MASKW;
        if (nkt <= 8) {
            const unsigned w = (j32 < nkt) ? 0xffffffffu : 0u;
            mr0[j32] = w; mr0[32 + j32] = 0u; mr1[j32] = w; mr1[32 + j32] = 0u;
            if (j32 < 2) { mr0[64 + j32] = 0u; mr1[64 + j32] = 0u; }
            continue;
        }
        int nk = nkt; asm volatile("" : "+s"(nk));
        const int qq = 2 * (j32 >> 4) + ((j32 >> 2) & 1), hh = 4 * ((j32 >> 3) & 1) + (j32 & 3);
        bf16x8 aq[4];
        { const bf16_t* p = QI + (size_t)(row0 + qq) * 512 + hh * 64 + 8 * hf;
#pragma unroll
          for (int jj = 0; jj < 4; ++jj) aq[jj] = *(const bf16x8*)(p + 16 * jj); }
        float wv0[8], wv1[8];
        { const float* p0 = WI + (size_t)(row0 + hf) * 8; const float* p1 = WI + (size_t)(row0 + 2 + hf) * 8;
          const f32x4 x0 = *(const f32x4*)p0, x1 = *(const f32x4*)(p0 + 4), y0 = *(const f32x4*)p1, y1 = *(const f32x4*)(p1 + 4);
          wv0[0] = x0.x; wv0[1] = x0.y; wv0[2] = x0.z; wv0[3] = x0.w; wv0[4] = x1.x; wv0[5] = x1.y; wv0[6] = x1.z; wv0[7] = x1.w;
          wv1[0] = y0.x; wv1[1] = y0.y; wv1[2] = y0.z; wv1[3] = y0.w; wv1[4] = y1.x; wv1[5] = y1.y; wv1[6] = y1.z; wv1[7] = y1.w; }
        const char* kbase = (const char*)KI;
        const unsigned koff = (unsigned)(j32 * 64 + 8 * hf) * 2u;
        unsigned kk[66];
#pragma unroll
        for (int g = 0; g < 17; ++g) {
#pragma unroll
            for (int u = 0; u < 4; ++u) if (4 * g + u < 66) kk[4 * g + u] = 0u;
            if (4 * g < nk) {
                bf16x8 bt[4][4];
#pragma unroll
                for (int u = 0; u < 4; ++u) { const int tt = (4 * g + u < nk) ? 4 * g + u : nk - 1; const char* p = kbase + (size_t)tt * 4096 + koff;
#pragma unroll
                    for (int jj = 0; jj < 4; ++jj) bt[u][jj] = *(const bf16x8*)(p + 32 * jj); }
#pragma unroll
                for (int u = 0; u < 4; ++u) {
                    const int t = 4 * g + u;
                    if (t < 66) {
                        f32x16 acc;
#pragma unroll
                        for (int i = 0; i < 16; ++i) acc[i] = 0.f;
#pragma unroll
                        for (int jj = 0; jj < 4; ++jj) acc = __builtin_amdgcn_mfma_f32_32x32x16_bf16(aq[jj], bt[u][jj], acc, 0, 0, 0);
                        float s0 = 0.f, s1 = 0.f;
#pragma unroll
                        for (int i = 0; i < 8; ++i) {
                            s0 = __builtin_fmaf(__int_as_float(max(__float_as_int(acc[i]), 0)), wv0[i], s0);
                            s1 = __builtin_fmaf(__int_as_float(max(__float_as_int(acc[8 + i]), 0)), wv1[i], s1);
                        }
                        const bool live = t < nk;
                        kk[t] = live ? fkey(s0) : 0u;
                        lk[t * 64] = live ? fkey(s1) : 0u;
                    }
                }
            } else {
#pragma unroll
                for (int u = 0; u < 4; ++u) if (4 * g + u < 66) lk[(4 * g + u) * 64] = 0u;
            }
            __builtin_amdgcn_sched_barrier(0);
        }
        select_write(kk, nk, hf, j32, mr0);
#pragma unroll
        for (int t = 0; t < 66; ++t) kk[t] = lk[t * 64];
        select_write(kk, nk, hf, j32, mr1);
    }
}

DI void phase_attn(const Args& a, LAS unsigned char* lds) {
    const int tid = threadIdx.x, wave = __builtin_amdgcn_readfirstlane(tid >> 6), lane = tid & 63, hf = lane >> 5, j32 = lane & 31, G = gridDim.x;
    const bf16_t* Q = (const bf16_t*)(a.ws + WS_Q);
    const unsigned* MASK = (const unsigned*)(a.ws + WS_MASK);
    bf16_t* O = (bf16_t*)(a.ws + WS_HA);
    constexpr int NIT = 64 + 4096;
    constexpr float LOG2E = 1.4426950408889634f;
    constexpr int RS = 144, RSV = 528, KREG = 256 * RS, BUFB = KREG + 64 * RSV;
    const int th = wave >> 2, hd = wave & 3;
    const int pik = (j32 & 0x13) | ((j32 & 8) >> 1) | ((j32 & 4) << 1);
    const bf16x8 ones = {0x3f80, 0x3f80, 0x3f80, 0x3f80, 0x3f80, 0x3f80, 0x3f80, 0x3f80};
    const unsigned kread = (unsigned)(pik * RS + 16 * hf), vread = (unsigned)(KREG + j32 * RSV + 16 * hf);
    for (int base = 0, rnd = 0; base < NIT; base += G, ++rnd) {
        const int idx = (rnd & 1) ? (G - 1 - (int)blockIdx.x) : (int)blockIdx.x;
        const int pos = base + idx;
        if (pos >= NIT) continue;
        int nst, rowbase, L, g; const bf16_t *Kb, *Vt;
        if (pos < 64) { const int b = pos >> 2; g = pos & 3; nst = 33; L = LS; rowbase = NP + b * 64;
            Kb = (const bf16_t*)(a.ws + WS_KS) + ((size_t)b * 4 + g) * LS * 64; Vt = (const bf16_t*)(a.ws + WS_VTS) + ((size_t)b * 4 + g) * 64 * LS; }
        else { const int p = pos - 64, c = 31 - (p >> 7), b = (p & 127) >> 2; g = p & 3; nst = c + 1; L = 2048; rowbase = b * 2048 + c * 64;
            Kb = (const bf16_t*)(a.ws + WS_KP) + ((size_t)b * 4 + g) * 2048 * 64; Vt = (const bf16_t*)(a.ws + WS_VTP) + ((size_t)b * 4 + g) * 64 * 2048; }
        const int nbig = (nst + 3) >> 2;
        const int row = rowbase + th * 32 + j32, head = 4 * g + hd;
        bf16x8 qf[4];
        { const bf16_t* p = Q + (size_t)row * 1024 + head * 64 + 8 * hf;
#pragma unroll
          for (int jj = 0; jj < 4; ++jj) qf[jj] = *(const bf16x8*)(p + 16 * jj); }
        const unsigned* mrow = MASK + (size_t)row * MASKW;
        u32x4 kr[4], vr[4];
        auto stage_load = [&](int bs) __attribute__((always_inline)) {
#pragma unroll
            for (int i = 0; i < 4; ++i) {
                const int cid = tid + 512 * i;
                int kr_row = bs * 256 + (cid >> 3); kr_row = kr_row < L ? kr_row : L - 1;
                kr[i] = *(const u32x4*)(Kb + (size_t)kr_row * 64 + (cid & 7) * 8);
                int vcol = bs * 256 + (cid & 31) * 8; vcol = vcol < L - 8 ? vcol : L - 8;
                vr[i] = *(const u32x4*)(Vt + (size_t)(cid >> 5) * L + vcol);
            }
        };
        auto stage_store = [&](LAS unsigned char* buf) __attribute__((always_inline)) {
#pragma unroll
            for (int i = 0; i < 4; ++i) {
                const int cid = tid + 512 * i;
                *(LAS u32x4*)(buf + (cid >> 3) * RS + (cid & 7) * 16) = kr[i];
                *(LAS u32x4*)(buf + KREG + (cid >> 5) * RSV + (cid & 31) * 16) = vr[i];
            }
        };
        stage_load(0);
        f32x16 o0, o1, lacc;
#pragma unroll
        for (int i = 0; i < 16; ++i) { o0[i] = 0.f; o1[i] = 0.f; lacc[i] = 0.f; }
        float mrun = -1e30f;
        u32x4 mwa = *(const u32x4*)mrow, mwb = *(const u32x4*)(mrow + 4);
        __syncthreads();
        stage_store(lds);
        __syncthreads();
        for (int bs = 0; bs < nbig; ++bs) {
            LAS unsigned char* cur = lds + (bs & 1) * BUFB;
            const bool more = bs + 1 < nbig;
            if (more) stage_load(bs + 1);
            const unsigned mw8[8] = {mwa.x, mwa.y, mwa.z, mwa.w, mwb.x, mwb.y, mwb.z, mwb.w};
            if (more) { mwa = *(const u32x4*)(mrow + 8 * (bs + 1)); mwb = *(const u32x4*)(mrow + 8 * (bs + 1) + 4); }
            const int nv = (nst - 4 * bs) < 4 ? (nst - 4 * bs) : 4;
#pragma unroll
            for (int j = 0; j < 4; ++j) {
                if (j < nv) {
                    f32x16 sc[2];
#pragma unroll
                    for (int tt = 0; tt < 2; ++tt) {
#pragma unroll
                        for (int i = 0; i < 16; ++i) sc[tt][i] = 0.f;
#pragma unroll
                        for (int jj = 0; jj < 4; ++jj) {
                            const bf16x8 kf = *(const LAS bf16x8*)(cur + kread + (j * 64 + tt * 32) * RS + 32 * jj);
                            sc[tt] = __builtin_amdgcn_mfma_f32_32x32x16_bf16(kf, qf[jj], sc[tt], 0, 0, 0);
                        }
                    }
                    float mx = __builtin_fmaxf(sc[0][0], sc[1][0]);
#pragma unroll
                    for (int i = 1; i < 16; ++i) mx = __builtin_fmaxf(__builtin_fmaxf(mx, sc[0][i]), sc[1][i]);
                    mx = xhalf_max(mx);
                    if (__ballot(mx > mrun + 8.0f) != 0ull) {
                        const float mnew = fmaxf(mrun, mx);
                        const float alpha = __builtin_amdgcn_exp2f((mrun - mnew) * LOG2E);
                        mrun = mnew;
#pragma unroll
                        for (int i = 0; i < 16; ++i) { o0[i] *= alpha; o1[i] *= alpha; lacc[i] *= alpha; }
                    }
                    const float nm = -mrun * LOG2E;
#pragma unroll
                    for (int tt = 0; tt < 2; ++tt) {
                        const unsigned mw = mw8[2 * j + tt] >> (8 * hf);
                        float p[16];
#pragma unroll
                        for (int i = 0; i < 16; ++i) {
                            const float e = __builtin_amdgcn_exp2f(__builtin_fmaf(sc[tt][i], LOG2E, nm));
                            const unsigned msk = (unsigned)__builtin_amdgcn_sbfe((int)mw, (i & 7) + 16 * (i >> 3), 1);
                            p[i] = __uint_as_float(__float_as_uint(e) & msk);
                        }
#pragma unroll
                        for (int s2 = 0; s2 < 2; ++s2) {
                            u32x4 pw = {pk2(p[8 * s2], p[8 * s2 + 1]), pk2(p[8 * s2 + 2], p[8 * s2 + 3]), pk2(p[8 * s2 + 4], p[8 * s2 + 5]), pk2(p[8 * s2 + 6], p[8 * s2 + 7])};
                            const bf16x8 pf = __builtin_bit_cast(bf16x8, pw);
                            const bf16x8 v0 = *(const LAS bf16x8*)(cur + vread + (j * 64 + tt * 32 + 16 * s2) * 2);
                            const bf16x8 v1 = *(const LAS bf16x8*)(cur + vread + 32 * RSV + (j * 64 + tt * 32 + 16 * s2) * 2);
                            o0 = __builtin_amdgcn_mfma_f32_32x32x16_bf16(v0, pf, o0, 0, 0, 0);
                            o1 = __builtin_amdgcn_mfma_f32_32x32x16_bf16(v1, pf, o1, 0, 0, 0);
                            lacc = __builtin_amdgcn_mfma_f32_32x32x16_bf16(ones, pf, lacc, 0, 0, 0);
                        }
                    }
                }
            }
            if (more) stage_store(lds + ((bs & 1) ^ 1) * BUFB);
            __syncthreads();
        }
        const float inv = 1.0f / lacc[0];
        bf16_t* op = O + (size_t)row * 1024 + head * 64 + 4 * hf;
#pragma unroll
        for (int q = 0; q < 4; ++q) {
            u32x2 x0 = {pk2(o0[4 * q] * inv, o0[4 * q + 1] * inv), pk2(o0[4 * q + 2] * inv, o0[4 * q + 3] * inv)};
            u32x2 x1 = {pk2(o1[4 * q] * inv, o1[4 * q + 1] * inv), pk2(o1[4 * q + 2] * inv, o1[4 * q + 3] * inv)};
            *(u32x2*)(op + 8 * q) = x0; *(u32x2*)(op + 32 + 8 * q) = x1;
        }
    }
}

DI void phase_final(const Args& a) {
    const int tid = threadIdx.x, wave = tid >> 6, lane = tid & 63, G = gridDim.x;
    const float* ss = (const float*)(a.ws + WS_SS1);
    const bf16_t* Xb = (const bf16_t*)(a.ws + WS_HB);
    const float* gf = a.in[8];
    f32x4 g0[2], g1[2];
#pragma unroll
    for (int j = 0; j < 2; ++j) { g0[j] = *(const f32x4*)(gf + (lane + 64 * j) * 8); g1[j] = *(const f32x4*)(gf + (lane + 64 * j) * 8 + 4); }
    for (int row = blockIdx.x * 8 + wave; row < NR; row += G * 8) {
        float s = ss[(size_t)row * 16 + (lane & 15)];
        s += __shfl_xor(s, 1); s += __shfl_xor(s, 2); s += __shfl_xor(s, 4); s += __shfl_xor(s, 8);
        const float rstd = __builtin_amdgcn_rsqf(s * (1.0f / 1024.0f) + EPS);
        const u32x4* hr = (const u32x4*)(Xb + (size_t)row * D) + lane;
        f32x4* yr = (f32x4*)(a.out + (size_t)row * D) + 2 * lane;
#pragma unroll
        for (int j = 0; j < 2; ++j) {
            const u32x4 h = hr[64 * j];
            f32x4 y0 = {__uint_as_float(h.x << 16), __uint_as_float(h.x & 0xffff0000u), __uint_as_float(h.y << 16), __uint_as_float(h.y & 0xffff0000u)};
            f32x4 y1 = {__uint_as_float(h.z << 16), __uint_as_float(h.z & 0xffff0000u), __uint_as_float(h.w << 16), __uint_as_float(h.w & 0xffff0000u)};
            yr[128 * j] = y0 * rstd * g0[j]; yr[128 * j + 1] = y1 * rstd * g1[j];
        }
    }
}

#define XB_TMO      128
#define XB_XCNT(j)  (256  + 64 * (j))
#define XB_XSUB(j)  (1280 + 64 * (j))
#define XB_XGEN(j)  (2304 + 64 * (j))
#define XB_TOP      3328
#define XB_TOPGEN   3392
#define XCD_BAR_WORDS 3456
#define XB_SPIN_CAP (1u << 20)
DI unsigned xb_ld(unsigned* p)              { return __hip_atomic_load(p, __ATOMIC_RELAXED, __HIP_MEMORY_SCOPE_AGENT); }
DI unsigned xb_add(unsigned* p, unsigned v) { return __hip_atomic_fetch_add(p, v, __ATOMIC_RELAXED, __HIP_MEMORY_SCOPE_AGENT); }
DI unsigned xb_xcc_id() { return (unsigned)__builtin_amdgcn_s_getreg((3 << 11) | 20) & 0xFu; }
#define XB_SPIN(cond, bar) do { unsigned _sp = 0; while (cond) { __builtin_amdgcn_s_sleep(1); \
    if ((++_sp & 255u) == 0u) { if (xb_ld(&(bar)[XB_TMO])) break; if (_sp > XB_SPIN_CAP) { atomicAdd(&(bar)[XB_TMO], 1u); break; } } } } while (0)
struct XcdBarrier { unsigned* bar; unsigned x; volatile LAS unsigned* st; };
DI XcdBarrier xcd_barrier_post(unsigned* bar, volatile LAS unsigned* st) {
    XcdBarrier b; b.bar = bar; b.x = xb_xcc_id(); b.st = st;
    if (threadIdx.x == 0) (void)xb_add(&bar[XB_XCNT(b.x)], 1u);
    return b;
}
DI void xcd_barrier_complete(unsigned* bar, unsigned x, unsigned& nloc, unsigned& nx) {
    const unsigned G = gridDim.x * gridDim.y * gridDim.z;
    unsigned sum, cnt, mine, sp = 0u;
    for (;;) {
        sum = 0u; cnt = 0u; mine = 0u;
#pragma unroll
        for (unsigned j = 0; j < 16; ++j) { const unsigned c = xb_ld(&bar[XB_XCNT(j)]); sum += c; cnt += (c > 0u) ? 1u : 0u; mine = (j == x) ? c : mine; }
        if (sum == G) break;
        __builtin_amdgcn_s_sleep(1);
        if ((++sp & 255u) == 0u) { if (xb_ld(&bar[XB_TMO])) break; if (sp > XB_SPIN_CAP) { atomicAdd(&bar[XB_TMO], 1u); break; } }
    }
    nloc = mine > 0u ? mine : 1u; nx = cnt > 0u ? cnt : 1u;
}
DI void xcd_barrier(const XcdBarrier& b) {
    asm volatile("s_waitcnt vmcnt(0)" ::: "memory");
    __syncthreads();
    if (threadIdx.x == 0) {
        unsigned* bar = b.bar;
        __builtin_amdgcn_s_waitcnt(0);
        unsigned nloc = b.st[0], nx = b.st[1];
        if (nloc == 0u) { xcd_barrier_complete(bar, b.x, nloc, nx); b.st[0] = nloc; b.st[1] = nx; }
        const unsigned old = xb_add(&bar[XB_XSUB(b.x)], 1u);
        const unsigned gen = old / nloc;
        if (old + 1u == (gen + 1u) * nloc) {
            __builtin_amdgcn_fence(__ATOMIC_RELEASE, "agent");
            asm volatile("s_waitcnt vmcnt(0)" ::: "memory");
            const unsigned og = xb_add(&bar[XB_TOP], 1u);
            const unsigned tg = og / nx;
            if (og + 1u == (tg + 1u) * nx) xb_add(&bar[XB_TOPGEN], 1u);
            else XB_SPIN(xb_ld(&bar[XB_TOPGEN]) == tg, bar);
            __builtin_amdgcn_fence(__ATOMIC_ACQUIRE, "agent");
            xb_add(&bar[XB_XGEN(b.x)], 1u);
            asm volatile("s_waitcnt vmcnt(0)" ::: "memory");
        } else {
            XB_SPIN(xb_ld(&bar[XB_XGEN(b.x)]) == gen, bar);
            __builtin_amdgcn_fence(__ATOMIC_ACQUIRE, "agent");
            asm volatile("s_waitcnt vmcnt(0)" ::: "memory");
        }
    }
    __syncthreads();
}

__global__ void __launch_bounds__(512, 2) fwd_kernel(Args a) {
    extern __shared__ __attribute__((aligned(16))) unsigned char lds_raw[];
    LAS unsigned char* lds = (LAS unsigned char*)lds_raw;
    cg::grid_group grid = cg::this_grid();
    volatile LAS unsigned* xst = (volatile LAS unsigned*)(lds + LDS_PHASE);
    if (threadIdx.x == 0) { xst[0] = 0u; xst[1] = 0u; }
    __syncthreads();
    const XcdBarrier xb = xcd_barrier_post((unsigned*)(a.ws + WS_BAR), xst);
    unsigned char* ws = a.ws;
    const int G = gridDim.x;
    pg8::StaticOrder S;
    float* ss0 = (float*)(ws + WS_SS0); float* ss1 = (float*)(ws + WS_SS1);
    bf16_t* HA = (bf16_t*)(ws + WS_HA); bf16_t* Xb = (bf16_t*)(ws + WS_HB); bf16_t* U = (bf16_t*)(ws + WS_U);
#ifndef PHMASK
#define PHMASK 0xfff
#endif
#ifndef PROBE_REP
#define PROBE_REP 0x0
#endif
#define PHASE(k) if (((PHMASK >> (k)) & 1) && (k) >= a.ph_lo && (k) < a.ph_hi)
#define SEAM(k) do { if ((k) >= a.ph_lo && (k) + 1 < a.ph_hi) xcd_barrier(xb); } while (0)
    const bool defer0 = (G == 256);
    PHASE(0) { phase0(a, lds, defer0 ? 1 : 7, blockIdx.x, G); phase1(a, lds); }
#if PROBE_REP & 0x1
    grid.sync(); phase0(a, lds, 7, blockIdx.x, G); phase1(a, lds);
#endif
    SEAM(0);
    PHASE(1) {
        pg8::Gemm g{HA, (const bf16_t*)(ws + WS_WPOOL), NR, 1024, 256, 1024, 256, 512};
        S.init(NR, 1024, G, blockIdx.x);
        EpiRes<true, true> E{a.in[0], a.in[1], Xb, a.in[10], ss0};
        pg8::gemm_phase(lds, g, S, E);
        if (defer0 && blockIdx.x >= 16) phase0(a, lds, 4, blockIdx.x - 16, 240);
    }
    SEAM(1);
    PHASE(2) {
        pg8::Gemm g{Xb, (const bf16_t*)(ws + WS_WUP0), NR, DFF, 1024, 1024, 1024, 0};
        S.init(NR, DFF, G, blockIdx.x);
        EpiUp E{ss0, U};
        pg8::gemm_phase(lds, g, S, E);
    }
    SEAM(2);
    PHASE(3) {
        pg8::Gemm g{U, (const bf16_t*)(ws + WS_WDN0), NR, 1024, DFF, DFF, DFF, 0};
        S.init(NR, 1024, G, blockIdx.x);
        EpiRes<false, false> E{nullptr, nullptr, Xb, nullptr, ss1};
        pg8::gemm_phase(lds, g, S, E);
        if (defer0 && blockIdx.x >= 16) phase0(a, lds, 2, blockIdx.x - 16, 240);
    }
    SEAM(3);
    PHASE(4) {
        pg8::Gemm g{Xb, (const bf16_t*)(ws + WS_WIN), NR, NWIN, 1024, 1024, 1024, 0};
        S.init(NR, NWIN, G, blockIdx.x);
        EpiWin E{ss1, (const float*)(ws + WS_ROPE), (bf16_t*)(ws + WS_Q), (bf16_t*)(ws + WS_QI), (bf16_t*)(ws + WS_KP), (bf16_t*)(ws + WS_VTP), (bf16_t*)(ws + WS_KIP),
                 (bf16_t*)(ws + WS_KS), (bf16_t*)(ws + WS_VTS), (bf16_t*)(ws + WS_KIS), (float*)(ws + WS_WI), a.out};
        pg8::gemm_phase(lds, g, S, E);
    }
    SEAM(4);
    PHASE(5) { phase_index(a, lds); }
    SEAM(5);
    PHASE(6) { phase_attn(a, lds); }
    SEAM(6);
    PHASE(7) {
        pg8::Gemm g{HA, (const bf16_t*)(ws + WS_WO), NR, 1024, 1024, 1024, 1024, 0};
        S.init(NR, 1024, G, blockIdx.x);
        EpiRes<false, false> E{nullptr, nullptr, Xb, nullptr, ss0};
        pg8::gemm_phase(lds, g, S, E);
    }
    SEAM(7);
    PHASE(8) {
        pg8::Gemm g{Xb, (const bf16_t*)(ws + WS_WUP1), NR, DFF, 1024, 1024, 1024, 0};
        S.init(NR, DFF, G, blockIdx.x);
        EpiUp E{ss0, U};
        pg8::gemm_phase(lds, g, S, E);
    }
    SEAM(8);
    PHASE(9) {
        pg8::Gemm g{U, (const bf16_t*)(ws + WS_WDN1), NR, 1024, DFF, DFF, DFF, 0};
        S.init(NR, 1024, G, blockIdx.x);
        EpiRes<false, false> E{nullptr, nullptr, Xb, nullptr, ss1};
        pg8::gemm_phase(lds, g, S, E);
    }
    SEAM(9);
    PHASE(10) { phase_final(a); }
    if (a.ph_hi > 1000) grid.sync();
}

#ifndef N_LAUNCHES
#define N_LAUNCHES 1
#endif
extern "C" void kernel_launch(void* const* d_in, const int* in_sizes, int n_in, void* d_out, int out_size, void* d_ws, size_t ws_size, hipStream_t stream) {
    static int grid = 0;
    if (grid == 0) {
        if (n_in != 15 || out_size != 107233280 || ws_size < WS_END) { fprintf(stderr, "kernel_launch: unexpected shapes (n_in %d out %d ws %zu need %zu)\n", n_in, out_size, ws_size, (size_t)WS_END); grid = -1; return; }
        int dev = 0, cus = 0, per_cu = 0;
        hipGetDevice(&dev); hipDeviceGetAttribute(&cus, hipDeviceAttributeMultiprocessorCount, dev);
        if (hipFuncSetAttribute((const void*)fwd_kernel, hipFuncAttributeMaxDynamicSharedMemorySize, LDS_BYTES) != hipSuccess) { fprintf(stderr, "kernel_launch: hipFuncSetAttribute failed\n"); grid = -1; return; }
        hipOccupancyMaxActiveBlocksPerMultiprocessor(&per_cu, (const void*)fwd_kernel, 512, LDS_BYTES);
        if (per_cu < 1) { fprintf(stderr, "kernel_launch: occupancy query says %d\n", per_cu); per_cu = 1; }
        (void)hipGetLastError();
        grid = cus;
    }
    if (grid < 0) return;
    if (hipMemsetAsync((char*)d_ws + WS_BAR, 0, XCD_BAR_WORDS * 4, stream) != hipSuccess) { fprintf(stderr, "kernel_launch: memset of the barrier words failed\n"); return; }
    Args a{};
    for (int i = 0; i < 15; ++i) a.in[i] = (const float*)d_in[i];
    a.out = (float*)d_out; a.ws = (unsigned char*)d_ws;
#if N_LAUNCHES == 1
    a.ph_lo = 0; a.ph_hi = 11;
    void* args[] = {&a};
    hipError_t e = hipLaunchCooperativeKernel((const void*)fwd_kernel, dim3(grid), dim3(512), args, LDS_BYTES, stream);
    if (e != hipSuccess) fprintf(stderr, "cooperative launch failed: %s (grid %d)\n", hipGetErrorString(e), grid);
#else
    for (int ph = 0; ph < 11; ++ph) { a.ph_lo = ph; a.ph_hi = ph + 1; hipLaunchKernelGGL(fwd_kernel, dim3(grid), dim3(512), LDS_BYTES, stream, a); }
#endif
}
```

```cpp
#include <hip/hip_runtime.h>
#include <hip/hip_cooperative_groups.h>
#include <cstdio>
#include <cstdint>
namespace cg = cooperative_groups;

#define LAS __attribute__((address_space(3)))
#define DI __device__ __forceinline__
typedef unsigned short bf16_t;
typedef short bf16x8 __attribute__((ext_vector_type(8)));
typedef float f32x2 __attribute__((ext_vector_type(2)));
typedef float f32x4 __attribute__((ext_vector_type(4)));
typedef float f32x16 __attribute__((ext_vector_type(16)));
typedef unsigned u32x2 __attribute__((ext_vector_type(2)));
typedef unsigned u32x4 __attribute__((ext_vector_type(4)));
typedef __bf16 bfv2 __attribute__((ext_vector_type(2)));

constexpr int D = 1024, NP = 65536, NS = 1024, NR = NP + NS, TP = 2048, TS = 64, LS = 2112, DFF = 4096;
constexpr int NWIN = 2304;
constexpr int MASKW = 68;
constexpr float EPS = 1e-6f;
constexpr size_t O_Y = 0, O_POOLP = 68157440, O_POOLS = 68648960, O_KP = 68894720, O_VP = 85671936, O_KIP = 102449152,
                 O_KS = 106643456, O_VS = 106905600, O_KIS = 107167744;
constexpr size_t WS_WPOOL = 0;
constexpr size_t WS_WIN = WS_WPOOL + 524288;
constexpr size_t WS_WO = WS_WIN + (size_t)NWIN * 1024 * 2;
constexpr size_t WS_WUP0 = WS_WO + 2097152;
constexpr size_t WS_WUP1 = WS_WUP0 + 8388608;
constexpr size_t WS_WDN0 = WS_WUP1 + 8388608;
constexpr size_t WS_WDN1 = WS_WDN0 + 8388608;
constexpr size_t WS_ROPE = WS_WDN1 + 8388608;
constexpr size_t WS_SS0 = WS_ROPE + 540672;
constexpr size_t WS_SS1 = WS_SS0 + (size_t)NR * 64;
constexpr size_t WS_KS = WS_SS1 + (size_t)NR * 64;
constexpr size_t WS_VTS = WS_KS + (size_t)16 * 4 * LS * 64 * 2;
constexpr size_t WS_KIS = WS_VTS + (size_t)16 * 4 * LS * 64 * 2;
constexpr size_t WS_HA = WS_KIS + (size_t)16 * LS * 64 * 2;
constexpr size_t WS_HB = WS_HA + (size_t)NR * 1024 * 2;
constexpr size_t WS_U = WS_HB + (size_t)NR * 1024 * 2;
constexpr size_t WS_BAR = WS_U + (size_t)NR * 4096 * 2;
constexpr size_t WS_END = WS_BAR + 16384;
constexpr size_t WS_Q = WS_U;
constexpr size_t WS_QI = WS_Q + (size_t)NR * 1024 * 2;
constexpr size_t WS_KP = WS_QI + (size_t)NR * 512 * 2;
constexpr size_t WS_VTP = WS_KP + (size_t)32 * 4 * 2048 * 64 * 2;
constexpr size_t WS_KIP = WS_VTP + (size_t)32 * 4 * 2048 * 64 * 2;
constexpr size_t WS_WI = WS_KIP + (size_t)32 * 2048 * 64 * 2;
constexpr size_t WS_MASK = WS_WI + (size_t)NR * 8 * 4;
constexpr size_t WS_ALIAS_END = WS_MASK + (size_t)NR * MASKW * 4;
static_assert(WS_ALIAS_END <= WS_BAR, "alias overflow");

constexpr int LDS_PHASE = 141312;
constexpr int LDS_BYTES = LDS_PHASE + 16;

struct Args {
    const float* in[15];
    float* out;
    unsigned char* ws;
    int ph_lo, ph_hi;
};

DI unsigned pk2(float lo, float hi) { f32x2 v = {lo, hi}; bfv2 b = __builtin_convertvector(v, bfv2); return __builtin_bit_cast(unsigned, b); }
DI float bf2f(bf16_t b) { return __uint_as_float(((unsigned)b) << 16); }
DI float xhalf_max(float x) {
    auto r = __builtin_amdgcn_permlane32_swap(__float_as_uint(x), __float_as_uint(x), false, false);
    return fmaxf(__uint_as_float(r[0]), __uint_as_float(r[1]));
}
DI float xhalf_sum(float x) {
    auto r = __builtin_amdgcn_permlane32_swap(__float_as_uint(x), __float_as_uint(x), false, false);
    return __uint_as_float(r[0]) + __uint_as_float(r[1]);
}

namespace pg8 {
constexpr int BM = 256, BK = 64, HALF = 128, HTB = HALF * BK * 2, STAGE_BYTES = 8 * HTB, NXCD = 8, WGM = 8;
DI int lds_byte(int r, int c) { const int st = (r >> 4) * 2 + (c >> 5), rr = r & 15, cc = c & 31, ob = rr * 64 + cc * 2; return st * 1024 + (ob ^ (((ob >> 9) & 1) << 5)); }
DI void stage_rc(int b, int& R, int& C) { const int st = b / 1024, sb = b % 1024, swz = sb ^ (((sb >> 9) & 1) << 5); R = (st >> 1) * 16 + swz / 64; C = (st & 1) * 32 + (swz % 64) / 2; }
DI int perm32(int rho) { const int n = rho >> 4, i = rho & 15; return 8 * (i >> 2) + 4 * n + (i & 3); }
struct Unit { int pm, pn; };
struct Gemm { const bf16_t* A; const bf16_t* Bt; int M, N, K, lda, ldb, a_pn_bytes; };
struct StaticOrder {
    int nM, nN, nwg, G, c;
    DI void init(int M, int N, int G_, int c_) { nM = M / BM; nN = N / BM; nwg = nM * nN; G = G_; c = c_; }
    DI bool next(int i, Unit& u) const {
        const long L = (long)i * G + c; if (L >= nwg) return false;
        int wgid = (int)L; { const int q = nwg / NXCD, r = nwg % NXCD, xcd = wgid % NXCD, off = wgid / NXCD; wgid = (xcd < r ? xcd * (q + 1) : r * (q + 1) + (xcd - r) * q) + off; }
        const int nig = WGM * nN, gid = wgid / nig, fm = gid * WGM, gsz = (nM - fm) < WGM ? (nM - fm) : WGM;
        u.pm = fm + ((wgid % nig) % gsz); u.pn = (wgid % nig) / gsz; return true;
    }
};

template <class Epi>
DI void gemm_phase(LAS unsigned char* lds, const Gemm g, const StaticOrder& S, const Epi& E) {
    const int tid = threadIdx.x, wid = __builtin_amdgcn_readfirstlane(tid >> 6), lane = tid & 63, wr = wid >> 2, wc = wid & 3, fr = lane & 15, fq = lane >> 4;
    const int K = g.K, nt = K / BK;
    unsigned voffA[2], voffB[2];
#pragma unroll
    for (int i = 0; i < 2; ++i) { int R, C; stage_rc(tid * 16 + i * 8192, R, C); const int Rb = (R & ~31) + perm32(R & 31);
        voffA[i] = (unsigned)(R * g.lda + C) * 2u; voffB[i] = (unsigned)(Rb * g.ldb + C) * 2u; }
    const size_t kstep = (size_t)(BK * 2);
    const size_t hstepA = (size_t)HALF * g.lda * 2, hstepB = (size_t)HALF * g.ldb * 2;
    const size_t tstepA = 2 * hstepA, tstepB = 2 * hstepB;
    const unsigned ldsw = (unsigned)wid * 1024u;
    const int aoff = lds_byte(wr * 64 + fr, fq * 8), boff = lds_byte(wc * 32 + fr, fq * 8);
#define PG8_SA(b, h) (((b) * 2 + (h)) * HTB)
#define PG8_SB(b, h) ((4 + (b) * 2 + (h)) * HTB)
#define PG8_STAGE(bufoff, gbase, voff) do { _Pragma("unroll") for (int _i = 0; _i < 2; ++_i) \
        __builtin_amdgcn_global_load_lds((const unsigned*)((const char*)(gbase) + (voff)[_i]), (LAS unsigned*)(lds + (bufoff) + ldsw + _i * 8192), 16, 0, 0); } while (0)
#define PG8_LDA(dst, b, h) do { _Pragma("unroll") for (int m = 0; m < 4; ++m) _Pragma("unroll") for (int k = 0; k < 2; ++k) dst[m][k] = *(const LAS bf16x8*)(lds + PG8_SA(b, h) + aoff + m * 2048 + k * 1024); } while (0)
#define PG8_LDB(dst, b, h) do { _Pragma("unroll") for (int n = 0; n < 2; ++n) _Pragma("unroll") for (int k = 0; k < 2; ++k) dst[n][k] = *(const LAS bf16x8*)(lds + PG8_SB(b, h) + boff + n * 2048 + k * 1024); } while (0)
#define PG8_MMA(ai, bj, At, Bt) do { __builtin_amdgcn_s_setprio(1); _Pragma("unroll") for (int m = 0; m < 4; ++m) _Pragma("unroll") for (int n = 0; n < 2; ++n) _Pragma("unroll") for (int k = 0; k < 2; ++k) \
        acc[ai][bj][m][n] = __builtin_amdgcn_mfma_f32_16x16x32_bf16(Bt[n][k], At[m][k], acc[ai][bj][m][n], 0, 0, 0); __builtin_amdgcn_s_setprio(0); } while (0)
#define PG8_WAIT_V(n) asm volatile("s_waitcnt vmcnt(" #n ")" ::: "memory")
#define PG8_WAIT_L(n) asm volatile("s_waitcnt lgkmcnt(" #n ")" ::: "memory")
#define PG8_BAR __builtin_amdgcn_s_barrier()
#define PG8_SCHED __builtin_amdgcn_sched_barrier(0)
    Unit cur, nxt; int ui = 0;
    if (!S.next(0, cur)) return;
    f32x4 acc[2][2][4][2];
#pragma unroll
    for (int a = 0; a < 2; ++a)
#pragma unroll
        for (int b = 0; b < 2; ++b)
#pragma unroll
            for (int m = 0; m < 4; ++m)
#pragma unroll
                for (int n = 0; n < 2; ++n) acc[a][b][m][n] = (f32x4){0.f, 0.f, 0.f, 0.f};
    bf16x8 At[4][2], B0[2][2], B1[2][2];
    const char* cA = (const char*)g.A + (size_t)cur.pm * tstepA + (size_t)cur.pn * g.a_pn_bytes; const char* cB = (const char*)g.Bt + (size_t)cur.pn * tstepB;
    PG8_STAGE(PG8_SB(0, 0), cB, voffB); PG8_STAGE(PG8_SB(0, 1), cB + hstepB, voffB); PG8_STAGE(PG8_SA(0, 0), cA, voffA); PG8_STAGE(PG8_SA(0, 1), cA + hstepA, voffA);
    if (wr == 1) PG8_BAR;
    PG8_WAIT_V(2); PG8_BAR;
    PG8_STAGE(PG8_SB(1, 0), cB + kstep, voffB); PG8_STAGE(PG8_SA(1, 0), cA + kstep, voffA); PG8_STAGE(PG8_SB(1, 1), cB + hstepB + kstep, voffB);
    PG8_WAIT_V(6); PG8_BAR;
    for (;;) {
        const bool has_next = S.next(ui + 1, nxt);
        const char* nA = has_next ? (const char*)g.A + (size_t)nxt.pm * tstepA + (size_t)nxt.pn * g.a_pn_bytes : cA; const char* nB = has_next ? (const char*)g.Bt + (size_t)nxt.pn * tstepB : cB;
#pragma unroll 1
        for (int t = 0; t < nt; t += 2) {
            const bool last = (t == nt - 2);
            const char* a1 = cA + (size_t)(t + 1) * kstep;
            const char* a2 = last ? nA : cA + (size_t)(t + 2) * kstep; const char* b2 = last ? nB : cB + (size_t)(t + 2) * kstep;
            const char* a3 = a2 + kstep; const char* b3 = b2 + kstep;
            PG8_LDB(B0, 0, 0); PG8_LDB(B1, 0, 1); PG8_SCHED; PG8_LDA(At, 0, 0); PG8_STAGE(PG8_SA(1, 1), a1 + hstepA, voffA);
            PG8_WAIT_V(8); PG8_WAIT_L(0); PG8_BAR; PG8_MMA(0, 0, At, B0); PG8_MMA(0, 1, At, B1); PG8_BAR; PG8_SCHED;
            PG8_LDA(At, 0, 1); PG8_STAGE(PG8_SB(0, 0), b2, voffB); PG8_STAGE(PG8_SB(0, 1), b2 + hstepB, voffB); PG8_STAGE(PG8_SA(0, 0), a2, voffA);
            PG8_WAIT_V(8); PG8_WAIT_L(0); PG8_BAR; PG8_MMA(1, 0, At, B0); PG8_MMA(1, 1, At, B1); PG8_BAR; PG8_SCHED;
            PG8_LDB(B0, 1, 0); PG8_LDB(B1, 1, 1); PG8_SCHED; PG8_LDA(At, 1, 0); PG8_STAGE(PG8_SA(0, 1), a2 + hstepA, voffA);
            PG8_WAIT_V(8); PG8_WAIT_L(0); PG8_BAR; PG8_MMA(0, 0, At, B0); PG8_MMA(0, 1, At, B1); PG8_BAR; PG8_SCHED;
            PG8_LDA(At, 1, 1); PG8_STAGE(PG8_SB(1, 0), b3, voffB); PG8_STAGE(PG8_SB(1, 1), b3 + hstepB, voffB); PG8_STAGE(PG8_SA(1, 0), a3, voffA);
            PG8_WAIT_V(8); PG8_WAIT_L(0); PG8_BAR; PG8_MMA(1, 0, At, B0); PG8_MMA(1, 1, At, B1); PG8_BAR; PG8_SCHED;
        }
        if (wr == 0) PG8_BAR;
        E(acc, cur, wr, wc, fr, fq);
        if (!has_next) break;
#pragma unroll
        for (int a = 0; a < 2; ++a)
#pragma unroll
            for (int b = 0; b < 2; ++b)
#pragma unroll
                for (int m = 0; m < 4; ++m)
#pragma unroll
                    for (int n = 0; n < 2; ++n) acc[a][b][m][n] = (f32x4){0.f, 0.f, 0.f, 0.f};
        cur = nxt; cA = nA; cB = nB; ++ui;
        if (wr == 1) PG8_BAR;
    }
    PG8_WAIT_V(0);
    PG8_BAR;
#undef PG8_SA
#undef PG8_SB
#undef PG8_STAGE
#undef PG8_LDA
#undef PG8_LDB
#undef PG8_MMA
#undef PG8_WAIT_V
#undef PG8_WAIT_L
#undef PG8_BAR
#undef PG8_SCHED
}
}
using pg8::Unit;

DI float row_rstd(const float* ss, int row) {
    const f32x4* p = (const f32x4*)(ss + (size_t)row * 16);
    f32x4 a = p[0], b = p[1], c = p[2], d = p[3];
    const float s = ((a.x + a.y) + (a.z + a.w)) + ((b.x + b.y) + (b.z + b.w)) + ((c.x + c.y) + (c.z + c.w)) + ((d.x + d.y) + (d.z + d.w));
    return __builtin_amdgcn_rsqf(s * (1.0f / 1024.0f) + EPS);
}

template <bool HAS_SCALE, bool IN_F32>
struct EpiRes {
    const float* xin_p; const float* xin_s; bf16_t* X; const float* colscale; float* ss;
    DI void operator()(const f32x4 (&acc)[2][2][4][2], const Unit& u, int wr, int wc, int fr, int fq) const {
        const int col0 = u.pn * 256 + wc * 32 + 8 * fq;
        float sq[2][4];
#pragma unroll
        for (int ai = 0; ai < 2; ++ai)
#pragma unroll
            for (int m = 0; m < 4; ++m) sq[ai][m] = 0.f;
#pragma unroll
        for (int bj = 0; bj < 2; ++bj) {
            const int col = col0 + bj * 128;
            f32x4 sc0, sc1;
            if (HAS_SCALE) { sc0 = *(const f32x4*)(colscale + col); sc1 = *(const f32x4*)(colscale + col + 4); }
#pragma unroll
            for (int ai = 0; ai < 2; ++ai)
#pragma unroll
                for (int m = 0; m < 4; ++m) {
                    const int row = u.pm * 256 + ai * 128 + wr * 64 + m * 16 + fr;
                    bf16_t* xb = X + (size_t)row * D + col;
                    f32x4 x0, x1;
                    if (IN_F32) {
                        const float* xr = (row < NP) ? xin_p + (size_t)row * D : xin_s + (size_t)(row - NP) * D;
                        x0 = *(const f32x4*)(xr + col); x1 = *(const f32x4*)(xr + col + 4);
                    } else {
                        const u32x4 h = *(const u32x4*)xb;
                        x0 = (f32x4){__uint_as_float(h.x << 16), __uint_as_float(h.x & 0xffff0000u), __uint_as_float(h.y << 16), __uint_as_float(h.y & 0xffff0000u)};
                        x1 = (f32x4){__uint_as_float(h.z << 16), __uint_as_float(h.z & 0xffff0000u), __uint_as_float(h.w << 16), __uint_as_float(h.w & 0xffff0000u)};
                    }
                    f32x4 y0 = acc[ai][bj][m][0], y1 = acc[ai][bj][m][1];
                    if (HAS_SCALE) { y0 = y0 * sc0; y1 = y1 * sc1; }
                    x0 = x0 + y0; x1 = x1 + y1;
                    sq[ai][m] += (x0.x * x0.x + x0.y * x0.y) + (x0.z * x0.z + x0.w * x0.w) + (x1.x * x1.x + x1.y * x1.y) + (x1.z * x1.z + x1.w * x1.w);
                    u32x4 o; o.x = pk2(x0.x, x0.y); o.y = pk2(x0.z, x0.w); o.z = pk2(x1.x, x1.y); o.w = pk2(x1.z, x1.w);
                    *(u32x4*)xb = o;
                }
        }
#pragma unroll
        for (int ai = 0; ai < 2; ++ai)
#pragma unroll
            for (int m = 0; m < 4; ++m) {
                const int row = u.pm * 256 + ai * 128 + wr * 64 + m * 16 + fr;
                float q = sq[ai][m];
                q += __shfl_xor(q, 16); q += __shfl_xor(q, 32);
                if (fq == 0) ss[(size_t)row * 16 + u.pn * 4 + wc] = q;
            }
    }
};

struct EpiUp {
    const float* ss; bf16_t* U;
    DI void operator()(const f32x4 (&acc)[2][2][4][2], const Unit& u, int wr, int wc, int fr, int fq) const {
        const int col0 = u.pn * 256 + wc * 32 + 8 * fq;
#pragma unroll
        for (int ai = 0; ai < 2; ++ai)
#pragma unroll
            for (int m = 0; m < 4; ++m) {
                const int row = u.pm * 256 + ai * 128 + wr * 64 + m * 16 + fr;
                const float rstd = row_rstd(ss, row);
#pragma unroll
                for (int bj = 0; bj < 2; ++bj) {
                    f32x4 v0 = acc[ai][bj][m][0] * rstd, v1 = acc[ai][bj][m][1] * rstd;
                    float e[8] = {v0.x, v0.y, v0.z, v0.w, v1.x, v1.y, v1.z, v1.w};
#pragma unroll
                    for (int i = 0; i < 8; ++i) { const float r = fmaxf(e[i], 0.f); e[i] = r * r; }
                    u32x4 o; o.x = pk2(e[0], e[1]); o.y = pk2(e[2], e[3]); o.z = pk2(e[4], e[5]); o.w = pk2(e[6], e[7]);
                    *(u32x4*)(U + (size_t)row * DFF + col0 + bj * 128) = o;
                }
            }
    }
};

struct EpiWin {
    const float* ss; const float* rope;
    bf16_t *Q, *QI, *KP, *VTP, *KIP, *KS, *VTS, *KIS; float* WI; float* out;
    DI void operator()(const f32x4 (&acc)[2][2][4][2], const Unit& u, int wr, int wc, int fr, int fq) const {
        const int q8 = (wc & 1) * 4 + fq;
        const bool smp = u.pm >= 256;
#pragma unroll
        for (int ai = 0; ai < 2; ++ai)
#pragma unroll
            for (int m = 0; m < 4; ++m) {
                const int row = u.pm * 256 + ai * 128 + wr * 64 + m * 16 + fr;
                const float rstd = row_rstd(ss, row);
                int b, pos, L; size_t rl;
                if (smp) { const int rs = row - NP; b = rs >> 6; pos = 2048 + (rs & 63); L = LS; rl = rs; } else { b = row >> 11; pos = row & 2047; L = 2048; rl = row; }
                const f32x4 cs0 = *(const f32x4*)(rope + ((size_t)pos * 32 + 4 * q8) * 2), cs1 = *(const f32x4*)(rope + ((size_t)pos * 32 + 4 * q8) * 2 + 4);
                const float cc[4] = {cs0.x, cs0.z, cs1.x, cs1.z}, sn[4] = {cs0.y, cs0.w, cs1.y, cs1.w};
#pragma unroll
                for (int bj = 0; bj < 2; ++bj) {
                    const int blk = u.pn * 4 + bj * 2 + (wc >> 1);
                    const f32x4 v0 = acc[ai][bj][m][0] * rstd, v1 = acc[ai][bj][m][1] * rstd;
                    const float a0[4] = {v0.x, v0.y, v0.z, v0.w}, a1[4] = {v1.x, v1.y, v1.z, v1.w};
                    float r1[4], r2[4];
#pragma unroll
                    for (int i = 0; i < 4; ++i) { r1[i] = a0[i] * cc[i] - a1[i] * sn[i]; r2[i] = a1[i] * cc[i] + a0[i] * sn[i]; }
                    if (blk < 16) {
                        bf16_t* p = Q + (size_t)row * 1024 + blk * 64 + 4 * q8;
                        u32x2 lo = {pk2(r1[0] * 0.125f, r1[1] * 0.125f), pk2(r1[2] * 0.125f, r1[3] * 0.125f)}, hi = {pk2(r2[0] * 0.125f, r2[1] * 0.125f), pk2(r2[2] * 0.125f, r2[3] * 0.125f)};
                        *(u32x2*)p = lo; *(u32x2*)(p + 32) = hi;
                    } else if (blk < 20) {
                        const int g = blk - 16;
                        float* po = out + (smp ? O_KS : O_KP) + rl * 256 + g * 64 + 4 * q8;
                        *(f32x4*)po = (f32x4){r1[0], r1[1], r1[2], r1[3]}; *(f32x4*)(po + 32) = (f32x4){r2[0], r2[1], r2[2], r2[3]};
                        bf16_t* p = (smp ? KS : KP) + (((size_t)b * 4 + g) * L + pos) * 64 + 4 * q8;
                        u32x2 lo = {pk2(r1[0], r1[1]), pk2(r1[2], r1[3])}, hi = {pk2(r2[0], r2[1]), pk2(r2[2], r2[3])};
                        *(u32x2*)p = lo; *(u32x2*)(p + 32) = hi;
                    } else if (blk < 24) {
                        const int g = blk - 20;
                        float* po = out + (smp ? O_VS : O_VP) + rl * 256 + g * 64 + 8 * q8;
                        *(f32x4*)po = v0; *(f32x4*)(po + 4) = v1;
                        bf16_t* p = (smp ? VTS : VTP) + (((size_t)b * 4 + g) * 64 + 8 * q8) * L + pos;
                        const unsigned w0 = pk2(a0[0], a0[1]), w1 = pk2(a0[2], a0[3]), w2 = pk2(a1[0], a1[1]), w3 = pk2(a1[2], a1[3]);
                        p[0] = (bf16_t)w0; p[(size_t)L] = (bf16_t)(w0 >> 16); p[(size_t)2 * L] = (bf16_t)w1; p[(size_t)3 * L] = (bf16_t)(w1 >> 16);
                        p[(size_t)4 * L] = (bf16_t)w2; p[(size_t)5 * L] = (bf16_t)(w2 >> 16); p[(size_t)6 * L] = (bf16_t)w3; p[(size_t)7 * L] = (bf16_t)(w3 >> 16);
                    } else if (blk < 32) {
                        bf16_t* p = QI + (size_t)row * 512 + (blk - 24) * 64 + 4 * q8;
                        u32x2 lo = {pk2(r1[0] * 0.125f, r1[1] * 0.125f), pk2(r1[2] * 0.125f, r1[3] * 0.125f)}, hi = {pk2(r2[0] * 0.125f, r2[1] * 0.125f), pk2(r2[2] * 0.125f, r2[3] * 0.125f)};
                        *(u32x2*)p = lo; *(u32x2*)(p + 32) = hi;
                    } else if (blk == 32) {
                        float* po = out + (smp ? O_KIS : O_KIP) + rl * 64 + 4 * q8;
                        *(f32x4*)po = (f32x4){r1[0], r1[1], r1[2], r1[3]}; *(f32x4*)(po + 32) = (f32x4){r2[0], r2[1], r2[2], r2[3]};
                        bf16_t* p = (smp ? KIS : KIP) + ((size_t)b * L + pos) * 64 + 4 * q8;
                        u32x2 lo = {pk2(r1[0], r1[1]), pk2(r1[2], r1[3])}, hi = {pk2(r2[0], r2[1]), pk2(r2[2], r2[3])};
                        *(u32x2*)p = lo; *(u32x2*)(p + 32) = hi;
                    } else if (blk == 33 && q8 == 0) {
                        const float s = 0.35355339059327373f;
                        float* p = WI + (size_t)row * 8;
                        *(f32x4*)p = v0 * s; *(f32x4*)(p + 4) = v1 * s;
                    }
                }
            }
    }
};

DI int win_rowmap(int n) {
    const bool roped = (n < 1280) || (n >= 1536 && n < 2112);
    if (!roped) return n;
    const int j = n & 63, base = n & ~63;
    return base + (j < 32 ? 8 * (j >> 2) + (j & 3) : 8 * ((j - 32) >> 2) + 4 + (j & 3));
}
template <bool WINMAP>
DI void transpose_item(const float* W, int K, int N, bf16_t* WT, LAS float* scr, int item, int lane, const float* gk = nullptr) {
    const int nblk = (N + 31) / 32, kb = item / nblk, nb = item % nblk, k0 = 64 * kb, n0 = 32 * nb;
    const int ncol = n0 + (lane & 31);
#pragma unroll 8
    for (int i = 0; i < 32; ++i) { const int kk = 2 * i + (lane >> 5); float v = (ncol < N) ? W[(size_t)(k0 + kk) * N + ncol] : 0.f; if (gk) v *= gk[k0 + kk]; scr[kk * 33 + (lane & 31)] = v; }
    asm volatile("s_waitcnt lgkmcnt(0)" ::: "memory");
    const int c = lane & 7;
#pragma unroll
    for (int j = 0; j < 4; ++j) {
        const int nl = (lane >> 3) + 8 * j, n = n0 + nl;
        const LAS float* s = scr + (8 * c) * 33 + nl;
        u32x4 o; o.x = pk2(s[0], s[33]); o.y = pk2(s[2 * 33], s[3 * 33]); o.z = pk2(s[4 * 33], s[5 * 33]); o.w = pk2(s[6 * 33], s[7 * 33]);
        if (n < N) { const int rowo = WINMAP ? win_rowmap(n) : n; *(u32x4*)(WT + (size_t)rowo * K + k0 + 8 * c) = o; }
    }
    asm volatile("s_waitcnt lgkmcnt(0)" ::: "memory");
}

DI void phase0(const Args& a, LAS unsigned char* lds, int part, int vb, int VG) {
    const int tid = threadIdx.x, wave = tid >> 6, lane = tid & 63, G = VG;
    LAS float* scr = (LAS float*)(lds + wave * 8448);
    unsigned char* ws = a.ws;
    const int gw = vb * 8 + wave, NGW = G * 8;
    const bool pa = part & 1, pb = part & 2, pc = part & 4;
    constexpr int I_POOL = 4 * 4 * 8, I_WIN = 16 * 67, I_WO = 16 * 32, I_UP = 16 * 128, I_DN = 64 * 32;
    constexpr int NITEMS = I_POOL + I_WIN + I_WO + 2 * I_UP + 2 * I_DN;
    for (int it = gw; it < NITEMS; it += NGW) {
        int r = it;
        if (r < I_POOL) { if (!pa) continue; const int g = r >> 5; transpose_item<false>(a.in[9] + (size_t)g * 65536, 256, 256, (bf16_t*)(ws + WS_WPOOL) + (size_t)g * 65536, scr, r & 31, lane); continue; } r -= I_POOL;
        if (r < I_WIN) { if (!pb) continue; transpose_item<true>(a.in[11], 1024, 2120, (bf16_t*)(ws + WS_WIN), scr, r, lane, a.in[6] + D); continue; } r -= I_WIN;
        if (r < I_WO) { if (!pb) continue; transpose_item<false>(a.in[12], 1024, 1024, (bf16_t*)(ws + WS_WO), scr, r, lane); continue; } r -= I_WO;
        if (r < 2 * I_UP) { const int l = r / I_UP; if (!(l ? pb : pc)) continue; transpose_item<false>(a.in[13] + (size_t)l * 4194304, 1024, 4096, (bf16_t*)(ws + (l ? WS_WUP1 : WS_WUP0)), scr, r % I_UP, lane, a.in[7] + (size_t)l * D); continue; } r -= 2 * I_UP;
        { const int l = r / I_DN; if (!(l ? pb : pc)) continue; transpose_item<false>(a.in[14] + (size_t)l * 4194304, 4096, 1024, (bf16_t*)(ws + (l ? WS_WDN1 : WS_WDN0)), scr, r % I_DN, lane); }
    }
    if (!pb) return;
    const int gt = vb * 512 + tid, NGT = G * 512;
    { u32x4* z = (u32x4*)((bf16_t*)(ws + WS_WIN) + (size_t)2120 * 1024); const int n16 = (NWIN - 2120) * 1024 * 2 / 16;
      for (int i = gt; i < n16; i += NGT) z[i] = (u32x4){0u, 0u, 0u, 0u}; }
    { float* rt = (float*)(ws + WS_ROPE);
      for (int i = gt; i < LS * 32; i += NGT) {
          const int pos = i >> 5, f = i & 31;
          double inv = 1.0; for (int k = 0; k < f; ++k) inv *= 0.7498942093324559;
          double rev = (double)pos * inv * 0.15915494309189535; rev -= __builtin_rint(rev);
          const float fr = (float)rev;
          rt[2 * i] = __builtin_amdgcn_cosf(fr); rt[2 * i + 1] = __builtin_amdgcn_sinf(fr);
      } }
    { const float* src = a.in[5]; bf16_t* dst = (bf16_t*)(ws + WS_KIS);
      for (int i = gt; i < 16 * 2048 * 8; i += NGT) {
          const int b = i >> 14, s = (i >> 3) & 2047, d8 = i & 7;
          const f32x4 v0 = *(const f32x4*)(src + (size_t)i * 8), v1 = *(const f32x4*)(src + (size_t)i * 8 + 4);
          u32x4 o = {pk2(v0.x, v0.y), pk2(v0.z, v0.w), pk2(v1.x, v1.y), pk2(v1.z, v1.w)};
          *(u32x4*)(dst + ((size_t)b * LS + s) * 64 + d8 * 8) = o;
      } }
    { const float* src = a.in[3]; bf16_t* dst = (bf16_t*)(ws + WS_KS);
      for (int i = gt; i < 16 * 2048 * 4 * 8; i += NGT) {
          const int d8 = i & 7, g = (i >> 3) & 3, s = (i >> 5) & 2047, b = i >> 16;
          const f32x4 v0 = *(const f32x4*)(src + (size_t)i * 8), v1 = *(const f32x4*)(src + (size_t)i * 8 + 4);
          u32x4 o = {pk2(v0.x, v0.y), pk2(v0.z, v0.w), pk2(v1.x, v1.y), pk2(v1.z, v1.w)};
          *(u32x4*)(dst + (((size_t)b * 4 + g) * LS + s) * 64 + d8 * 8) = o;
      } }
    { const float* src = a.in[4]; bf16_t* dst = (bf16_t*)(ws + WS_VTS);
      for (int i = gt; i < 16 * 4 * 256 * 64; i += NGT) {
          const int d = i & 63, s8 = (i >> 6) & 255, g = (i >> 14) & 3, b = i >> 16;
          const float* p = src + (((size_t)b * 2048 + s8 * 8) * 4 + g) * 64 + d;
          float v[8];
#pragma unroll
          for (int j = 0; j < 8; ++j) v[j] = p[(size_t)j * 256];
          u32x4 o = {pk2(v[0], v[1]), pk2(v[2], v[3]), pk2(v[4], v[5]), pk2(v[6], v[7])};
          *(u32x4*)(dst + (((size_t)b * 4 + g) * 64 + d) * LS + s8 * 8) = o;
      } }
}

DI void phase1(const Args& a, LAS unsigned char* lds) {
    const int tid = threadIdx.x, half = tid >> 8, ht = tid & 255, wv = ht >> 6, lane = tid & 63, G = gridDim.x;
    LAS float* rs = (LAS float*)(lds) + half * 64;
    const float* gmix = a.in[6];
    bf16_t* Dout = (bf16_t*)(a.ws + WS_HA);
    const int c = 4 * ht;
    const f32x4 gq = *(const f32x4*)(gmix + c);
    const int win = 2 << wv;
    for (int base = blockIdx.x * 2; base < 2080; base += 2 * G) {
        const int it = base + half;
        const bool smp = it >= 2048;
        int b, t0, T; const float* xs; size_t rowbase;
        if (smp) { b = (it - 2048) >> 1; t0 = ((it - 2048) & 1) * 32; T = TS; xs = a.in[1] + (size_t)b * TS * D; rowbase = (size_t)NP + b * TS; }
        else { b = it >> 6; t0 = (it & 63) * 32; T = TP; xs = a.in[0] + (size_t)b * TP * D; rowbase = (size_t)b * TP; }
        const float* past = a.in[2] + (size_t)b * 15 * D;
        __syncthreads();
        for (int i = wv; i < 47; i += 4) {
            const int t = t0 + i - 15;
            if (t >= 0) {
                const f32x4* xr = (const f32x4*)(xs + (size_t)t * D) + lane;
                float s = 0.f;
#pragma unroll
                for (int j = 0; j < 4; ++j) { const f32x4 v = xr[64 * j]; s += (v.x * v.x + v.y * v.y) + (v.z * v.z + v.w * v.w); }
#pragma unroll
                for (int o = 1; o < 64; o <<= 1) s += __shfl_xor(s, o);
                if (lane == 0) rs[i] = __builtin_amdgcn_rsqf(s * (1.0f / 1024.0f) + EPS);
            }
        }
        __syncthreads();
        auto hrow = [&](int r) -> f32x4 {
            const int t = t0 + r;
            if (t < 0) { if (smp) return *(const f32x4*)(past + (size_t)(15 + t) * D + c); return (f32x4){0.f, 0.f, 0.f, 0.f}; }
            const f32x4 v = *(const f32x4*)(xs + (size_t)t * D + c);
            return v * rs[r + 15] * gq;
        };
        f32x4 S = {0.f, 0.f, 0.f, 0.f};
        for (int j = 1; j < win; ++j) S = S + hrow(-j);
        float* pout = a.out + (smp ? O_POOLS : O_POOLP) + (size_t)b * 15 * D + c;
#pragma unroll 4
        for (int r = 0; r < 32; ++r) {
            const f32x4 hv = hrow(r);
            S = S + hv;
            const int t = t0 + r;
            const int cnt = smp ? win : (t + 1 < win ? t + 1 : win);
            const float inv = 1.0f / (float)cnt;
            const f32x4 dv = S * inv - hv;
            u32x2 o = {pk2(dv.x, dv.y), pk2(dv.z, dv.w)};
            *(u32x2*)(Dout + (rowbase + t) * D + c) = o;
            if (t >= T - 15) *(f32x4*)(pout + (size_t)(t - (T - 15)) * D) = hv;
            S = S - hrow(r - win + 1);
        }
    }
}

DI unsigned fkey(float s) { s = s + 0.0f; const unsigned u = __float_as_uint(s); return (u & 0x80000000u) ? ~u : (u | 0x80000000u); }
DI unsigned row16_sum(unsigned v) {
    v += (unsigned)__builtin_amdgcn_update_dpp(0, (int)v, 0xB1, 0xf, 0xf, false);
    v += (unsigned)__builtin_amdgcn_update_dpp(0, (int)v, 0x4E, 0xf, 0xf, false);
    v += (unsigned)__builtin_amdgcn_update_dpp(0, (int)v, 0x124, 0xf, 0xf, false);
    v += (unsigned)__builtin_amdgcn_update_dpp(0, (int)v, 0x128, 0xf, 0xf, false);
    return v;
}
DI unsigned row16_max(unsigned v) {
    v = max(v, (unsigned)__builtin_amdgcn_update_dpp(0, (int)v, 0xB1, 0xf, 0xf, false));
    v = max(v, (unsigned)__builtin_amdgcn_update_dpp(0, (int)v, 0x4E, 0xf, 0xf, false));
    v = max(v, (unsigned)__builtin_amdgcn_update_dpp(0, (int)v, 0x124, 0xf, 0xf, false));
    v = max(v, (unsigned)__builtin_amdgcn_update_dpp(0, (int)v, 0x128, 0xf, 0xf, false));
    return v;
}
DI float unkey(unsigned k) { return __uint_as_float((k & 0x80000000u) ? (k & 0x7fffffffu) : ~k); }
DI unsigned count_ge(const unsigned (&kk)[66], unsigned c) {
    unsigned cnt = 0u;
#pragma unroll
    for (int t = 0; t < 66; ++t) asm volatile("v_cmp_ge_u32 vcc, %1, %2\n\tv_addc_co_u32 %0, vcc, 0, %0, vcc" : "+v"(cnt) : "v"(kk[t]), "v"(c) : "vcc");
    return cnt;
}
DI void select_write(const unsigned (&kk)[66], int nk, int hf, int j32, unsigned* mr) {
    unsigned mxk = 0u, mnk = 0xffffffffu;
#pragma unroll
    for (int t = 0; t < 66; ++t) { mxk = max(mxk, kk[t]); mnk = min(mnk, kk[t] - 1u); }
    mxk = row16_max(mxk); mnk = ~row16_max(~mnk);
    { const unsigned m0 = max((unsigned)__builtin_amdgcn_readlane((int)mxk, 0), (unsigned)__builtin_amdgcn_readlane((int)mxk, 16));
      const unsigned m1 = max((unsigned)__builtin_amdgcn_readlane((int)mxk, 32), (unsigned)__builtin_amdgcn_readlane((int)mxk, 48));
      mxk = hf ? m1 : m0;
      const unsigned n0 = min((unsigned)__builtin_amdgcn_readlane((int)mnk, 0), (unsigned)__builtin_amdgcn_readlane((int)mnk, 16));
      const unsigned n1 = min((unsigned)__builtin_amdgcn_readlane((int)mnk, 32), (unsigned)__builtin_amdgcn_readlane((int)mnk, 48));
      mnk = (hf ? n1 : n0) + 1u; }
    unsigned lo = mnk, hi = mxk + 1u;
    unsigned tau = 0u, thr = 0u; bool done = false;
    for (int it = 0; it < 80; ++it) {
        const unsigned span = hi - lo;
        unsigned c = (it < 16) ? fkey(0.5f * unkey(lo) + 0.5f * unkey(hi - 1u)) : lo + (span >> 1);
        c = max(c, lo + 1u); c = min(c, hi - 1u);
        if (done || span < 2u) c = lo;
        unsigned cnt = row16_sum(count_ge(kk, c));
        const unsigned nlo = (unsigned)__builtin_amdgcn_readlane((int)cnt, 0) + (unsigned)__builtin_amdgcn_readlane((int)cnt, 16);
        const unsigned nhi = (unsigned)__builtin_amdgcn_readlane((int)cnt, 32) + (unsigned)__builtin_amdgcn_readlane((int)cnt, 48);
        const unsigned n = hf ? nhi : nlo;
        if (!done) {
            if (span < 2u) { done = true; tau = lo; thr = 0u; }
            else if (n == 256u) { done = true; thr = c; tau = c; }
            else if (n > 256u) lo = c;
            else hi = c;
        }
        if (__ballot(!done) == 0ull) break;
    }
    done = thr != 0u;
    unsigned w[3] = {0u, 0u, 0u};
    if (__ballot(!done) == 0ull) {
#pragma unroll
        for (int t = 0; t < 66; ++t) {
            const unsigned long long bs = __ballot(kk[t] >= thr);
            const unsigned sw = hf ? (unsigned)(bs >> 32) : (unsigned)bs;
            if (j32 == (t & 31)) w[t >> 5] = sw;
        }
    } else {
        unsigned glo = 0u, ghi = 0u;
#pragma unroll
        for (int t = 0; t < 66; ++t) { const unsigned long long b = __ballot(kk[t] > tau); glo += __popc((unsigned)b); ghi += __popc((unsigned)(b >> 32)); }
        const unsigned r0 = 256u - (hf ? ghi : glo);
        unsigned tk = 0u;
        const unsigned below_mask = (1u << j32) - 1u;
#pragma unroll
        for (int t = 0; t < 66; ++t) {
            if (t < nk) {
                const bool eq = kk[t] == tau;
                const unsigned long long be = __ballot(eq);
                const unsigned e = hf ? (unsigned)(be >> 32) : (unsigned)be;
                const bool take = eq && (tk + __popc(e & below_mask) < r0);
                tk += __popc(e);
                const unsigned long long bs = __ballot((kk[t] > tau) || take);
                const unsigned sw = hf ? (unsigned)(bs >> 32) : (unsigned)bs;
                if (j32 == (t & 31)) w[t >> 5] = sw;
            }
        }
    }
    mr[j32] = w[0]; mr[32 + j32] = w[1];
    if (j32 < 2) mr[64 + j32] = w[2];
}
DI void phase_index(const Args& a, LAS unsigned char* lds) {
    const int tid = threadIdx.x, wave = __builtin_amdgcn_readfirstlane(tid >> 6), lane = tid & 63, hf = lane >> 5, j32 = lane & 31, G = gridDim.x;
    const bf16_t* QI = (const bf16_t*)(a.ws + WS_QI); const float* WI = (const float*)(a.ws + WS_WI);
    unsigned* MASK = (unsigned*)(a.ws + WS_MASK);
    LAS unsigned* lk = (LAS unsigned*)(lds + wave * 16896) + lane;
    constexpr int NIT = 32 + 2048;
    for (int base = 0, rnd = 0; base < NIT; base += G, ++rnd) {
        const int idx = (rnd & 1) ? (G - 1 - (int)blockIdx.x) : (int)blockIdx.x;
        const int pos = base + idx;
        if (pos >= NIT) continue;
        int nkt, rowbase; const bf16_t* KI;
        if (pos < 32) { const int b = pos >> 1; nkt = 66; rowbase = NP + b * 64 + (pos & 1) * 32; KI = (const bf16_t*)(a.ws + WS_KIS) + (size_t)b * LS * 64; }
        else { const int p = pos - 32, c = 31 - (p >> 6), b = (p & 63) >> 1; nkt = 2 * (c + 1); rowbase = b * 2048 + c * 64 + (p & 1) * 32; KI = (const bf16_t*)(a.ws + WS_KIP) + (size_t)b * 2048 * 64; }
        const int row0 = rowbase + wave * 4;
        unsigned* mr0 = MASK + (size_t)(row0 + hf) * MASKW; unsigned* mr1 = MASK + (size_t)(row0 + 2 + hf) * MASKW;
        if (nkt <= 8) {
            const unsigned w = (j32 < nkt) ? 0xffffffffu : 0u;
            mr0[j32] = w; mr0[32 + j32] = 0u; mr1[j32] = w; mr1[32 + j32] = 0u;
            if (j32 < 2) { mr0[64 + j32] = 0u; mr1[64 + j32] = 0u; }
            continue;
        }
        int nk = nkt; asm volatile("" : "+s"(nk));
        const int qq = 2 * (j32 >> 4) + ((j32 >> 2) & 1), hh = 4 * ((j32 >> 3) & 1) + (j32 & 3);
        bf16x8 aq[4];
        { const bf16_t* p = QI + (size_t)(row0 + qq) * 512 + hh * 64 + 8 * hf;
#pragma unroll
          for (int jj = 0; jj < 4; ++jj) aq[jj] = *(const bf16x8*)(p + 16 * jj); }
        float wv0[8], wv1[8];
        { const float* p0 = WI + (size_t)(row0 + hf) * 8; const float* p1 = WI + (size_t)(row0 + 2 + hf) * 8;
          const f32x4 x0 = *(const f32x4*)p0, x1 = *(const f32x4*)(p0 + 4), y0 = *(const f32x4*)p1, y1 = *(const f32x4*)(p1 + 4);
          wv0[0] = x0.x; wv0[1] = x0.y; wv0[2] = x0.z; wv0[3] = x0.w; wv0[4] = x1.x; wv0[5] = x1.y; wv0[6] = x1.z; wv0[7] = x1.w;
          wv1[0] = y0.x; wv1[1] = y0.y; wv1[2] = y0.z; wv1[3] = y0.w; wv1[4] = y1.x; wv1[5] = y1.y; wv1[6] = y1.z; wv1[7] = y1.w; }
        const char* kbase = (const char*)KI;
        const unsigned koff = (unsigned)(j32 * 64 + 8 * hf) * 2u;
        unsigned kk[66];
#pragma unroll
        for (int g = 0; g < 17; ++g) {
#pragma unroll
            for (int u = 0; u < 4; ++u) if (4 * g + u < 66) kk[4 * g + u] = 0u;
            if (4 * g < nk) {
                bf16x8 bt[4][4];
#pragma unroll
                for (int u = 0; u < 4; ++u) { const int tt = (4 * g + u < nk) ? 4 * g + u : nk - 1; const char* p = kbase + (size_t)tt * 4096 + koff;
#pragma unroll
                    for (int jj = 0; jj < 4; ++jj) bt[u][jj] = *(const bf16x8*)(p + 32 * jj); }
#pragma unroll
                for (int u = 0; u < 4; ++u) {
                    const int t = 4 * g + u;
                    if (t < 66) {
                        f32x16 acc;
#pragma unroll
                        for (int i = 0; i < 16; ++i) acc[i] = 0.f;
#pragma unroll
                        for (int jj = 0; jj < 4; ++jj) acc = __builtin_amdgcn_mfma_f32_32x32x16_bf16(aq[jj], bt[u][jj], acc, 0, 0, 0);
                        float s0 = 0.f, s1 = 0.f;
#pragma unroll
                        for (int i = 0; i < 8; ++i) {
                            s0 = __builtin_fmaf(__int_as_float(max(__float_as_int(acc[i]), 0)), wv0[i], s0);
                            s1 = __builtin_fmaf(__int_as_float(max(__float_as_int(acc[8 + i]), 0)), wv1[i], s1);
                        }
                        const bool live = t < nk;
                        kk[t] = live ? fkey(s0) : 0u;
                        lk[t * 64] = live ? fkey(s1) : 0u;
                    }
                }
            } else {
#pragma unroll
                for (int u = 0; u < 4; ++u) if (4 * g + u < 66) lk[(4 * g + u) * 64] = 0u;
            }
            __builtin_amdgcn_sched_barrier(0);
        }
        select_write(kk, nk, hf, j32, mr0);
#pragma unroll
        for (int t = 0; t < 66; ++t) kk[t] = lk[t * 64];
        select_write(kk, nk, hf, j32, mr1);
    }
}

DI void phase_attn(const Args& a, LAS unsigned char* lds) {
    const int tid = threadIdx.x, wave = __builtin_amdgcn_readfirstlane(tid >> 6), lane = tid & 63, hf = lane >> 5, j32 = lane & 31, G = gridDim.x;
    const bf16_t* Q = (const bf16_t*)(a.ws + WS_Q);
    const unsigned* MASK = (const unsigned*)(a.ws + WS_MASK);
    bf16_t* O = (bf16_t*)(a.ws + WS_HA);
    constexpr int NIT = 64 + 4096;
    constexpr float LOG2E = 1.4426950408889634f;
    constexpr int RS = 144, RSV = 528, KREG = 256 * RS, BUFB = KREG + 64 * RSV;
    const int th = wave >> 2, hd = wave & 3;
    const int pik = (j32 & 0x13) | ((j32 & 8) >> 1) | ((j32 & 4) << 1);
    const bf16x8 ones = {0x3f80, 0x3f80, 0x3f80, 0x3f80, 0x3f80, 0x3f80, 0x3f80, 0x3f80};
    const unsigned kread = (unsigned)(pik * RS + 16 * hf), vread = (unsigned)(KREG + j32 * RSV + 16 * hf);
    for (int base = 0, rnd = 0; base < NIT; base += G, ++rnd) {
        const int idx = (rnd & 1) ? (G - 1 - (int)blockIdx.x) : (int)blockIdx.x;
        const int pos = base + idx;
        if (pos >= NIT) continue;
        int nst, rowbase, L, g; const bf16_t *Kb, *Vt;
        if (pos < 64) { const int b = pos >> 2; g = pos & 3; nst = 33; L = LS; rowbase = NP + b * 64;
            Kb = (const bf16_t*)(a.ws + WS_KS) + ((size_t)b * 4 + g) * LS * 64; Vt = (const bf16_t*)(a.ws + WS_VTS) + ((size_t)b * 4 + g) * 64 * LS; }
        else { const int p = pos - 64, c = 31 - (p >> 7), b = (p & 127) >> 2; g = p & 3; nst = c + 1; L = 2048; rowbase = b * 2048 + c * 64;
            Kb = (const bf16_t*)(a.ws + WS_KP) + ((size_t)b * 4 + g) * 2048 * 64; Vt = (const bf16_t*)(a.ws + WS_VTP) + ((size_t)b * 4 + g) * 64 * 2048; }
        const int nbig = (nst + 3) >> 2;
        const int row = rowbase + th * 32 + j32, head = 4 * g + hd;
        bf16x8 qf[4];
        { const bf16_t* p = Q + (size_t)row * 1024 + head * 64 + 8 * hf;
#pragma unroll
          for (int jj = 0; jj < 4; ++jj) qf[jj] = *(const bf16x8*)(p + 16 * jj); }
        const unsigned* mrow = MASK + (size_t)row * MASKW;
        u32x4 kr[4], vr[4];
        auto stage_load = [&](int bs) __attribute__((always_inline)) {
#pragma unroll
            for (int i = 0; i < 4; ++i) {
                const int cid = tid + 512 * i;
                int kr_row = bs * 256 + (cid >> 3); kr_row = kr_row < L ? kr_row : L - 1;
                kr[i] = *(const u32x4*)(Kb + (size_t)kr_row * 64 + (cid & 7) * 8);
                int vcol = bs * 256 + (cid & 31) * 8; vcol = vcol < L - 8 ? vcol : L - 8;
                vr[i] = *(const u32x4*)(Vt + (size_t)(cid >> 5) * L + vcol);
            }
        };
        auto stage_store = [&](LAS unsigned char* buf) __attribute__((always_inline)) {
#pragma unroll
            for (int i = 0; i < 4; ++i) {
                const int cid = tid + 512 * i;
                *(LAS u32x4*)(buf + (cid >> 3) * RS + (cid & 7) * 16) = kr[i];
                *(LAS u32x4*)(buf + KREG + (cid >> 5) * RSV + (cid & 31) * 16) = vr[i];
            }
        };
        stage_load(0);
        f32x16 o0, o1, lacc;
#pragma unroll
        for (int i = 0; i < 16; ++i) { o0[i] = 0.f; o1[i] = 0.f; lacc[i] = 0.f; }
        float mrun = -1e30f;
        u32x4 mwa = *(const u32x4*)mrow, mwb = *(const u32x4*)(mrow + 4);
        __syncthreads();
        stage_store(lds);
        __syncthreads();
        for (int bs = 0; bs < nbig; ++bs) {
            LAS unsigned char* cur = lds + (bs & 1) * BUFB;
            const bool more = bs + 1 < nbig;
            if (more) stage_load(bs + 1);
            const unsigned mw8[8] = {mwa.x, mwa.y, mwa.z, mwa.w, mwb.x, mwb.y, mwb.z, mwb.w};
            if (more) { mwa = *(const u32x4*)(mrow + 8 * (bs + 1)); mwb = *(const u32x4*)(mrow + 8 * (bs + 1) + 4); }
            const int nv = (nst - 4 * bs) < 4 ? (nst - 4 * bs) : 4;
#pragma unroll
            for (int j = 0; j < 4; ++j) {
                if (j < nv) {
                    f32x16 sc[2];
#pragma unroll
                    for (int tt = 0; tt < 2; ++tt) {
#pragma unroll
                        for (int i = 0; i < 16; ++i) sc[tt][i] = 0.f;
#pragma unroll
                        for (int jj = 0; jj < 4; ++jj) {
                            const bf16x8 kf = *(const LAS bf16x8*)(cur + kread + (j * 64 + tt * 32) * RS + 32 * jj);
                            sc[tt] = __builtin_amdgcn_mfma_f32_32x32x16_bf16(kf, qf[jj], sc[tt], 0, 0, 0);
                        }
                    }
                    float mx = __builtin_fmaxf(sc[0][0], sc[1][0]);
#pragma unroll
                    for (int i = 1; i < 16; ++i) mx = __builtin_fmaxf(__builtin_fmaxf(mx, sc[0][i]), sc[1][i]);
                    mx = xhalf_max(mx);
                    if (__ballot(mx > mrun + 8.0f) != 0ull) {
                        const float mnew = fmaxf(mrun, mx);
                        const float alpha = __builtin_amdgcn_exp2f((mrun - mnew) * LOG2E);
                        mrun = mnew;
#pragma unroll
                        for (int i = 0; i < 16; ++i) { o0[i] *= alpha; o1[i] *= alpha; lacc[i] *= alpha; }
                    }
                    const float nm = -mrun * LOG2E;
#pragma unroll
                    for (int tt = 0; tt < 2; ++tt) {
                        const unsigned mw = mw8[2 * j + tt] >> (8 * hf);
                        float p[16];
#pragma unroll
                        for (int i = 0; i < 16; ++i) {
                            const float e = __builtin_amdgcn_exp2f(__builtin_fmaf(sc[tt][i], LOG2E, nm));
                            const unsigned msk = (unsigned)__builtin_amdgcn_sbfe((int)mw, (i & 7) + 16 * (i >> 3), 1);
                            p[i] = __uint_as_float(__float_as_uint(e) & msk);
                        }
#pragma unroll
                        for (int s2 = 0; s2 < 2; ++s2) {
                            u32x4 pw = {pk2(p[8 * s2], p[8 * s2 + 1]), pk2(p[8 * s2 + 2], p[8 * s2 + 3]), pk2(p[8 * s2 + 4], p[8 * s2 + 5]), pk2(p[8 * s2 + 6], p[8 * s2 + 7])};
                            const bf16x8 pf = __builtin_bit_cast(bf16x8, pw);
                            const bf16x8 v0 = *(const LAS bf16x8*)(cur + vread + (j * 64 + tt * 32 + 16 * s2) * 2);
                            const bf16x8 v1 = *(const LAS bf16x8*)(cur + vread + 32 * RSV + (j * 64 + tt * 32 + 16 * s2) * 2);
                            o0 = __builtin_amdgcn_mfma_f32_32x32x16_bf16(v0, pf, o0, 0, 0, 0);
                            o1 = __builtin_amdgcn_mfma_f32_32x32x16_bf16(v1, pf, o1, 0, 0, 0);
                            lacc = __builtin_amdgcn_mfma_f32_32x32x16_bf16(ones, pf, lacc, 0, 0, 0);
                        }
                    }
                }
            }
            if (more) stage_store(lds + ((bs & 1) ^ 1) * BUFB);
            __syncthreads();
        }
        const float inv = 1.0f / lacc[0];
        bf16_t* op = O + (size_t)row * 1024 + head * 64 + 4 * hf;
#pragma unroll
        for (int q = 0; q < 4; ++q) {
            u32x2 x0 = {pk2(o0[4 * q] * inv, o0[4 * q + 1] * inv), pk2(o0[4 * q + 2] * inv, o0[4 * q + 3] * inv)};
            u32x2 x1 = {pk2(o1[4 * q] * inv, o1[4 * q + 1] * inv), pk2(o1[4 * q + 2] * inv, o1[4 * q + 3] * inv)};
            *(u32x2*)(op + 8 * q) = x0; *(u32x2*)(op + 32 + 8 * q) = x1;
        }
    }
}

DI void phase_final(const Args& a) {
    const int tid = threadIdx.x, wave = tid >> 6, lane = tid & 63, G = gridDim.x;
    const float* ss = (const float*)(a.ws + WS_SS1);
    const bf16_t* Xb = (const bf16_t*)(a.ws + WS_HB);
    const float* gf = a.in[8];
    f32x4 g0[2], g1[2];
#pragma unroll
    for (int j = 0; j < 2; ++j) { g0[j] = *(const f32x4*)(gf + (lane + 64 * j) * 8); g1[j] = *(const f32x4*)(gf + (lane + 64 * j) * 8 + 4); }
    for (int row = blockIdx.x * 8 + wave; row < NR; row += G * 8) {
        float s = ss[(size_t)row * 16 + (lane & 15)];
        s += __shfl_xor(s, 1); s += __shfl_xor(s, 2); s += __shfl_xor(s, 4); s += __shfl_xor(s, 8);
        const float rstd = __builtin_amdgcn_rsqf(s * (1.0f / 1024.0f) + EPS);
        const u32x4* hr = (const u32x4*)(Xb + (size_t)row * D) + lane;
        f32x4* yr = (f32x4*)(a.out + (size_t)row * D) + 2 * lane;
#pragma unroll
        for (int j = 0; j < 2; ++j) {
            const u32x4 h = hr[64 * j];
            f32x4 y0 = {__uint_as_float(h.x << 16), __uint_as_float(h.x & 0xffff0000u), __uint_as_float(h.y << 16), __uint_as_float(h.y & 0xffff0000u)};
            f32x4 y1 = {__uint_as_float(h.z << 16), __uint_as_float(h.z & 0xffff0000u), __uint_as_float(h.w << 16), __uint_as_float(h.w & 0xffff0000u)};
            yr[128 * j] = y0 * rstd * g0[j]; yr[128 * j + 1] = y1 * rstd * g1[j];
        }
    }
}

#define XB_TMO      128
#define XB_XCNT(j)  (256  + 64 * (j))
#define XB_XSUB(j)  (1280 + 64 * (j))
#define XB_XGEN(j)  (2304 + 64 * (j))
#define XB_TOP      3328
#define XB_TOPGEN   3392
#define XCD_BAR_WORDS 3456
#define XB_SPIN_CAP (1u << 20)
DI unsigned xb_ld(unsigned* p)              { return __hip_atomic_load(p, __ATOMIC_RELAXED, __HIP_MEMORY_SCOPE_AGENT); }
DI unsigned xb_add(unsigned* p, unsigned v) { return __hip_atomic_fetch_add(p, v, __ATOMIC_RELAXED, __HIP_MEMORY_SCOPE_AGENT); }
DI unsigned xb_xcc_id() { return (unsigned)__builtin_amdgcn_s_getreg((3 << 11) | 20) & 0xFu; }
#define XB_SPIN(cond, bar) do { unsigned _sp = 0; while (cond) { __builtin_amdgcn_s_sleep(1); \
    if ((++_sp & 255u) == 0u) { if (xb_ld(&(bar)[XB_TMO])) break; if (_sp > XB_SPIN_CAP) { atomicAdd(&(bar)[XB_TMO], 1u); break; } } } } while (0)
struct XcdBarrier { unsigned* bar; unsigned x; volatile LAS unsigned* st; };
DI XcdBarrier xcd_barrier_post(unsigned* bar, volatile LAS unsigned* st) {
    XcdBarrier b; b.bar = bar; b.x = xb_xcc_id(); b.st = st;
    if (threadIdx.x == 0) (void)xb_add(&bar[XB_XCNT(b.x)], 1u);
    return b;
}
DI void xcd_barrier_complete(unsigned* bar, unsigned x, unsigned& nloc, unsigned& nx) {
    const unsigned G = gridDim.x * gridDim.y * gridDim.z;
    unsigned sum, cnt, mine, sp = 0u;
    for (;;) {
        sum = 0u; cnt = 0u; mine = 0u;
#pragma unroll
        for (unsigned j = 0; j < 16; ++j) { const unsigned c = xb_ld(&bar[XB_XCNT(j)]); sum += c; cnt += (c > 0u) ? 1u : 0u; mine = (j == x) ? c : mine; }
        if (sum == G) break;
        __builtin_amdgcn_s_sleep(1);
        if ((++sp & 255u) == 0u) { if (xb_ld(&bar[XB_TMO])) break; if (sp > XB_SPIN_CAP) { atomicAdd(&bar[XB_TMO], 1u); break; } }
    }
    nloc = mine > 0u ? mine : 1u; nx = cnt > 0u ? cnt : 1u;
}
DI void xcd_barrier(const XcdBarrier& b) {
    asm volatile("s_waitcnt vmcnt(0)" ::: "memory");
    __syncthreads();
    if (threadIdx.x == 0) {
        unsigned* bar = b.bar;
        __builtin_amdgcn_s_waitcnt(0);
        unsigned nloc = b.st[0], nx = b.st[1];
        if (nloc == 0u) { xcd_barrier_complete(bar, b.x, nloc, nx); b.st[0] = nloc; b.st[1] = nx; }
        const unsigned old = xb_add(&bar[XB_XSUB(b.x)], 1u);
        const unsigned gen = old / nloc;
        if (old + 1u == (gen + 1u) * nloc) {
            __builtin_amdgcn_fence(__ATOMIC_RELEASE, "agent");
            asm volatile("s_waitcnt vmcnt(0)" ::: "memory");
            const unsigned og = xb_add(&bar[XB_TOP], 1u);
            const unsigned tg = og / nx;
            if (og + 1u == (tg + 1u) * nx) xb_add(&bar[XB_TOPGEN], 1u);
            else XB_SPIN(xb_ld(&bar[XB_TOPGEN]) == tg, bar);
            __builtin_amdgcn_fence(__ATOMIC_ACQUIRE, "agent");
            xb_add(&bar[XB_XGEN(b.x)], 1u);
            asm volatile("s_waitcnt vmcnt(0)" ::: "memory");
        } else {
            XB_SPIN(xb_ld(&bar[XB_XGEN(b.x)]) == gen, bar);
            __builtin_amdgcn_fence(__ATOMIC_ACQUIRE, "agent");
            asm volatile("s_waitcnt vmcnt(0)" ::: "memory");
        }
    }
    __syncthreads();
}

__global__ void __launch_bounds__(512, 2) fwd_kernel(Args a) {
    extern __shared__ __attribute__((aligned(16))) unsigned char lds_raw[];
    LAS unsigned char* lds = (LAS unsigned char*)lds_raw;
    cg::grid_group grid = cg::this_grid();
    volatile LAS unsigned* xst = (volatile LAS unsigned*)(lds + LDS_PHASE);
    if (threadIdx.x == 0) { xst[0] = 0u; xst[1] = 0u; }
    __syncthreads();
    const XcdBarrier xb = xcd_barrier_post((unsigned*)(a.ws + WS_BAR), xst);
    unsigned char* ws = a.ws;
    const int G = gridDim.x;
    pg8::StaticOrder S;
    float* ss0 = (float*)(ws + WS_SS0); float* ss1 = (float*)(ws + WS_SS1);
    bf16_t* HA = (bf16_t*)(ws + WS_HA); bf16_t* Xb = (bf16_t*)(ws + WS_HB); bf16_t* U = (bf16_t*)(ws + WS_U);
#ifndef PHMASK
#define PHMASK 0xfff
#endif
#ifndef PROBE_REP
#define PROBE_REP 0x0
#endif
#define PHASE(k) if (((PHMASK >> (k)) & 1) && (k) >= a.ph_lo && (k) < a.ph_hi)
#define SEAM(k) do { if ((k) >= a.ph_lo && (k) + 1 < a.ph_hi) xcd_barrier(xb); } while (0)
    const bool defer0 = (G == 256);
    PHASE(0) { phase0(a, lds, defer0 ? 1 : 7, blockIdx.x, G); phase1(a, lds); }
#if PROBE_REP & 0x1
    grid.sync(); phase0(a, lds, 7, blockIdx.x, G); phase1(a, lds);
#endif
    SEAM(0);
    PHASE(1) {
        pg8::Gemm g{HA, (const bf16_t*)(ws + WS_WPOOL), NR, 1024, 256, 1024, 256, 512};
        S.init(NR, 1024, G, blockIdx.x);
        EpiRes<true, true> E{a.in[0], a.in[1], Xb, a.in[10], ss0};
        pg8::gemm_phase(lds, g, S, E);
        if (defer0 && blockIdx.x >= 16) phase0(a, lds, 4, blockIdx.x - 16, 240);
    }
    SEAM(1);
    PHASE(2) {
        pg8::Gemm g{Xb, (const bf16_t*)(ws + WS_WUP0), NR, DFF, 1024, 1024, 1024, 0};
        S.init(NR, DFF, G, blockIdx.x);
        EpiUp E{ss0, U};
        pg8::gemm_phase(lds, g, S, E);
    }
    SEAM(2);
    PHASE(3) {
        pg8::Gemm g{U, (const bf16_t*)(ws + WS_WDN0), NR, 1024, DFF, DFF, DFF, 0};
        S.init(NR, 1024, G, blockIdx.x);
        EpiRes<false, false> E{nullptr, nullptr, Xb, nullptr, ss1};
        pg8::gemm_phase(lds, g, S, E);
        if (defer0 && blockIdx.x >= 16) phase0(a, lds, 2, blockIdx.x - 16, 240);
    }
    SEAM(3);
    PHASE(4) {
        pg8::Gemm g{Xb, (const bf16_t*)(ws + WS_WIN), NR, NWIN, 1024, 1024, 1024, 0};
        S.init(NR, NWIN, G, blockIdx.x);
        EpiWin E{ss1, (const float*)(ws + WS_ROPE), (bf16_t*)(ws + WS_Q), (bf16_t*)(ws + WS_QI), (bf16_t*)(ws + WS_KP), (bf16_t*)(ws + WS_VTP), (bf16_t*)(ws + WS_KIP),
                 (bf16_t*)(ws + WS_KS), (bf16_t*)(ws + WS_VTS), (bf16_t*)(ws + WS_KIS), (float*)(ws + WS_WI), a.out};
        pg8::gemm_phase(lds, g, S, E);
    }
    SEAM(4);
    PHASE(5) { phase_index(a, lds); }
    SEAM(5);
    PHASE(6) { phase_attn(a, lds); }
    SEAM(6);
    PHASE(7) {
        pg8::Gemm g{HA, (const bf16_t*)(ws + WS_WO), NR, 1024, 1024, 1024, 1024, 0};
        S.init(NR, 1024, G, blockIdx.x);
        EpiRes<false, false> E{nullptr, nullptr, Xb, nullptr, ss0};
        pg8::gemm_phase(lds, g, S, E);
    }
    SEAM(7);
    PHASE(8) {
        pg8::Gemm g{Xb, (const bf16_t*)(ws + WS_WUP1), NR, DFF, 1024, 1024, 1024, 0};
        S.init(NR, DFF, G, blockIdx.x);
        EpiUp E{ss0, U};
        pg8::gemm_phase(lds, g, S, E);
    }
    SEAM(8);
    PHASE(9) {
        pg8::Gemm g{U, (const bf16_t*)(ws + WS_WDN1), NR, 1024, DFF, DFF, DFF, 0};
        S.init(NR, 1024, G, blockIdx.x);
        EpiRes<false, false> E{nullptr, nullptr, Xb, nullptr, ss1};
        pg8::gemm_phase(lds, g, S, E);
    }
    SEAM(9);
    PHASE(10) { phase_final(a); }
    if (a.ph_hi > 1000) grid.sync();
}

#ifndef N_LAUNCHES
#define N_LAUNCHES 1
#endif
extern "C" void kernel_launch(void* const* d_in, const int* in_sizes, int n_in, void* d_out, int out_size, void* d_ws, size_t ws_size, hipStream_t stream) {
    static int grid = 0;
    if (grid == 0) {
        if (n_in != 15 || out_size != 107233280 || ws_size < WS_END) { fprintf(stderr, "kernel_launch: unexpected shapes (n_in %d out %d ws %zu need %zu)\n", n_in, out_size, ws_size, (size_t)WS_END); grid = -1; return; }
        int dev = 0, cus = 0, per_cu = 0;
        hipGetDevice(&dev); hipDeviceGetAttribute(&cus, hipDeviceAttributeMultiprocessorCount, dev);
        if (hipFuncSetAttribute((const void*)fwd_kernel, hipFuncAttributeMaxDynamicSharedMemorySize, LDS_BYTES) != hipSuccess) { fprintf(stderr, "kernel_launch: hipFuncSetAttribute failed\n"); grid = -1; return; }
        hipOccupancyMaxActiveBlocksPerMultiprocessor(&per_cu, (const void*)fwd_kernel, 512, LDS_BYTES);
        if (per_cu < 1) { fprintf(stderr, "kernel_launch: occupancy query says %d\n", per_cu); per_cu = 1; }
        (void)hipGetLastError();
        grid = cus;
    }
    if (grid < 0) return;
    if (hipMemsetAsync((char*)d_ws + WS_BAR, 0, XCD_BAR_WORDS * 4, stream) != hipSuccess) { fprintf(stderr, "kernel_launch: memset of the barrier words failed\n"); return; }
    Args a{};
    for (int i = 0; i < 15; ++i) a.in[i] = (const float*)d_in[i];
    a.out = (float*)d_out; a.ws = (unsigned char*)d_ws;
#if N_LAUNCHES == 1
    a.ph_lo = 0; a.ph_hi = 11;
    void* args[] = {&a};
    hipError_t e = hipLaunchCooperativeKernel((const void*)fwd_kernel, dim3(grid), dim3(512), args, LDS_BYTES, stream);
    if (e != hipSuccess) fprintf(stderr, "cooperative launch failed: %s (grid %d)\n", hipGetErrorString(e), grid);
#else
    for (int ph = 0; ph < 11; ++ph) { a.ph_lo = ph; a.ph_hi = ph + 1; hipLaunchKernelGGL(fwd_kernel, dim3(grid), dim3(512), LDS_BYTES, stream, a); }
#endif
}
```

```cpp
#include <hip/hip_runtime.h>
#include <hip/hip_cooperative_groups.h>
#include <cstdio>
#include <cstdint>
namespace cg = cooperative_groups;

#define LAS __attribute__((address_space(3)))
#define DI __device__ __forceinline__
typedef unsigned short bf16_t;
typedef short bf16x8 __attribute__((ext_vector_type(8)));
typedef float f32x2 __attribute__((ext_vector_type(2)));
typedef float f32x4 __attribute__((ext_vector_type(4)));
typedef float f32x16 __attribute__((ext_vector_type(16)));
typedef unsigned u32x2 __attribute__((ext_vector_type(2)));
typedef unsigned u32x4 __attribute__((ext_vector_type(4)));
typedef __bf16 bfv2 __attribute__((ext_vector_type(2)));

constexpr int D = 1024, NP = 65536, NS = 1024, NR = NP + NS, TP = 2048, TS = 64, LS = 2112, DFF = 4096;
constexpr int NWIN = 2304;
constexpr int MASKW = 68;
constexpr float EPS = 1e-6f;
constexpr size_t O_Y = 0, O_POOLP = 68157440, O_POOLS = 68648960, O_KP = 68894720, O_VP = 85671936, O_KIP = 102449152,
                 O_KS = 106643456, O_VS = 106905600, O_KIS = 107167744;
constexpr size_t WS_WPOOL = 0;
constexpr size_t WS_WIN = WS_WPOOL + 524288;
constexpr size_t WS_WO = WS_WIN + (size_t)NWIN * 1024 * 2;
constexpr size_t WS_WUP0 = WS_WO + 2097152;
constexpr size_t WS_WUP1 = WS_WUP0 + 8388608;
constexpr size_t WS_WDN0 = WS_WUP1 + 8388608;
constexpr size_t WS_WDN1 = WS_WDN0 + 8388608;
constexpr size_t WS_ROPE = WS_WDN1 + 8388608;
constexpr size_t WS_SS0 = WS_ROPE + 540672;
constexpr size_t WS_SS1 = WS_SS0 + (size_t)NR * 64;
constexpr size_t WS_KS = WS_SS1 + (size_t)NR * 64;
constexpr size_t WS_VTS = WS_KS + (size_t)16 * 4 * LS * 64 * 2;
constexpr size_t WS_KIS = WS_VTS + (size_t)16 * 4 * LS * 64 * 2;
constexpr size_t WS_HA = WS_KIS + (size_t)16 * LS * 64 * 2;
constexpr size_t WS_HB = WS_HA + (size_t)NR * 1024 * 2;
constexpr size_t WS_U = WS_HB + (size_t)NR * 1024 * 2;
constexpr size_t WS_BAR = WS_U + (size_t)NR * 4096 * 2;
constexpr size_t WS_END = WS_BAR + 16384;
constexpr size_t WS_Q = WS_U;
constexpr size_t WS_QI = WS_Q + (size_t)NR * 1024 * 2;
constexpr size_t WS_KP = WS_QI + (size_t)NR * 512 * 2;
constexpr size_t WS_VTP = WS_KP + (size_t)32 * 4 * 2048 * 64 * 2;
constexpr size_t WS_KIP = WS_VTP + (size_t)32 * 4 * 2048 * 64 * 2;
constexpr size_t WS_WI = WS_KIP + (size_t)32 * 2048 * 64 * 2;
constexpr size_t WS_MASK = WS_WI + (size_t)NR * 8 * 4;
constexpr size_t WS_ALIAS_END = WS_MASK + (size_t)NR * MASKW * 4;
static_assert(WS_ALIAS_END <= WS_BAR, "alias overflow");

constexpr int LDS_PHASE = 141312;
constexpr int LDS_BYTES = LDS_PHASE + 16;

struct Args {
    const float* in[15];
    float* out;
    unsigned char* ws;
    int ph_lo, ph_hi;
};

DI unsigned pk2(float lo, float hi) { f32x2 v = {lo, hi}; bfv2 b = __builtin_convertvector(v, bfv2); return __builtin_bit_cast(unsigned, b); }
DI float bf2f(bf16_t b) { return __uint_as_float(((unsigned)b) << 16); }
DI float xhalf_max(float x) {
    auto r = __builtin_amdgcn_permlane32_swap(__float_as_uint(x), __float_as_uint(x), false, false);
    return fmaxf(__uint_as_float(r[0]), __uint_as_float(r[1]));
}
DI float xhalf_sum(float x) {
    auto r = __builtin_amdgcn_permlane32_swap(__float_as_uint(x), __float_as_uint(x), false, false);
    return __uint_as_float(r[0]) + __uint_as_float(r[1]);
}

namespace pg8 {
constexpr int BM = 256, BK = 64, HALF = 128, HTB = HALF * BK * 2, STAGE_BYTES = 8 * HTB, NXCD = 8, WGM = 8;
DI int lds_byte(int r, int c) { const int st = (r >> 4) * 2 + (c >> 5), rr = r & 15, cc = c & 31, ob = rr * 64 + cc * 2; return st * 1024 + (ob ^ (((ob >> 9) & 1) << 5)); }
DI void stage_rc(int b, int& R, int& C) { const int st = b / 1024, sb = b % 1024, swz = sb ^ (((sb >> 9) & 1) << 5); R = (st >> 1) * 16 + swz / 64; C = (st & 1) * 32 + (swz % 64) / 2; }
DI int perm32(int rho) { const int n = rho >> 4, i = rho & 15; return 8 * (i >> 2) + 4 * n + (i & 3); }
struct Unit { int pm, pn; };
struct Gemm { const bf16_t* A; const bf16_t* Bt; int M, N, K, lda, ldb, a_pn_bytes; };
struct StaticOrder {
    int nM, nN, nwg, G, c;
    DI void init(int M, int N, int G_, int c_) { nM = M / BM; nN = N / BM; nwg = nM * nN; G = G_; c = c_; }
    DI bool next(int i, Unit& u) const {
        const long L = (long)i * G + c; if (L >= nwg) return false;
        int wgid = (int)L; { const int q = nwg / NXCD, r = nwg % NXCD, xcd = wgid % NXCD, off = wgid / NXCD; wgid = (xcd < r ? xcd * (q + 1) : r * (q + 1) + (xcd - r) * q) + off; }
        const int nig = WGM * nN, gid = wgid / nig, fm = gid * WGM, gsz = (nM - fm) < WGM ? (nM - fm) : WGM;
        u.pm = fm + ((wgid % nig) % gsz); u.pn = (wgid % nig) / gsz; return true;
    }
};

template <class Epi>
DI void gemm_phase(LAS unsigned char* lds, const Gemm g, const StaticOrder& S, const Epi& E) {
    const int tid = threadIdx.x, wid = __builtin_amdgcn_readfirstlane(tid >> 6), lane = tid & 63, wr = wid >> 2, wc = wid & 3, fr = lane & 15, fq = lane >> 4;
    const int K = g.K, nt = K / BK;
    unsigned voffA[2], voffB[2];
#pragma unroll
    for (int i = 0; i < 2; ++i) { int R, C; stage_rc(tid * 16 + i * 8192, R, C); const int Rb = (R & ~31) + perm32(R & 31);
        voffA[i] = (unsigned)(R * g.lda + C) * 2u; voffB[i] = (unsigned)(Rb * g.ldb + C) * 2u; }
    const size_t kstep = (size_t)(BK * 2);
    const size_t hstepA = (size_t)HALF * g.lda * 2, hstepB = (size_t)HALF * g.ldb * 2;
    const size_t tstepA = 2 * hstepA, tstepB = 2 * hstepB;
    const unsigned ldsw = (unsigned)wid * 1024u;
    const int aoff = lds_byte(wr * 64 + fr, fq * 8), boff = lds_byte(wc * 32 + fr, fq * 8);
#define PG8_SA(b, h) (((b) * 2 + (h)) * HTB)
#define PG8_SB(b, h) ((4 + (b) * 2 + (h)) * HTB)
#define PG8_STAGE(bufoff, gbase, voff) do { _Pragma("unroll") for (int _i = 0; _i < 2; ++_i) \
        __builtin_amdgcn_global_load_lds((const unsigned*)((const char*)(gbase) + (voff)[_i]), (LAS unsigned*)(lds + (bufoff) + ldsw + _i * 8192), 16, 0, 0); } while (0)
#define PG8_LDA(dst, b, h) do { _Pragma("unroll") for (int m = 0; m < 4; ++m) _Pragma("unroll") for (int k = 0; k < 2; ++k) dst[m][k] = *(const LAS bf16x8*)(lds + PG8_SA(b, h) + aoff + m * 2048 + k * 1024); } while (0)
#define PG8_LDB(dst, b, h) do { _Pragma("unroll") for (int n = 0; n < 2; ++n) _Pragma("unroll") for (int k = 0; k < 2; ++k) dst[n][k] = *(const LAS bf16x8*)(lds + PG8_SB(b, h) + boff + n * 2048 + k * 1024); } while (0)
#define PG8_MMA(ai, bj, At, Bt) do { __builtin_amdgcn_s_setprio(1); _Pragma("unroll") for (int m = 0; m < 4; ++m) _Pragma("unroll") for (int n = 0; n < 2; ++n) _Pragma("unroll") for (int k = 0; k < 2; ++k) \
        acc[ai][bj][m][n] = __builtin_amdgcn_mfma_f32_16x16x32_bf16(Bt[n][k], At[m][k], acc[ai][bj][m][n], 0, 0, 0); __builtin_amdgcn_s_setprio(0); } while (0)
#define PG8_WAIT_V(n) asm volatile("s_waitcnt vmcnt(" #n ")" ::: "memory")
#define PG8_WAIT_L(n) asm volatile("s_waitcnt lgkmcnt(" #n ")" ::: "memory")
#define PG8_BAR __builtin_amdgcn_s_barrier()
#define PG8_SCHED __builtin_amdgcn_sched_barrier(0)
    Unit cur, nxt; int ui = 0;
    if (!S.next(0, cur)) return;
    f32x4 acc[2][2][4][2];
#pragma unroll
    for (int a = 0; a < 2; ++a)
#pragma unroll
        for (int b = 0; b < 2; ++b)
#pragma unroll
            for (int m = 0; m < 4; ++m)
#pragma unroll
                for (int n = 0; n < 2; ++n) acc[a][b][m][n] = (f32x4){0.f, 0.f, 0.f, 0.f};
    bf16x8 At[4][2], B0[2][2], B1[2][2];
    const char* cA = (const char*)g.A + (size_t)cur.pm * tstepA + (size_t)cur.pn * g.a_pn_bytes; const char* cB = (const char*)g.Bt + (size_t)cur.pn * tstepB;
    PG8_STAGE(PG8_SB(0, 0), cB, voffB); PG8_STAGE(PG8_SB(0, 1), cB + hstepB, voffB); PG8_STAGE(PG8_SA(0, 0), cA, voffA); PG8_STAGE(PG8_SA(0, 1), cA + hstepA, voffA);
    if (wr == 1) PG8_BAR;
    PG8_WAIT_V(2); PG8_BAR;
    PG8_STAGE(PG8_SB(1, 0), cB + kstep, voffB); PG8_STAGE(PG8_SA(1, 0), cA + kstep, voffA); PG8_STAGE(PG8_SB(1, 1), cB + hstepB + kstep, voffB);
    PG8_WAIT_V(6); PG8_BAR;
    for (;;) {
        const bool has_next = S.next(ui + 1, nxt);
        const char* nA = has_next ? (const char*)g.A + (size_t)nxt.pm * tstepA + (size_t)nxt.pn * g.a_pn_bytes : cA; const char* nB = has_next ? (const char*)g.Bt + (size_t)nxt.pn * tstepB : cB;
#pragma unroll 1
        for (int t = 0; t < nt; t += 2) {
            const bool last = (t == nt - 2);
            const char* a1 = cA + (size_t)(t + 1) * kstep;
            const char* a2 = last ? nA : cA + (size_t)(t + 2) * kstep; const char* b2 = last ? nB : cB + (size_t)(t + 2) * kstep;
            const char* a3 = a2 + kstep; const char* b3 = b2 + kstep;
            PG8_LDB(B0, 0, 0); PG8_LDB(B1, 0, 1); PG8_SCHED; PG8_LDA(At, 0, 0); PG8_STAGE(PG8_SA(1, 1), a1 + hstepA, voffA);
            PG8_WAIT_V(8); PG8_WAIT_L(0); PG8_BAR; PG8_MMA(0, 0, At, B0); PG8_MMA(0, 1, At, B1); PG8_BAR; PG8_SCHED;
            PG8_LDA(At, 0, 1); PG8_STAGE(PG8_SB(0, 0), b2, voffB); PG8_STAGE(PG8_SB(0, 1), b2 + hstepB, voffB); PG8_STAGE(PG8_SA(0, 0), a2, voffA);
            PG8_WAIT_V(8); PG8_WAIT_L(0); PG8_BAR; PG8_MMA(1, 0, At, B0); PG8_MMA(1, 1, At, B1); PG8_BAR; PG8_SCHED;
            PG8_LDB(B0, 1, 0); PG8_LDB(B1, 1, 1); PG8_SCHED; PG8_LDA(At, 1, 0); PG8_STAGE(PG8_SA(0, 1), a2 + hstepA, voffA);
            PG8_WAIT_V(8); PG8_WAIT_L(0); PG8_BAR; PG8_MMA(0, 0, At, B0); PG8_MMA(0, 1, At, B1); PG8_BAR; PG8_SCHED;
            PG8_LDA(At, 1, 1); PG8_STAGE(PG8_SB(1, 0), b3, voffB); PG8_STAGE(PG8_SB(1, 1), b3 + hstepB, voffB); PG8_STAGE(PG8_SA(1, 0), a3, voffA);
            PG8_WAIT_V(8); PG8_WAIT_L(0); PG8_BAR; PG8_MMA(1, 0, At, B0); PG8_MMA(1, 1, At, B1); PG8_BAR; PG8_SCHED;
        }
        if (wr == 0) PG8_BAR;
        E(acc, cur, wr, wc, fr, fq);
        if (!has_next) break;
#pragma unroll
        for (int a = 0; a < 2; ++a)
#pragma unroll
            for (int b = 0; b < 2; ++b)
#pragma unroll
                for (int m = 0; m < 4; ++m)
#pragma unroll
                    for (int n = 0; n < 2; ++n) acc[a][b][m][n] = (f32x4){0.f, 0.f, 0.f, 0.f};
        cur = nxt; cA = nA; cB = nB; ++ui;
        if (wr == 1) PG8_BAR;
    }
    PG8_WAIT_V(0);
    PG8_BAR;
#undef PG8_SA
#undef PG8_SB
#undef PG8_STAGE
#undef PG8_LDA
#undef PG8_LDB
#undef PG8_MMA
#undef PG8_WAIT_V
#undef PG8_WAIT_L
#undef PG8_BAR
#undef PG8_SCHED
}
}
using pg8::Unit;

DI float row_rstd(const float* ss, int row) {
    const f32x4* p = (const f32x4*)(ss + (size_t)row * 16);
    f32x4 a = p[0], b = p[1], c = p[2], d = p[3];
    const float s = ((a.x + a.y) + (a.z + a.w)) + ((b.x + b.y) + (b.z + b.w)) + ((c.x + c.y) + (c.z + c.w)) + ((d.x + d.y) + (d.z + d.w));
    return __builtin_amdgcn_rsqf(s * (1.0f / 1024.0f) + EPS);
}

template <bool HAS_SCALE, bool IN_F32>
struct EpiRes {
    const float* xin_p; const float* xin_s; bf16_t* X; const float* colscale; float* ss;
    DI void operator()(const f32x4 (&acc)[2][2][4][2], const Unit& u, int wr, int wc, int fr, int fq) const {
        const int col0 = u.pn * 256 + wc * 32 + 8 * fq;
        float sq[2][4];
#pragma unroll
        for (int ai = 0; ai < 2; ++ai)
#pragma unroll
            for (int m = 0; m < 4; ++m) sq[ai][m] = 0.f;
#pragma unroll
        for (int bj = 0; bj < 2; ++bj) {
            const int col = col0 + bj * 128;
            f32x4 sc0, sc1;
            if (HAS_SCALE) { sc0 = *(const f32x4*)(colscale + col); sc1 = *(const f32x4*)(colscale + col + 4); }
#pragma unroll
            for (int ai = 0; ai < 2; ++ai)
#pragma unroll
                for (int m = 0; m < 4; ++m) {
                    const int row = u.pm * 256 + ai * 128 + wr * 64 + m * 16 + fr;
                    bf16_t* xb = X + (size_t)row * D + col;
                    f32x4 x0, x1;
                    if (IN_F32) {
                        const float* xr = (row < NP) ? xin_p + (size_t)row * D : xin_s + (size_t)(row - NP) * D;
                        x0 = *(const f32x4*)(xr + col); x1 = *(const f32x4*)(xr + col + 4);
                    } else {
                        const u32x4 h = *(const u32x4*)xb;
                        x0 = (f32x4){__uint_as_float(h.x << 16), __uint_as_float(h.x & 0xffff0000u), __uint_as_float(h.y << 16), __uint_as_float(h.y & 0xffff0000u)};
                        x1 = (f32x4){__uint_as_float(h.z << 16), __uint_as_float(h.z & 0xffff0000u), __uint_as_float(h.w << 16), __uint_as_float(h.w & 0xffff0000u)};
                    }
                    f32x4 y0 = acc[ai][bj][m][0], y1 = acc[ai][bj][m][1];
                    if (HAS_SCALE) { y0 = y0 * sc0; y1 = y1 * sc1; }
                    x0 = x0 + y0; x1 = x1 + y1;
                    sq[ai][m] += (x0.x * x0.x + x0.y * x0.y) + (x0.z * x0.z + x0.w * x0.w) + (x1.x * x1.x + x1.y * x1.y) + (x1.z * x1.z + x1.w * x1.w);
                    u32x4 o; o.x = pk2(x0.x, x0.y); o.y = pk2(x0.z, x0.w); o.z = pk2(x1.x, x1.y); o.w = pk2(x1.z, x1.w);
                    *(u32x4*)xb = o;
                }
        }
#pragma unroll
        for (int ai = 0; ai < 2; ++ai)
#pragma unroll
            for (int m = 0; m < 4; ++m) {
                const int row = u.pm * 256 + ai * 128 + wr * 64 + m * 16 + fr;
                float q = sq[ai][m];
                q += __shfl_xor(q, 16); q += __shfl_xor(q, 32);
                if (fq == 0) ss[(size_t)row * 16 + u.pn * 4 + wc] = q;
            }
    }
};

struct EpiUp {
    const float* ss; bf16_t* U;
    DI void operator()(const f32x4 (&acc)[2][2][4][2], const Unit& u, int wr, int wc, int fr, int fq) const {
        const int col0 = u.pn * 256 + wc * 32 + 8 * fq;
#pragma unroll
        for (int ai = 0; ai < 2; ++ai)
#pragma unroll
            for (int m = 0; m < 4; ++m) {
                const int row = u.pm * 256 + ai * 128 + wr * 64 + m * 16 + fr;
                const float rstd = row_rstd(ss, row);
#pragma unroll
                for (int bj = 0; bj < 2; ++bj) {
                    f32x4 v0 = acc[ai][bj][m][0] * rstd, v1 = acc[ai][bj][m][1] * rstd;
                    float e[8] = {v0.x, v0.y, v0.z, v0.w, v1.x, v1.y, v1.z, v1.w};
#pragma unroll
                    for (int i = 0; i < 8; ++i) { const float r = fmaxf(e[i], 0.f); e[i] = r * r; }
                    u32x4 o; o.x = pk2(e[0], e[1]); o.y = pk2(e[2], e[3]); o.z = pk2(e[4], e[5]); o.w = pk2(e[6], e[7]);
                    *(u32x4*)(U + (size_t)row * DFF + col0 + bj * 128) = o;
                }
            }
    }
};

struct EpiWin {
    const float* ss; const float* rope;
    bf16_t *Q, *QI, *KP, *VTP, *KIP, *KS, *VTS, *KIS; float* WI; float* out;
    DI void operator()(const f32x4 (&acc)[2][2][4][2], const Unit& u, int wr, int wc, int fr, int fq) const {
        const int q8 = (wc & 1) * 4 + fq;
        const bool smp = u.pm >= 256;
#pragma unroll
        for (int ai = 0; ai < 2; ++ai)
#pragma unroll
            for (int m = 0; m < 4; ++m) {
                const int row = u.pm * 256 + ai * 128 + wr * 64 + m * 16 + fr;
                const float rstd = row_rstd(ss, row);
                int b, pos, L; size_t rl;
                if (smp) { const int rs = row - NP; b = rs >> 6; pos = 2048 + (rs & 63); L = LS; rl = rs; } else { b = row >> 11; pos = row & 2047; L = 2048; rl = row; }
                const f32x4 cs0 = *(const f32x4*)(rope + ((size_t)pos * 32 + 4 * q8) * 2), cs1 = *(const f32x4*)(rope + ((size_t)pos * 32 + 4 * q8) * 2 + 4);
                const float cc[4] = {cs0.x, cs0.z, cs1.x, cs1.z}, sn[4] = {cs0.y, cs0.w, cs1.y, cs1.w};
#pragma unroll
                for (int bj = 0; bj < 2; ++bj) {
                    const int blk = u.pn * 4 + bj * 2 + (wc >> 1);
                    const f32x4 v0 = acc[ai][bj][m][0] * rstd, v1 = acc[ai][bj][m][1] * rstd;
                    const float a0[4] = {v0.x, v0.y, v0.z, v0.w}, a1[4] = {v1.x, v1.y, v1.z, v1.w};
                    float r1[4], r2[4];
#pragma unroll
                    for (int i = 0; i < 4; ++i) { r1[i] = a0[i] * cc[i] - a1[i] * sn[i]; r2[i] = a1[i] * cc[i] + a0[i] * sn[i]; }
                    if (blk < 16) {
                        bf16_t* p = Q + (size_t)row * 1024 + blk * 64 + 4 * q8;
                        u32x2 lo = {pk2(r1[0] * 0.125f, r1[1] * 0.125f), pk2(r1[2] * 0.125f, r1[3] * 0.125f)}, hi = {pk2(r2[0] * 0.125f, r2[1] * 0.125f), pk2(r2[2] * 0.125f, r2[3] * 0.125f)};
                        *(u32x2*)p = lo; *(u32x2*)(p + 32) = hi;
                    } else if (blk < 20) {
                        const int g = blk - 16;
                        float* po = out + (smp ? O_KS : O_KP) + rl * 256 + g * 64 + 4 * q8;
                        *(f32x4*)po = (f32x4){r1[0], r1[1], r1[2], r1[3]}; *(f32x4*)(po + 32) = (f32x4){r2[0], r2[1], r2[2], r2[3]};
                        bf16_t* p = (smp ? KS : KP) + (((size_t)b * 4 + g) * L + pos) * 64 + 4 * q8;
                        u32x2 lo = {pk2(r1[0], r1[1]), pk2(r1[2], r1[3])}, hi = {pk2(r2[0], r2[1]), pk2(r2[2], r2[3])};
                        *(u32x2*)p = lo; *(u32x2*)(p + 32) = hi;
                    } else if (blk < 24) {
                        const int g = blk - 20;
                        float* po = out + (smp ? O_VS : O_VP) + rl * 256 + g * 64 + 8 * q8;
                        *(f32x4*)po = v0; *(f32x4*)(po + 4) = v1;
                        bf16_t* p = (smp ? VTS : VTP) + (((size_t)b * 4 + g) * 64 + 8 * q8) * L + pos;
                        const unsigned w0 = pk2(a0[0], a0[1]), w1 = pk2(a0[2], a0[3]), w2 = pk2(a1[0], a1[1]), w3 = pk2(a1[2], a1[3]);
                        p[0] = (bf16_t)w0; p[(size_t)L] = (bf16_t)(w0 >> 16); p[(size_t)2 * L] = (bf16_t)w1; p[(size_t)3 * L] = (bf16_t)(w1 >> 16);
                        p[(size_t)4 * L] = (bf16_t)w2; p[(size_t)5 * L] = (bf16_t)(w2 >> 16); p[(size_t)6 * L] = (bf16_t)w3; p[(size_t)7 * L] = (bf16_t)(w3 >> 16);
                    } else if (blk < 32) {
                        bf16_t* p = QI + (size_t)row * 512 + (blk - 24) * 64 + 4 * q8;
                        u32x2 lo = {pk2(r1[0] * 0.125f, r1[1] * 0.125f), pk2(r1[2] * 0.125f, r1[3] * 0.125f)}, hi = {pk2(r2[0] * 0.125f, r2[1] * 0.125f), pk2(r2[2] * 0.125f, r2[3] * 0.125f)};
                        *(u32x2*)p = lo; *(u32x2*)(p + 32) = hi;
                    } else if (blk == 32) {
                        float* po = out + (smp ? O_KIS : O_KIP) + rl * 64 + 4 * q8;
                        *(f32x4*)po = (f32x4){r1[0], r1[1], r1[2], r1[3]}; *(f32x4*)(po + 32) = (f32x4){r2[0], r2[1], r2[2], r2[3]};
                        bf16_t* p = (smp ? KIS : KIP) + ((size_t)b * L + pos) * 64 + 4 * q8;
                        u32x2 lo = {pk2(r1[0], r1[1]), pk2(r1[2], r1[3])}, hi = {pk2(r2[0], r2[1]), pk2(r2[2], r2[3])};
                        *(u32x2*)p = lo; *(u32x2*)(p + 32) = hi;
                    } else if (blk == 33 && q8 == 0) {
                        const float s = 0.35355339059327373f;
                        float* p = WI + (size_t)row * 8;
                        *(f32x4*)p = v0 * s; *(f32x4*)(p + 4) = v1 * s;
                    }
                }
            }
    }
};

DI int win_rowmap(int n) {
    const bool roped = (n < 1280) || (n >= 1536 && n < 2112);
    if (!roped) return n;
    const int j = n & 63, base = n & ~63;
    return base + (j < 32 ? 8 * (j >> 2) + (j & 3) : 8 * ((j - 32) >> 2) + 4 + (j & 3));
}
template <bool WINMAP>
DI void transpose_item(const float* W, int K, int N, bf16_t* WT, LAS float* scr, int item, int lane, const float* gk = nullptr) {
    const int nblk = (N + 31) / 32, kb = item / nblk, nb = item % nblk, k0 = 64 * kb, n0 = 32 * nb;
    const int ncol = n0 + (lane & 31);
#pragma unroll 8
    for (int i = 0; i < 32; ++i) { const int kk = 2 * i + (lane >> 5); float v = (ncol < N) ? W[(size_t)(k0 + kk) * N + ncol] : 0.f; if (gk) v *= gk[k0 + kk]; scr[kk * 33 + (lane & 31)] = v; }
    asm volatile("s_waitcnt lgkmcnt(0)" ::: "memory");
    const int c = lane & 7;
#pragma unroll
    for (int j = 0; j < 4; ++j) {
        const int nl = (lane >> 3) + 8 * j, n = n0 + nl;
        const LAS float* s = scr + (8 * c) * 33 + nl;
        u32x4 o; o.x = pk2(s[0], s[33]); o.y = pk2(s[2 * 33], s[3 * 33]); o.z = pk2(s[4 * 33], s[5 * 33]); o.w = pk2(s[6 * 33], s[7 * 33]);
        if (n < N) { const int rowo = WINMAP ? win_rowmap(n) : n; *(u32x4*)(WT + (size_t)rowo * K + k0 + 8 * c) = o; }
    }
    asm volatile("s_waitcnt lgkmcnt(0)" ::: "memory");
}

DI void phase0(const Args& a, LAS unsigned char* lds, int part, int vb, int VG) {
    const int tid = threadIdx.x, wave = tid >> 6, lane = tid & 63, G = VG;
    LAS float* scr = (LAS float*)(lds + wave * 8448);
    unsigned char* ws = a.ws;
    const int gw = vb * 8 + wave, NGW = G * 8;
    const bool pa = part & 1, pb = part & 2, pc = part & 4;
    constexpr int I_POOL = 4 * 4 * 8, I_WIN = 16 * 67, I_WO = 16 * 32, I_UP = 16 * 128, I_DN = 64 * 32;
    constexpr int NITEMS = I_POOL + I_WIN + I_WO + 2 * I_UP + 2 * I_DN;
    for (int it = gw; it < NITEMS; it += NGW) {
        int r = it;
        if (r < I_POOL) { if (!pa) continue; const int g = r >> 5; transpose_item<false>(a.in[9] + (size_t)g * 65536, 256, 256, (bf16_t*)(ws + WS_WPOOL) + (size_t)g * 65536, scr, r & 31, lane); continue; } r -= I_POOL;
        if (r < I_WIN) { if (!pb) continue; transpose_item<true>(a.in[11], 1024, 2120, (bf16_t*)(ws + WS_WIN), scr, r, lane, a.in[6] + D); continue; } r -= I_WIN;
        if (r < I_WO) { if (!pb) continue; transpose_item<false>(a.in[12], 1024, 1024, (bf16_t*)(ws + WS_WO), scr, r, lane); continue; } r -= I_WO;
        if (r < 2 * I_UP) { const int l = r / I_UP; if (!(l ? pb : pc)) continue; transpose_item<false>(a.in[13] + (size_t)l * 4194304, 1024, 4096, (bf16_t*)(ws + (l ? WS_WUP1 : WS_WUP0)), scr, r % I_UP, lane, a.in[7] + (size_t)l * D); continue; } r -= 2 * I_UP;
        { const int l = r / I_DN; if (!(l ? pb : pc)) continue; transpose_item<false>(a.in[14] + (size_t)l * 4194304, 4096, 1024, (bf16_t*)(ws + (l ? WS_WDN1 : WS_WDN0)), scr, r % I_DN, lane); }
    }
    if (!pb) return;
    const int gt = vb * 512 + tid, NGT = G * 512;
    { u32x4* z = (u32x4*)((bf16_t*)(ws + WS_WIN) + (size_t)2120 * 1024); const int n16 = (NWIN - 2120) * 1024 * 2 / 16;
      for (int i = gt; i < n16; i += NGT) z[i] = (u32x4){0u, 0u, 0u, 0u}; }
    { float* rt = (float*)(ws + WS_ROPE);
      for (int i = gt; i < LS * 32; i += NGT) {
          const int pos = i >> 5, f = i & 31;
          double inv = 1.0; for (int k = 0; k < f; ++k) inv *= 0.7498942093324559;
          double rev = (double)pos * inv * 0.15915494309189535; rev -= __builtin_rint(rev);
          const float fr = (float)rev;
          rt[2 * i] = __builtin_amdgcn_cosf(fr); rt[2 * i + 1] = __builtin_amdgcn_sinf(fr);
      } }
    { const float* src = a.in[5]; bf16_t* dst = (bf16_t*)(ws + WS_KIS);
      for (int i = gt; i < 16 * 2048 * 8; i += NGT) {
          const int b = i >> 14, s = (i >> 3) & 2047, d8 = i & 7;
          const f32x4 v0 = *(const f32x4*)(src + (size_t)i * 8), v1 = *(const f32x4*)(src + (size_t)i * 8 + 4);
          u32x4 o = {pk2(v0.x, v0.y), pk2(v0.z, v0.w), pk2(v1.x, v1.y), pk2(v1.z, v1.w)};
          *(u32x4*)(dst + ((size_t)b * LS + s) * 64 + d8 * 8) = o;
      } }
    { const float* src = a.in[3]; bf16_t* dst = (bf16_t*)(ws + WS_KS);
      for (int i = gt; i < 16 * 2048 * 4 * 8; i += NGT) {
          const int d8 = i & 7, g = (i >> 3) & 3, s = (i >> 5) & 2047, b = i >> 16;
          const f32x4 v0 = *(const f32x4*)(src + (size_t)i * 8), v1 = *(const f32x4*)(src + (size_t)i * 8 + 4);
          u32x4 o = {pk2(v0.x, v0.y), pk2(v0.z, v0.w), pk2(v1.x, v1.y), pk2(v1.z, v1.w)};
          *(u32x4*)(dst + (((size_t)b * 4 + g) * LS + s) * 64 + d8 * 8) = o;
      } }
    { const float* src = a.in[4]; bf16_t* dst = (bf16_t*)(ws + WS_VTS);
      for (int i = gt; i < 16 * 4 * 256 * 64; i += NGT) {
          const int d = i & 63, s8 = (i >> 6) & 255, g = (i >> 14) & 3, b = i >> 16;
          const float* p = src + (((size_t)b * 2048 + s8 * 8) * 4 + g) * 64 + d;
          float v[8];
#pragma unroll
          for (int j = 0; j < 8; ++j) v[j] = p[(size_t)j * 256];
          u32x4 o = {pk2(v[0], v[1]), pk2(v[2], v[3]), pk2(v[4], v[5]), pk2(v[6], v[7])};
          *(u32x4*)(dst + (((size_t)b * 4 + g) * 64 + d) * LS + s8 * 8) = o;
      } }
}

DI void phase1(const Args& a, LAS unsigned char* lds) {
    const int tid = threadIdx.x, half = tid >> 8, ht = tid & 255, wv = ht >> 6, lane = tid & 63, G = gridDim.x;
    LAS float* rs = (LAS float*)(lds) + half * 64;
    const float* gmix = a.in[6];
    bf16_t* Dout = (bf16_t*)(a.ws + WS_HA);
    const int c = 4 * ht;
    const f32x4 gq = *(const f32x4*)(gmix + c);
    const int win = 2 << wv;
    for (int base = blockIdx.x * 2; base < 2080; base += 2 * G) {
        const int it = base + half;
        const bool smp = it >= 2048;
        int b, t0, T; const float* xs; size_t rowbase;
        if (smp) { b = (it - 2048) >> 1; t0 = ((it - 2048) & 1) * 32; T = TS; xs = a.in[1] + (size_t)b * TS * D; rowbase = (size_t)NP + b * TS; }
        else { b = it >> 6; t0 = (it & 63) * 32; T = TP; xs = a.in[0] + (size_t)b * TP * D; rowbase = (size_t)b * TP; }
        const float* past = a.in[2] + (size_t)b * 15 * D;
        __syncthreads();
        for (int i = wv; i < 47; i += 4) {
            const int t = t0 + i - 15;
            if (t >= 0) {
                const f32x4* xr = (const f32x4*)(xs + (size_t)t * D) + lane;
                float s = 0.f;
#pragma unroll
                for (int j = 0; j < 4; ++j) { const f32x4 v = xr[64 * j]; s += (v.x * v.x + v.y * v.y) + (v.z * v.z + v.w * v.w); }
#pragma unroll
                for (int o = 1; o < 64; o <<= 1) s += __shfl_xor(s, o);
                if (lane == 0) rs[i] = __builtin_amdgcn_rsqf(s * (1.0f / 1024.0f) + EPS);
            }
        }
        __syncthreads();
        auto hrow = [&](int r) -> f32x4 {
            const int t = t0 + r;
            if (t < 0) { if (smp) return *(const f32x4*)(past + (size_t)(15 + t) * D + c); return (f32x4){0.f, 0.f, 0.f, 0.f}; }
            const f32x4 v = *(const f32x4*)(xs + (size_t)t * D + c);
            return v * rs[r + 15] * gq;
        };
        f32x4 S = {0.f, 0.f, 0.f, 0.f};
        for (int j = 1; j < win; ++j) S = S + hrow(-j);
        float* pout = a.out + (smp ? O_POOLS : O_POOLP) + (size_t)b * 15 * D + c;
#pragma unroll 4
        for (int r = 0; r < 32; ++r) {
            const f32x4 hv = hrow(r);
            S = S + hv;
            const int t = t0 + r;
            const int cnt = smp ? win : (t + 1 < win ? t + 1 : win);
            const float inv = 1.0f / (float)cnt;
            const f32x4 dv = S * inv - hv;
            u32x2 o = {pk2(dv.x, dv.y), pk2(dv.z, dv.w)};
            *(u32x2*)(Dout + (rowbase + t) * D + c) = o;
            if (t >= T - 15) *(f32x4*)(pout + (size_t)(t - (T - 15)) * D) = hv;
            S = S - hrow(r - win + 1);
        }
    }
}

DI unsigned fkey(float s) { s = s + 0.0f; const unsigned u = __float_as_uint(s); return (u & 0x80000000u) ? ~u : (u | 0x80000000u); }
DI unsigned row16_sum(unsigned v) {
    v += (unsigned)__builtin_amdgcn_update_dpp(0, (int)v, 0xB1, 0xf, 0xf, false);
    v += (unsigned)__builtin_amdgcn_update_dpp(0, (int)v, 0x4E, 0xf, 0xf, false);
    v += (unsigned)__builtin_amdgcn_update_dpp(0, (int)v, 0x124, 0xf, 0xf, false);
    v += (unsigned)__builtin_amdgcn_update_dpp(0, (int)v, 0x128, 0xf, 0xf, false);
    return v;
}
DI unsigned row16_max(unsigned v) {
    v = max(v, (unsigned)__builtin_amdgcn_update_dpp(0, (int)v, 0xB1, 0xf, 0xf, false));
    v = max(v, (unsigned)__builtin_amdgcn_update_dpp(0, (int)v, 0x4E, 0xf, 0xf, false));
    v = max(v, (unsigned)__builtin_amdgcn_update_dpp(0, (int)v, 0x124, 0xf, 0xf, false));
    v = max(v, (unsigned)__builtin_amdgcn_update_dpp(0, (int)v, 0x128, 0xf, 0xf, false));
    return v;
}
DI float unkey(unsigned k) { return __uint_as_float((k & 0x80000000u) ? (k & 0x7fffffffu) : ~k); }
DI unsigned count_ge(const unsigned (&kk)[66], unsigned c) {
    unsigned cnt = 0u;
#pragma unroll
    for (int t = 0; t < 66; ++t) asm volatile("v_cmp_ge_u32 vcc, %1, %2\n\tv_addc_co_u32 %0, vcc, 0, %0, vcc" : "+v"(cnt) : "v"(kk[t]), "v"(c) : "vcc");
    return cnt;
}
DI void select_write(const unsigned (&kk)[66], int nk, int hf, int j32, unsigned* mr) {
    unsigned mxk = 0u, mnk = 0xffffffffu;
#pragma unroll
    for (int t = 0; t < 66; ++t) { mxk = max(mxk, kk[t]); mnk = min(mnk, kk[t] - 1u); }
    mxk = row16_max(mxk); mnk = ~row16_max(~mnk);
    { const unsigned m0 = max((unsigned)__builtin_amdgcn_readlane((int)mxk, 0), (unsigned)__builtin_amdgcn_readlane((int)mxk, 16));
      const unsigned m1 = max((unsigned)__builtin_amdgcn_readlane((int)mxk, 32), (unsigned)__builtin_amdgcn_readlane((int)mxk, 48));
      mxk = hf ? m1 : m0;
      const unsigned n0 = min((unsigned)__builtin_amdgcn_readlane((int)mnk, 0), (unsigned)__builtin_amdgcn_readlane((int)mnk, 16));
      const unsigned n1 = min((unsigned)__builtin_amdgcn_readlane((int)mnk, 32), (unsigned)__builtin_amdgcn_readlane((int)mnk, 48));
      mnk = (hf ? n1 : n0) + 1u; }
    unsigned lo = mnk, hi = mxk + 1u;
    unsigned tau = 0u, thr = 0u; bool done = false;
    for (int it = 0; it < 80; ++it) {
        const unsigned span = hi - lo;
        unsigned c = (it < 16) ? fkey(0.5f * unkey(lo) + 0.5f * unkey(hi - 1u)) : lo + (span >> 1);
        c = max(c, lo + 1u); c = min(c, hi - 1u);
        if (done || span < 2u) c = lo;
        unsigned cnt = row16_sum(count_ge(kk, c));
        const unsigned nlo = (unsigned)__builtin_amdgcn_readlane((int)cnt, 0) + (unsigned)__builtin_amdgcn_readlane((int)cnt, 16);
        const unsigned nhi = (unsigned)__builtin_amdgcn_readlane((int)cnt, 32) + (unsigned)__builtin_amdgcn_readlane((int)cnt, 48);
        const unsigned n = hf ? nhi : nlo;
        if (!done) {
            if (span < 2u) { done = true; tau = lo; thr = 0u; }
            else if (n == 256u) { done = true; thr = c; tau = c; }
            else if (n > 256u) lo = c;
            else hi = c;
        }
        if (__ballot(!done) == 0ull) break;
    }
    done = thr != 0u;
    unsigned w[3] = {0u, 0u, 0u};
    if (__ballot(!done) == 0ull) {
#pragma unroll
        for (int t = 0; t < 66; ++t) {
            const unsigned long long bs = __ballot(kk[t] >= thr);
            const unsigned sw = hf ? (unsigned)(bs >> 32) : (unsigned)bs;
            if (j32 == (t & 31)) w[t >> 5] = sw;
        }
    } else {
        unsigned glo = 0u, ghi = 0u;
#pragma unroll
        for (int t = 0; t < 66; ++t) { const unsigned long long b = __ballot(kk[t] > tau); glo += __popc((unsigned)b); ghi += __popc((unsigned)(b >> 32)); }
        const unsigned r0 = 256u - (hf ? ghi : glo);
        unsigned tk = 0u;
        const unsigned below_mask = (1u << j32) - 1u;
#pragma unroll
        for (int t = 0; t < 66; ++t) {
            if (t < nk) {
                const bool eq = kk[t] == tau;
                const unsigned long long be = __ballot(eq);
                const unsigned e = hf ? (unsigned)(be >> 32) : (unsigned)be;
                const bool take = eq && (tk + __popc(e & below_mask) < r0);
                tk += __popc(e);
                const unsigned long long bs = __ballot((kk[t] > tau) || take);
                const unsigned sw = hf ? (unsigned)(bs >> 32) : (unsigned)bs;
                if (j32 == (t & 31)) w[t >> 5] = sw;
            }
        }
    }
    mr[j32] = w[0]; mr[32 + j32] = w[1];
    if (j32 < 2) mr[64 + j32] = w[2];
}
DI void phase_index(const Args& a, LAS unsigned char* lds) {
    const int tid = threadIdx.x, wave = __builtin_amdgcn_readfirstlane(tid >> 6), lane = tid & 63, hf = lane >> 5, j32 = lane & 31, G = gridDim.x;
    const bf16_t* QI = (const bf16_t*)(a.ws + WS_QI); const float* WI = (const float*)(a.ws + WS_WI);
    unsigned* MASK = (unsigned*)(a.ws + WS_MASK);
    LAS unsigned* lk = (LAS unsigned*)(lds + wave * 16896) + lane;
    constexpr int NIT = 32 + 2048;
    for (int base = 0, rnd = 0; base < NIT; base += G, ++rnd) {
        const int idx = (rnd & 1) ? (G - 1 - (int)blockIdx.x) : (int)blockIdx.x;
        const int pos = base + idx;
        if (pos >= NIT) continue;
        int nkt, rowbase; const bf16_t* KI;
        if (pos < 32) { const int b = pos >> 1; nkt = 66; rowbase = NP + b * 64 + (pos & 1) * 32; KI = (const bf16_t*)(a.ws + WS_KIS) + (size_t)b * LS * 64; }
        else { const int p = pos - 32, c = 31 - (p >> 6), b = (p & 63) >> 1; nkt = 2 * (c + 1); rowbase = b * 2048 + c * 64 + (p & 1) * 32; KI = (const bf16_t*)(a.ws + WS_KIP) + (size_t)b * 2048 * 64; }
        const int row0 = rowbase + wave * 4;
        unsigned* mr0 = MASK + (size_t)(row0 + hf) * MASKW; unsigned* mr1 = MASK + (size_t)(row0 + 2 + hf) * MASKW;
        if (nkt <= 8) {
            const unsigned w = (j32 < nkt) ? 0xffffffffu : 0u;
            mr0[j32] = w; mr0[32 + j32] = 0u; mr1[j32] = w; mr1[32 + j32] = 0u;
            if (j32 < 2) { mr0[64 + j32] = 0u; mr1[64 + j32] = 0u; }
            continue;
        }
        int nk = nkt; asm volatile("" : "+s"(nk));
        const int qq = 2 * (j32 >> 4) + ((j32 >> 2) & 1), hh = 4 * ((j32 >> 3) & 1) + (j32 & 3);
        bf16x8 aq[4];
        { const bf16_t* p = QI + (size_t)(row0 + qq) * 512 + hh * 64 + 8 * hf;
#pragma unroll
          for (int jj = 0; jj < 4; ++jj) aq[jj] = *(const bf16x8*)(p + 16 * jj); }
        float wv0[8], wv1[8];
        { const float* p0 = WI + (size_t)(row0 + hf) * 8; const float* p1 = WI + (size_t)(row0 + 2 + hf) * 8;
          const f32x4 x0 = *(const f32x4*)p0, x1 = *(const f32x4*)(p0 + 4), y0 = *(const f32x4*)p1, y1 = *(const f32x4*)(p1 + 4);
          wv0[0] = x0.x; wv0[1] = x0.y; wv0[2] = x0.z; wv0[3] = x0.w; wv0[4] = x1.x; wv0[5] = x1.y; wv0[6] = x1.z; wv0[7] = x1.w;
          wv1[0] = y0.x; wv1[1] = y0.y; wv1[2] = y0.z; wv1[3] = y0.w; wv1[4] = y1.x; wv1[5] = y1.y; wv1[6] = y1.z; wv1[7] = y1.w; }
        const char* kbase = (const char*)KI;
        const unsigned koff = (unsigned)(j32 * 64 + 8 * hf) * 2u;
        unsigned kk[66];
#pragma unroll
        for (int g = 0; g < 17; ++g) {
#pragma unroll
            for (int u = 0; u < 4; ++u) if (4 * g + u < 66) kk[4 * g + u] = 0u;
            if (4 * g < nk) {
                bf16x8 bt[4][4];
#pragma unroll
                for (int u = 0; u < 4; ++u) { const int tt = (4 * g + u < nk) ? 4 * g + u : nk - 1; const char* p = kbase + (size_t)tt * 4096 + koff;
#pragma unroll
                    for (int jj = 0; jj < 4; ++jj) bt[u][jj] = *(const bf16x8*)(p + 32 * jj); }
#pragma unroll
                for (int u = 0; u < 4; ++u) {
                    const int t = 4 * g + u;
                    if (t < 66) {
                        f32x16 acc;
#pragma unroll
                        for (int i = 0; i < 16; ++i) acc[i] = 0.f;
#pragma unroll
                        for (int jj = 0; jj < 4; ++jj) acc = __builtin_amdgcn_mfma_f32_32x32x16_bf16(aq[jj], bt[u][jj], acc, 0, 0, 0);
                        float s0 = 0.f, s1 = 0.f;
#pragma unroll
                        for (int i = 0; i < 8; ++i) {
                            s0 = __builtin_fmaf(__int_as_float(max(__float_as_int(acc[i]), 0)), wv0[i], s0);
                            s1 = __builtin_fmaf(__int_as_float(max(__float_as_int(acc[8 + i]), 0)), wv1[i], s1);
                        }
                        const bool live = t < nk;
                        kk[t] = live ? fkey(s0) : 0u;
                        lk[t * 64] = live ? fkey(s1) : 0u;
                    }
                }
            } else {
#pragma unroll
                for (int u = 0; u < 4; ++u) if (4 * g + u < 66) lk[(4 * g + u) * 64] = 0u;
            }
            __builtin_amdgcn_sched_barrier(0);
        }
        select_write(kk, nk, hf, j32, mr0);
#pragma unroll
        for (int t = 0; t < 66; ++t) kk[t] = lk[t * 64];
        select_write(kk, nk, hf, j32, mr1);
    }
}

DI void phase_attn(const Args& a, LAS unsigned char* lds) {
    const int tid = threadIdx.x, wave = __builtin_amdgcn_readfirstlane(tid >> 6), lane = tid & 63, hf = lane >> 5, j32 = lane & 31, G = gridDim.x;
    const bf16_t* Q = (const bf16_t*)(a.ws + WS_Q);
    const unsigned* MASK = (const unsigned*)(a.ws + WS_MASK);
    bf16_t* O = (bf16_t*)(a.ws + WS_HA);
    constexpr int NIT = 64 + 4096;
    constexpr float LOG2E = 1.4426950408889634f;
    constexpr int RS = 144, RSV = 528, KREG = 256 * RS, BUFB = KREG + 64 * RSV;
    const int th = wave >> 2, hd = wave & 3;
    const int pik = (j32 & 0x13) | ((j32 & 8) >> 1) | ((j32 & 4) << 1);
    const bf16x8 ones = {0x3f80, 0x3f80, 0x3f80, 0x3f80, 0x3f80, 0x3f80, 0x3f80, 0x3f80};
    const unsigned kread = (unsigned)(pik * RS + 16 * hf), vread = (unsigned)(KREG + j32 * RSV + 16 * hf);
    for (int base = 0, rnd = 0; base < NIT; base += G, ++rnd) {
        const int idx = (rnd & 1) ? (G - 1 - (int)blockIdx.x) : (int)blockIdx.x;
        const int pos = base + idx;
        if (pos >= NIT) continue;
        int nst, rowbase, L, g; const bf16_t *Kb, *Vt;
        if (pos < 64) { const int b = pos >> 2; g = pos & 3; nst = 33; L = LS; rowbase = NP + b * 64;
            Kb = (const bf16_t*)(a.ws + WS_KS) + ((size_t)b * 4 + g) * LS * 64; Vt = (const bf16_t*)(a.ws + WS_VTS) + ((size_t)b * 4 + g) * 64 * LS; }
        else { const int p = pos - 64, c = 31 - (p >> 7), b = (p & 127) >> 2; g = p & 3; nst = c + 1; L = 2048; rowbase = b * 2048 + c * 64;
            Kb = (const bf16_t*)(a.ws + WS_KP) + ((size_t)b * 4 + g) * 2048 * 64; Vt = (const bf16_t*)(a.ws + WS_VTP) + ((size_t)b * 4 + g) * 64 * 2048; }
        const int nbig = (nst + 3) >> 2;
        const int row = rowbase + th * 32 + j32, head = 4 * g + hd;
        bf16x8 qf[4];
        { const bf16_t* p = Q + (size_t)row * 1024 + head * 64 + 8 * hf;
#pragma unroll
          for (int jj = 0; jj < 4; ++jj) qf[jj] = *(const bf16x8*)(p + 16 * jj); }
        const unsigned* mrow = MASK + (size_t)row * MASKW;
        u32x4 kr[4], vr[4];
        auto stage_load = [&](int bs) __attribute__((always_inline)) {
#pragma unroll
            for (int i = 0; i < 4; ++i) {
                const int cid = tid + 512 * i;
                int kr_row = bs * 256 + (cid >> 3); kr_row = kr_row < L ? kr_row : L - 1;
                kr[i] = *(const u32x4*)(Kb + (size_t)kr_row * 64 + (cid & 7) * 8);
                int vcol = bs * 256 + (cid & 31) * 8; vcol = vcol < L - 8 ? vcol : L - 8;
                vr[i] = *(const u32x4*)(Vt + (size_t)(cid >> 5) * L + vcol);
            }
        };
        auto stage_store = [&](LAS unsigned char* buf) __attribute__((always_inline)) {
#pragma unroll
            for (int i = 0; i < 4; ++i) {
                const int cid = tid + 512 * i;
                *(LAS u32x4*)(buf + (cid >> 3) * RS + (cid & 7) * 16) = kr[i];
                *(LAS u32x4*)(buf + KREG + (cid >> 5) * RSV + (cid & 31) * 16) = vr[i];
            }
        };
        stage_load(0);
        f32x16 o0, o1, lacc;
#pragma unroll
        for (int i = 0; i < 16; ++i) { o0[i] = 0.f; o1[i] = 0.f; lacc[i] = 0.f; }
        float mrun = -1e30f;
        u32x4 mwa = *(const u32x4*)mrow, mwb = *(const u32x4*)(mrow + 4);
        __syncthreads();
        stage_store(lds);
        __syncthreads();
        for (int bs = 0; bs < nbig; ++bs) {
            LAS unsigned char* cur = lds + (bs & 1) * BUFB;
            const bool more = bs + 1 < nbig;
            if (more) stage_load(bs + 1);
            const unsigned mw8[8] = {mwa.x, mwa.y, mwa.z, mwa.w, mwb.x, mwb.y, mwb.z, mwb.w};
            if (more) { mwa = *(const u32x4*)(mrow + 8 * (bs + 1)); mwb = *(const u32x4*)(mrow + 8 * (bs + 1) + 4); }
            const int nv = (nst - 4 * bs) < 4 ? (nst - 4 * bs) : 4;
#pragma unroll
            for (int j = 0; j < 4; ++j) {
                if (j < nv) {
                    f32x16 sc[2];
                    {
                        bf16x8 kf[2][4];
#pragma unroll
                        for (int tt = 0; tt < 2; ++tt)
#pragma unroll
                            for (int jj = 0; jj < 4; ++jj) kf[tt][jj] = *(const LAS bf16x8*)(cur + kread + (j * 64 + tt * 32) * RS + 32 * jj);
#pragma unroll
                        for (int tt = 0; tt < 2; ++tt)
#pragma unroll
                            for (int i = 0; i < 16; ++i) sc[tt][i] = 0.f;
                        __builtin_amdgcn_s_setprio(1);
#pragma unroll
                        for (int jj = 0; jj < 4; ++jj)
#pragma unroll
                            for (int tt = 0; tt < 2; ++tt) sc[tt] = __builtin_amdgcn_mfma_f32_32x32x16_bf16(kf[tt][jj], qf[jj], sc[tt], 0, 0, 0);
                        __builtin_amdgcn_s_setprio(0);
                    }
                    float mx = __builtin_fmaxf(sc[0][0], sc[1][0]);
#pragma unroll
                    for (int i = 1; i < 16; ++i) mx = __builtin_fmaxf(__builtin_fmaxf(mx, sc[0][i]), sc[1][i]);
                    mx = xhalf_max(mx);
                    if (__ballot(mx > mrun + 8.0f) != 0ull) {
                        const float mnew = fmaxf(mrun, mx);
                        const float alpha = __builtin_amdgcn_exp2f((mrun - mnew) * LOG2E);
                        mrun = mnew;
#pragma unroll
                        for (int i = 0; i < 16; ++i) { o0[i] *= alpha; o1[i] *= alpha; lacc[i] *= alpha; }
                    }
                    const float nm = -mrun * LOG2E;
#pragma unroll
                    for (int tt = 0; tt < 2; ++tt) {
                        const unsigned mw = mw8[2 * j + tt] >> (8 * hf);
                        float p[16];
#pragma unroll
                        for (int i = 0; i < 16; ++i) {
                            const float e = __builtin_amdgcn_exp2f(__builtin_fmaf(sc[tt][i], LOG2E, nm));
                            const unsigned msk = (unsigned)__builtin_amdgcn_sbfe((int)mw, (i & 7) + 16 * (i >> 3), 1);
                            p[i] = __uint_as_float(__float_as_uint(e) & msk);
                        }
#pragma unroll
                        for (int s2 = 0; s2 < 2; ++s2) {
                            u32x4 pw = {pk2(p[8 * s2], p[8 * s2 + 1]), pk2(p[8 * s2 + 2], p[8 * s2 + 3]), pk2(p[8 * s2 + 4], p[8 * s2 + 5]), pk2(p[8 * s2 + 6], p[8 * s2 + 7])};
                            const bf16x8 pf = __builtin_bit_cast(bf16x8, pw);
                            const bf16x8 v0 = *(const LAS bf16x8*)(cur + vread + (j * 64 + tt * 32 + 16 * s2) * 2);
                            const bf16x8 v1 = *(const LAS bf16x8*)(cur + vread + 32 * RSV + (j * 64 + tt * 32 + 16 * s2) * 2);
                            o0 = __builtin_amdgcn_mfma_f32_32x32x16_bf16(v0, pf, o0, 0, 0, 0);
                            o1 = __builtin_amdgcn_mfma_f32_32x32x16_bf16(v1, pf, o1, 0, 0, 0);
                            lacc = __builtin_amdgcn_mfma_f32_32x32x16_bf16(ones, pf, lacc, 0, 0, 0);
                        }
                    }
                }
            }
            if (more) stage_store(lds + ((bs & 1) ^ 1) * BUFB);
            __syncthreads();
        }
        const float inv = 1.0f / lacc[0];
        bf16_t* op = O + (size_t)row * 1024 + head * 64 + 4 * hf;
#pragma unroll
        for (int q = 0; q < 4; ++q) {
            u32x2 x0 = {pk2(o0[4 * q] * inv, o0[4 * q + 1] * inv), pk2(o0[4 * q + 2] * inv, o0[4 * q + 3] * inv)};
            u32x2 x1 = {pk2(o1[4 * q] * inv, o1[4 * q + 1] * inv), pk2(o1[4 * q + 2] * inv, o1[4 * q + 3] * inv)};
            *(u32x2*)(op + 8 * q) = x0; *(u32x2*)(op + 32 + 8 * q) = x1;
        }
    }
}

DI void phase_final(const Args& a) {
    const int tid = threadIdx.x, wave = tid >> 6, lane = tid & 63, G = gridDim.x;
    const float* ss = (const float*)(a.ws + WS_SS1);
    const bf16_t* Xb = (const bf16_t*)(a.ws + WS_HB);
    const float* gf = a.in[8];
    f32x4 g0[2], g1[2];
#pragma unroll
    for (int j = 0; j < 2; ++j) { g0[j] = *(const f32x4*)(gf + (lane + 64 * j) * 8); g1[j] = *(const f32x4*)(gf + (lane + 64 * j) * 8 + 4); }
    for (int row = blockIdx.x * 8 + wave; row < NR; row += G * 8) {
        float s = ss[(size_t)row * 16 + (lane & 15)];
        s += __shfl_xor(s, 1); s += __shfl_xor(s, 2); s += __shfl_xor(s, 4); s += __shfl_xor(s, 8);
        const float rstd = __builtin_amdgcn_rsqf(s * (1.0f / 1024.0f) + EPS);
        const u32x4* hr = (const u32x4*)(Xb + (size_t)row * D) + lane;
        f32x4* yr = (f32x4*)(a.out + (size_t)row * D) + 2 * lane;
#pragma unroll
        for (int j = 0; j < 2; ++j) {
            const u32x4 h = hr[64 * j];
            f32x4 y0 = {__uint_as_float(h.x << 16), __uint_as_float(h.x & 0xffff0000u), __uint_as_float(h.y << 16), __uint_as_float(h.y & 0xffff0000u)};
            f32x4 y1 = {__uint_as_float(h.z << 16), __uint_as_float(h.z & 0xffff0000u), __uint_as_float(h.w << 16), __uint_as_float(h.w & 0xffff0000u)};
            yr[128 * j] = y0 * rstd * g0[j]; yr[128 * j + 1] = y1 * rstd * g1[j];
        }
    }
}

#define XB_TMO      128
#define XB_XCNT(j)  (256  + 64 * (j))
#define XB_XSUB(j)  (1280 + 64 * (j))
#define XB_XGEN(j)  (2304 + 64 * (j))
#define XB_TOP      3328
#define XB_TOPGEN   3392
#define XCD_BAR_WORDS 3456
#define XB_SPIN_CAP (1u << 20)
DI unsigned xb_ld(unsigned* p)              { return __hip_atomic_load(p, __ATOMIC_RELAXED, __HIP_MEMORY_SCOPE_AGENT); }
DI unsigned xb_add(unsigned* p, unsigned v) { return __hip_atomic_fetch_add(p, v, __ATOMIC_RELAXED, __HIP_MEMORY_SCOPE_AGENT); }
DI unsigned xb_xcc_id() { return (unsigned)__builtin_amdgcn_s_getreg((3 << 11) | 20) & 0xFu; }
#define XB_SPIN(cond, bar) do { unsigned _sp = 0; while (cond) { __builtin_amdgcn_s_sleep(1); \
    if ((++_sp & 255u) == 0u) { if (xb_ld(&(bar)[XB_TMO])) break; if (_sp > XB_SPIN_CAP) { atomicAdd(&(bar)[XB_TMO], 1u); break; } } } } while (0)
struct XcdBarrier { unsigned* bar; unsigned x; volatile LAS unsigned* st; };
DI XcdBarrier xcd_barrier_post(unsigned* bar, volatile LAS unsigned* st) {
    XcdBarrier b; b.bar = bar; b.x = xb_xcc_id(); b.st = st;
    if (threadIdx.x == 0) (void)xb_add(&bar[XB_XCNT(b.x)], 1u);
    return b;
}
DI void xcd_barrier_complete(unsigned* bar, unsigned x, unsigned& nloc, unsigned& nx) {
    const unsigned G = gridDim.x * gridDim.y * gridDim.z;
    unsigned sum, cnt, mine, sp = 0u;
    for (;;) {
        sum = 0u; cnt = 0u; mine = 0u;
#pragma unroll
        for (unsigned j = 0; j < 16; ++j) { const unsigned c = xb_ld(&bar[XB_XCNT(j)]); sum += c; cnt += (c > 0u) ? 1u : 0u; mine = (j == x) ? c : mine; }
        if (sum == G) break;
        __builtin_amdgcn_s_sleep(1);
        if ((++sp & 255u) == 0u) { if (xb_ld(&bar[XB_TMO])) break; if (sp > XB_SPIN_CAP) { atomicAdd(&bar[XB_TMO], 1u); break; } }
    }
    nloc = mine > 0u ? mine : 1u; nx = cnt > 0u ? cnt : 1u;
}
DI void xcd_barrier(const XcdBarrier& b) {
    asm volatile("s_waitcnt vmcnt(0)" ::: "memory");
    __syncthreads();
    if (threadIdx.x == 0) {
        unsigned* bar = b.bar;
        __builtin_amdgcn_s_waitcnt(0);
        unsigned nloc = b.st[0], nx = b.st[1];
        if (nloc == 0u) { xcd_barrier_complete(bar, b.x, nloc, nx); b.st[0] = nloc; b.st[1] = nx; }
        const unsigned old = xb_add(&bar[XB_XSUB(b.x)], 1u);
        const unsigned gen = old / nloc;
        if (old + 1u == (gen + 1u) * nloc) {
            __builtin_amdgcn_fence(__ATOMIC_RELEASE, "agent");
            asm volatile("s_waitcnt vmcnt(0)" ::: "memory");
            const unsigned og = xb_add(&bar[XB_TOP], 1u);
            const unsigned tg = og / nx;
            if (og + 1u == (tg + 1u) * nx) xb_add(&bar[XB_TOPGEN], 1u);
            else XB_SPIN(xb_ld(&bar[XB_TOPGEN]) == tg, bar);
            __builtin_amdgcn_fence(__ATOMIC_ACQUIRE, "agent");
            xb_add(&bar[XB_XGEN(b.x)], 1u);
            asm volatile("s_waitcnt vmcnt(0)" ::: "memory");
        } else {
            XB_SPIN(xb_ld(&bar[XB_XGEN(b.x)]) == gen, bar);
            __builtin_amdgcn_fence(__ATOMIC_ACQUIRE, "agent");
            asm volatile("s_waitcnt vmcnt(0)" ::: "memory");
        }
    }
    __syncthreads();
}

__global__ void __launch_bounds__(512, 2) fwd_kernel(Args a) {
    extern __shared__ __attribute__((aligned(16))) unsigned char lds_raw[];
    LAS unsigned char* lds = (LAS unsigned char*)lds_raw;
    cg::grid_group grid = cg::this_grid();
    volatile LAS unsigned* xst = (volatile LAS unsigned*)(lds + LDS_PHASE);
    if (threadIdx.x == 0) { xst[0] = 0u; xst[1] = 0u; }
    __syncthreads();
    const XcdBarrier xb = xcd_barrier_post((unsigned*)(a.ws + WS_BAR), xst);
    unsigned char* ws = a.ws;
    const int G = gridDim.x;
    pg8::StaticOrder S;
    float* ss0 = (float*)(ws + WS_SS0); float* ss1 = (float*)(ws + WS_SS1);
    bf16_t* HA = (bf16_t*)(ws + WS_HA); bf16_t* Xb = (bf16_t*)(ws + WS_HB); bf16_t* U = (bf16_t*)(ws + WS_U);
#ifndef PHMASK
#define PHMASK 0xfff
#endif
#ifndef PROBE_REP
#define PROBE_REP 0x0
#endif
#define PHASE(k) if (((PHMASK >> (k)) & 1) && (k) >= a.ph_lo && (k) < a.ph_hi)
#define SEAM(k) do { if ((k) >= a.ph_lo && (k) + 1 < a.ph_hi) xcd_barrier(xb); } while (0)
    const bool defer0 = (G == 256);
    PHASE(0) { phase0(a, lds, defer0 ? 1 : 7, blockIdx.x, G); phase1(a, lds); }
#if PROBE_REP & 0x1
    grid.sync(); phase0(a, lds, 7, blockIdx.x, G); phase1(a, lds);
#endif
    SEAM(0);
    PHASE(1) {
        pg8::Gemm g{HA, (const bf16_t*)(ws + WS_WPOOL), NR, 1024, 256, 1024, 256, 512};
        S.init(NR, 1024, G, blockIdx.x);
        EpiRes<true, true> E{a.in[0], a.in[1], Xb, a.in[10], ss0};
        pg8::gemm_phase(lds, g, S, E);
        if (defer0 && blockIdx.x >= 16) phase0(a, lds, 4, blockIdx.x - 16, 240);
    }
    SEAM(1);
    PHASE(2) {
        pg8::Gemm g{Xb, (const bf16_t*)(ws + WS_WUP0), NR, DFF, 1024, 1024, 1024, 0};
        S.init(NR, DFF, G, blockIdx.x);
        EpiUp E{ss0, U};
        pg8::gemm_phase(lds, g, S, E);
    }
    SEAM(2);
    PHASE(3) {
        pg8::Gemm g{U, (const bf16_t*)(ws + WS_WDN0), NR, 1024, DFF, DFF, DFF, 0};
        S.init(NR, 1024, G, blockIdx.x);
        EpiRes<false, false> E{nullptr, nullptr, Xb, nullptr, ss1};
        pg8::gemm_phase(lds, g, S, E);
        if (defer0 && blockIdx.x >= 16) phase0(a, lds, 2, blockIdx.x - 16, 240);
    }
    SEAM(3);
    PHASE(4) {
        pg8::Gemm g{Xb, (const bf16_t*)(ws + WS_WIN), NR, NWIN, 1024, 1024, 1024, 0};
        S.init(NR, NWIN, G, blockIdx.x);
        EpiWin E{ss1, (const float*)(ws + WS_ROPE), (bf16_t*)(ws + WS_Q), (bf16_t*)(ws + WS_QI), (bf16_t*)(ws + WS_KP), (bf16_t*)(ws + WS_VTP), (bf16_t*)(ws + WS_KIP),
                 (bf16_t*)(ws + WS_KS), (bf16_t*)(ws + WS_VTS), (bf16_t*)(ws + WS_KIS), (float*)(ws + WS_WI), a.out};
        pg8::gemm_phase(lds, g, S, E);
    }
    SEAM(4);
    PHASE(5) { phase_index(a, lds); }
    SEAM(5);
    PHASE(6) { phase_attn(a, lds); }
    SEAM(6);
    PHASE(7) {
        pg8::Gemm g{HA, (const bf16_t*)(ws + WS_WO), NR, 1024, 1024, 1024, 1024, 0};
        S.init(NR, 1024, G, blockIdx.x);
        EpiRes<false, false> E{nullptr, nullptr, Xb, nullptr, ss0};
        pg8::gemm_phase(lds, g, S, E);
    }
    SEAM(7);
    PHASE(8) {
        pg8::Gemm g{Xb, (const bf16_t*)(ws + WS_WUP1), NR, DFF, 1024, 1024, 1024, 0};
        S.init(NR, DFF, G, blockIdx.x);
        EpiUp E{ss0, U};
        pg8::gemm_phase(lds, g, S, E);
    }
    SEAM(8);
    PHASE(9) {
        pg8::Gemm g{U, (const bf16_t*)(ws + WS_WDN1), NR, 1024, DFF, DFF, DFF, 0};
        S.init(NR, 1024, G, blockIdx.x);
        EpiRes<false, false> E{nullptr, nullptr, Xb, nullptr, ss1};
        pg8::gemm_phase(lds, g, S, E);
    }
    SEAM(9);
    PHASE(10) { phase_final(a); }
    if (a.ph_hi > 1000) grid.sync();
}

#ifndef N_LAUNCHES
#define N_LAUNCHES 1
#endif
extern "C" void kernel_launch(void* const* d_in, const int* in_sizes, int n_in, void* d_out, int out_size, void* d_ws, size_t ws_size, hipStream_t stream) {
    static int grid = 0;
    if (grid == 0) {
        if (n_in != 15 || out_size != 107233280 || ws_size < WS_END) { fprintf(stderr, "kernel_launch: unexpected shapes (n_in %d out %d ws %zu need %zu)\n", n_in, out_size, ws_size, (size_t)WS_END); grid = -1; return; }
        int dev = 0, cus = 0, per_cu = 0;
        hipGetDevice(&dev); hipDeviceGetAttribute(&cus, hipDeviceAttributeMultiprocessorCount, dev);
        if (hipFuncSetAttribute((const void*)fwd_kernel, hipFuncAttributeMaxDynamicSharedMemorySize, LDS_BYTES) != hipSuccess) { fprintf(stderr, "kernel_launch: hipFuncSetAttribute failed\n"); grid = -1; return; }
        hipOccupancyMaxActiveBlocksPerMultiprocessor(&per_cu, (const void*)fwd_kernel, 512, LDS_BYTES);
        if (per_cu < 1) { fprintf(stderr, "kernel_launch: occupancy query says %d\n", per_cu); per_cu = 1; }
        (void)hipGetLastError();
        grid = cus;
    }
    if (grid < 0) return;
    if (hipMemsetAsync((char*)d_ws + WS_BAR, 0, XCD_BAR_WORDS * 4, stream) != hipSuccess) { fprintf(stderr, "kernel_launch: memset of the barrier words failed\n"); return; }
    Args a{};
    for (int i = 0; i < 15; ++i) a.in[i] = (const float*)d_in[i];
    a.out = (float*)d_out; a.ws = (unsigned char*)d_ws;
#if N_LAUNCHES == 1
    a.ph_lo = 0; a.ph_hi = 11;
    void* args[] = {&a};
    hipError_t e = hipLaunchCooperativeKernel((const void*)fwd_kernel, dim3(grid), dim3(512), args, LDS_BYTES, stream);
    if (e != hipSuccess) fprintf(stderr, "cooperative launch failed: %s (grid %d)\n", hipGetErrorString(e), grid);
#else
    for (int ph = 0; ph < 11; ++ph) { a.ph_lo = ph; a.ph_hi = ph + 1; hipLaunchKernelGGL(fwd_kernel, dim3(grid), dim3(512), LDS_BYTES, stream, a); }
#endif
}
```

```cpp
#include <hip/hip_runtime.h>
#include <hip/hip_cooperative_groups.h>
#include <cstdio>
#include <cstdint>
namespace cg = cooperative_groups;

#define LAS __attribute__((address_space(3)))
#define DI __device__ __forceinline__
typedef unsigned short bf16_t;
typedef short bf16x8 __attribute__((ext_vector_type(8)));
typedef float f32x2 __attribute__((ext_vector_type(2)));
typedef float f32x4 __attribute__((ext_vector_type(4)));
typedef float f32x16 __attribute__((ext_vector_type(16)));
typedef unsigned u32x2 __attribute__((ext_vector_type(2)));
typedef unsigned u32x4 __attribute__((ext_vector_type(4)));
typedef __bf16 bfv2 __attribute__((ext_vector_type(2)));

constexpr int D = 1024, NP = 65536, NS = 1024, NR = NP + NS, TP = 2048, TS = 64, LS = 2112, DFF = 4096;
constexpr int NWIN = 2304;
constexpr int MASKW = 68;
constexpr float EPS = 1e-6f;
constexpr size_t O_Y = 0, O_POOLP = 68157440, O_POOLS = 68648960, O_KP = 68894720, O_VP = 85671936, O_KIP = 102449152,
                 O_KS = 106643456, O_VS = 106905600, O_KIS = 107167744;
constexpr size_t WS_WPOOL = 0;
constexpr size_t WS_WIN = WS_WPOOL + 524288;
constexpr size_t WS_WO = WS_WIN + (size_t)NWIN * 1024 * 2;
constexpr size_t WS_WUP0 = WS_WO + 2097152;
constexpr size_t WS_WUP1 = WS_WUP0 + 8388608;
constexpr size_t WS_WDN0 = WS_WUP1 + 8388608;
constexpr size_t WS_WDN1 = WS_WDN0 + 8388608;
constexpr size_t WS_ROPE = WS_WDN1 + 8388608;
constexpr size_t WS_SS0 = WS_ROPE + 540672;
constexpr size_t WS_SS1 = WS_SS0 + (size_t)NR * 64;
constexpr size_t WS_KS = WS_SS1 + (size_t)NR * 64;
constexpr size_t WS_VTS = WS_KS + (size_t)16 * 4 * LS * 64 * 2;
constexpr size_t WS_KIS = WS_VTS + (size_t)16 * 4 * LS * 64 * 2;
constexpr size_t WS_HA = WS_KIS + (size_t)16 * LS * 64 * 2;
constexpr size_t WS_HB = WS_HA + (size_t)NR * 1024 * 2;
constexpr size_t WS_U = WS_HB + (size_t)NR * 1024 * 2;
constexpr size_t WS_BAR = WS_U + (size_t)NR * 4096 * 2;
constexpr size_t WS_END = WS_BAR + 16384;
constexpr size_t WS_Q = WS_U;
constexpr size_t WS_QI = WS_Q + (size_t)NR * 1024 * 2;
constexpr size_t WS_KP = WS_QI + (size_t)NR * 512 * 2;
constexpr size_t WS_VTP = WS_KP + (size_t)32 * 4 * 2048 * 64 * 2;
constexpr size_t WS_KIP = WS_VTP + (size_t)32 * 4 * 2048 * 64 * 2;
constexpr size_t WS_WI = WS_KIP + (size_t)32 * 2048 * 64 * 2;
constexpr size_t WS_MASK = WS_WI + (size_t)NR * 8 * 4;
constexpr size_t WS_ALIAS_END = WS_MASK + (size_t)NR * MASKW * 4;
static_assert(WS_ALIAS_END <= WS_BAR, "alias overflow");

constexpr int LDS_PHASE = 141312;
constexpr int LDS_BYTES = LDS_PHASE + 16;

struct Args {
    const float* in[15];
    float* out;
    unsigned char* ws;
    int ph_lo, ph_hi;
};

DI unsigned pk2(float lo, float hi) { f32x2 v = {lo, hi}; bfv2 b = __builtin_convertvector(v, bfv2); return __builtin_bit_cast(unsigned, b); }
DI float bf2f(bf16_t b) { return __uint_as_float(((unsigned)b) << 16); }
DI float xhalf_max(float x) {
    auto r = __builtin_amdgcn_permlane32_swap(__float_as_uint(x), __float_as_uint(x), false, false);
    return fmaxf(__uint_as_float(r[0]), __uint_as_float(r[1]));
}
DI float xhalf_sum(float x) {
    auto r = __builtin_amdgcn_permlane32_swap(__float_as_uint(x), __float_as_uint(x), false, false);
    return __uint_as_float(r[0]) + __uint_as_float(r[1]);
}

namespace pg8 {
constexpr int BM = 256, BK = 64, HALF = 128, HTB = HALF * BK * 2, STAGE_BYTES = 8 * HTB, NXCD = 8, WGM = 8;
DI int lds_byte(int r, int c) { const int st = (r >> 4) * 2 + (c >> 5), rr = r & 15, cc = c & 31, ob = rr * 64 + cc * 2; return st * 1024 + (ob ^ (((ob >> 9) & 1) << 5)); }
DI void stage_rc(int b, int& R, int& C) { const int st = b / 1024, sb = b % 1024, swz = sb ^ (((sb >> 9) & 1) << 5); R = (st >> 1) * 16 + swz / 64; C = (st & 1) * 32 + (swz % 64) / 2; }
DI int perm32(int rho) { const int n = rho >> 4, i = rho & 15; return 8 * (i >> 2) + 4 * n + (i & 3); }
struct Unit { int pm, pn; };
struct Gemm { const bf16_t* A; const bf16_t* Bt; int M, N, K, lda, ldb, a_pn_bytes; };
struct StaticOrder {
    int nM, nN, nwg, G, c;
    DI void init(int M, int N, int G_, int c_) { nM = M / BM; nN = N / BM; nwg = nM * nN; G = G_; c = c_; }
    DI bool next(int i, Unit& u) const {
        const long L = (long)i * G + c; if (L >= nwg) return false;
        int wgid = (int)L; { const int q = nwg / NXCD, r = nwg % NXCD, xcd = wgid % NXCD, off = wgid / NXCD; wgid = (xcd < r ? xcd * (q + 1) : r * (q + 1) + (xcd - r) * q) + off; }
        const int nig = WGM * nN, gid = wgid / nig, fm = gid * WGM, gsz = (nM - fm) < WGM ? (nM - fm) : WGM;
        u.pm = fm + ((wgid % nig) % gsz); u.pn = (wgid % nig) / gsz; return true;
    }
};

template <class Epi>
DI void gemm_phase(LAS unsigned char* lds, const Gemm g, const StaticOrder& S, const Epi& E) {
    const int tid = threadIdx.x, wid = __builtin_amdgcn_readfirstlane(tid >> 6), lane = tid & 63, wr = wid >> 2, wc = wid & 3, fr = lane & 15, fq = lane >> 4;
    const int K = g.K, nt = K / BK;
    unsigned voffA[2], voffB[2];
#pragma unroll
    for (int i = 0; i < 2; ++i) { int R, C; stage_rc(tid * 16 + i * 8192, R, C); const int Rb = (R & ~31) + perm32(R & 31);
        voffA[i] = (unsigned)(R * g.lda + C) * 2u; voffB[i] = (unsigned)(Rb * g.ldb + C) * 2u; }
    const size_t kstep = (size_t)(BK * 2);
    const size_t hstepA = (size_t)HALF * g.lda * 2, hstepB = (size_t)HALF * g.ldb * 2;
    const size_t tstepA = 2 * hstepA, tstepB = 2 * hstepB;
    const unsigned ldsw = (unsigned)wid * 1024u;
    const int aoff = lds_byte(wr * 64 + fr, fq * 8), boff = lds_byte(wc * 32 + fr, fq * 8);
#define PG8_SA(b, h) (((b) * 2 + (h)) * HTB)
#define PG8_SB(b, h) ((4 + (b) * 2 + (h)) * HTB)
#define PG8_STAGE(bufoff, gbase, voff) do { _Pragma("unroll") for (int _i = 0; _i < 2; ++_i) \
        __builtin_amdgcn_global_load_lds((const unsigned*)((const char*)(gbase) + (voff)[_i]), (LAS unsigned*)(lds + (bufoff) + ldsw + _i * 8192), 16, 0, 0); } while (0)
#define PG8_LDA(dst, b, h) do { _Pragma("unroll") for (int m = 0; m < 4; ++m) _Pragma("unroll") for (int k = 0; k < 2; ++k) dst[m][k] = *(const LAS bf16x8*)(lds + PG8_SA(b, h) + aoff + m * 2048 + k * 1024); } while (0)
#define PG8_LDB(dst, b, h) do { _Pragma("unroll") for (int n = 0; n < 2; ++n) _Pragma("unroll") for (int k = 0; k < 2; ++k) dst[n][k] = *(const LAS bf16x8*)(lds + PG8_SB(b, h) + boff + n * 2048 + k * 1024); } while (0)
#define PG8_MMA(ai, bj, At, Bt) do { __builtin_amdgcn_s_setprio(1); _Pragma("unroll") for (int m = 0; m < 4; ++m) _Pragma("unroll") for (int n = 0; n < 2; ++n) _Pragma("unroll") for (int k = 0; k < 2; ++k) \
        acc[ai][bj][m][n] = __builtin_amdgcn_mfma_f32_16x16x32_bf16(Bt[n][k], At[m][k], acc[ai][bj][m][n], 0, 0, 0); __builtin_amdgcn_s_setprio(0); } while (0)
#define PG8_WAIT_V(n) asm volatile("s_waitcnt vmcnt(" #n ")" ::: "memory")
#define PG8_WAIT_L(n) asm volatile("s_waitcnt lgkmcnt(" #n ")" ::: "memory")
#define PG8_BAR __builtin_amdgcn_s_barrier()
#define PG8_SCHED __builtin_amdgcn_sched_barrier(0)
    Unit cur, nxt; int ui = 0;
    if (!S.next(0, cur)) return;
    f32x4 acc[2][2][4][2];
#pragma unroll
    for (int a = 0; a < 2; ++a)
#pragma unroll
        for (int b = 0; b < 2; ++b)
#pragma unroll
            for (int m = 0; m < 4; ++m)
#pragma unroll
                for (int n = 0; n < 2; ++n) acc[a][b][m][n] = (f32x4){0.f, 0.f, 0.f, 0.f};
    bf16x8 At[4][2], B0[2][2], B1[2][2];
    const char* cA = (const char*)g.A + (size_t)cur.pm * tstepA + (size_t)cur.pn * g.a_pn_bytes; const char* cB = (const char*)g.Bt + (size_t)cur.pn * tstepB;
    PG8_STAGE(PG8_SB(0, 0), cB, voffB); PG8_STAGE(PG8_SB(0, 1), cB + hstepB, voffB); PG8_STAGE(PG8_SA(0, 0), cA, voffA); PG8_STAGE(PG8_SA(0, 1), cA + hstepA, voffA);
    if (wr == 1) PG8_BAR;
    PG8_WAIT_V(2); PG8_BAR;
    PG8_STAGE(PG8_SB(1, 0), cB + kstep, voffB); PG8_STAGE(PG8_SA(1, 0), cA + kstep, voffA); PG8_STAGE(PG8_SB(1, 1), cB + hstepB + kstep, voffB);
    PG8_WAIT_V(6); PG8_BAR;
    for (;;) {
        const bool has_next = S.next(ui + 1, nxt);
        const char* nA = has_next ? (const char*)g.A + (size_t)nxt.pm * tstepA + (size_t)nxt.pn * g.a_pn_bytes : cA; const char* nB = has_next ? (const char*)g.Bt + (size_t)nxt.pn * tstepB : cB;
#pragma unroll 1
        for (int t = 0; t < nt; t += 2) {
            const bool last = (t == nt - 2);
            const char* a1 = cA + (size_t)(t + 1) * kstep;
            const char* a2 = last ? nA : cA + (size_t)(t + 2) * kstep; const char* b2 = last ? nB : cB + (size_t)(t + 2) * kstep;
            const char* a3 = a2 + kstep; const char* b3 = b2 + kstep;
            PG8_LDB(B0, 0, 0); PG8_LDB(B1, 0, 1); PG8_SCHED; PG8_LDA(At, 0, 0); PG8_STAGE(PG8_SA(1, 1), a1 + hstepA, voffA);
            PG8_WAIT_V(8); PG8_WAIT_L(0); PG8_BAR; PG8_MMA(0, 0, At, B0); PG8_MMA(0, 1, At, B1); PG8_BAR; PG8_SCHED;
            PG8_LDA(At, 0, 1); PG8_STAGE(PG8_SB(0, 0), b2, voffB); PG8_STAGE(PG8_SB(0, 1), b2 + hstepB, voffB); PG8_STAGE(PG8_SA(0, 0), a2, voffA);
            PG8_WAIT_V(8); PG8_WAIT_L(0); PG8_BAR; PG8_MMA(1, 0, At, B0); PG8_MMA(1, 1, At, B1); PG8_BAR; PG8_SCHED;
            PG8_LDB(B0, 1, 0); PG8_LDB(B1, 1, 1); PG8_SCHED; PG8_LDA(At, 1, 0); PG8_STAGE(PG8_SA(0, 1), a2 + hstepA, voffA);
            PG8_WAIT_V(8); PG8_WAIT_L(0); PG8_BAR; PG8_MMA(0, 0, At, B0); PG8_MMA(0, 1, At, B1); PG8_BAR; PG8_SCHED;
            PG8_LDA(At, 1, 1); PG8_STAGE(PG8_SB(1, 0), b3, voffB); PG8_STAGE(PG8_SB(1, 1), b3 + hstepB, voffB); PG8_STAGE(PG8_SA(1, 0), a3, voffA);
            PG8_WAIT_V(8); PG8_WAIT_L(0); PG8_BAR; PG8_MMA(1, 0, At, B0); PG8_MMA(1, 1, At, B1); PG8_BAR; PG8_SCHED;
        }
        if (wr == 0) PG8_BAR;
        E(acc, cur, wr, wc, fr, fq);
        if (!has_next) break;
#pragma unroll
        for (int a = 0; a < 2; ++a)
#pragma unroll
            for (int b = 0; b < 2; ++b)
#pragma unroll
                for (int m = 0; m < 4; ++m)
#pragma unroll
                    for (int n = 0; n < 2; ++n) acc[a][b][m][n] = (f32x4){0.f, 0.f, 0.f, 0.f};
        cur = nxt; cA = nA; cB = nB; ++ui;
        if (wr == 1) PG8_BAR;
    }
    PG8_WAIT_V(0);
    PG8_BAR;
#undef PG8_SA
#undef PG8_SB
#undef PG8_STAGE
#undef PG8_LDA
#undef PG8_LDB
#undef PG8_MMA
#undef PG8_WAIT_V
#undef PG8_WAIT_L
#undef PG8_BAR
#undef PG8_SCHED
}
}
using pg8::Unit;

DI float row_rstd(const float* ss, int row) {
    const f32x4* p = (const f32x4*)(ss + (size_t)row * 16);
    f32x4 a = p[0], b = p[1], c = p[2], d = p[3];
    const float s = ((a.x + a.y) + (a.z + a.w)) + ((b.x + b.y) + (b.z + b.w)) + ((c.x + c.y) + (c.z + c.w)) + ((d.x + d.y) + (d.z + d.w));
    return __builtin_amdgcn_rsqf(s * (1.0f / 1024.0f) + EPS);
}

template <bool HAS_SCALE, bool IN_F32>
struct EpiRes {
    const float* xin_p; const float* xin_s; bf16_t* X; const float* colscale; float* ss;
    DI void operator()(const f32x4 (&acc)[2][2][4][2], const Unit& u, int wr, int wc, int fr, int fq) const {
        const int col0 = u.pn * 256 + wc * 32 + 8 * fq;
        float sq[2][4];
#pragma unroll
        for (int ai = 0; ai < 2; ++ai)
#pragma unroll
            for (int m = 0; m < 4; ++m) sq[ai][m] = 0.f;
#pragma unroll
        for (int bj = 0; bj < 2; ++bj) {
            const int col = col0 + bj * 128;
            f32x4 sc0, sc1;
            if (HAS_SCALE) { sc0 = *(const f32x4*)(colscale + col); sc1 = *(const f32x4*)(colscale + col + 4); }
#pragma unroll
            for (int ai = 0; ai < 2; ++ai)
#pragma unroll
                for (int m = 0; m < 4; ++m) {
                    const int row = u.pm * 256 + ai * 128 + wr * 64 + m * 16 + fr;
                    bf16_t* xb = X + (size_t)row * D + col;
                    f32x4 x0, x1;
                    if (IN_F32) {
                        const float* xr = (row < NP) ? xin_p + (size_t)row * D : xin_s + (size_t)(row - NP) * D;
                        x0 = *(const f32x4*)(xr + col); x1 = *(const f32x4*)(xr + col + 4);
                    } else {
                        const u32x4 h = *(const u32x4*)xb;
                        x0 = (f32x4){__uint_as_float(h.x << 16), __uint_as_float(h.x & 0xffff0000u), __uint_as_float(h.y << 16), __uint_as_float(h.y & 0xffff0000u)};
                        x1 = (f32x4){__uint_as_float(h.z << 16), __uint_as_float(h.z & 0xffff0000u), __uint_as_float(h.w << 16), __uint_as_float(h.w & 0xffff0000u)};
                    }
                    f32x4 y0 = acc[ai][bj][m][0], y1 = acc[ai][bj][m][1];
                    if (HAS_SCALE) { y0 = y0 * sc0; y1 = y1 * sc1; }
                    x0 = x0 + y0; x1 = x1 + y1;
                    sq[ai][m] += (x0.x * x0.x + x0.y * x0.y) + (x0.z * x0.z + x0.w * x0.w) + (x1.x * x1.x + x1.y * x1.y) + (x1.z * x1.z + x1.w * x1.w);
                    u32x4 o; o.x = pk2(x0.x, x0.y); o.y = pk2(x0.z, x0.w); o.z = pk2(x1.x, x1.y); o.w = pk2(x1.z, x1.w);
                    *(u32x4*)xb = o;
                }
        }
#pragma unroll
        for (int ai = 0; ai < 2; ++ai)
#pragma unroll
            for (int m = 0; m < 4; ++m) {
                const int row = u.pm * 256 + ai * 128 + wr * 64 + m * 16 + fr;
                float q = sq[ai][m];
                q += __shfl_xor(q, 16); q += __shfl_xor(q, 32);
                if (fq == 0) ss[(size_t)row * 16 + u.pn * 4 + wc] = q;
            }
    }
};

struct EpiUp {
    const float* ss; bf16_t* U;
    DI void operator()(const f32x4 (&acc)[2][2][4][2], const Unit& u, int wr, int wc, int fr, int fq) const {
        const int col0 = u.pn * 256 + wc * 32 + 8 * fq;
#pragma unroll
        for (int ai = 0; ai < 2; ++ai)
#pragma unroll
            for (int m = 0; m < 4; ++m) {
                const int row = u.pm * 256 + ai * 128 + wr * 64 + m * 16 + fr;
                const float rstd = row_rstd(ss, row);
#pragma unroll
                for (int bj = 0; bj < 2; ++bj) {
                    f32x4 v0 = acc[ai][bj][m][0] * rstd, v1 = acc[ai][bj][m][1] * rstd;
                    float e[8] = {v0.x, v0.y, v0.z, v0.w, v1.x, v1.y, v1.z, v1.w};
#pragma unroll
                    for (int i = 0; i < 8; ++i) { const float r = fmaxf(e[i], 0.f); e[i] = r * r; }
                    u32x4 o; o.x = pk2(e[0], e[1]); o.y = pk2(e[2], e[3]); o.z = pk2(e[4], e[5]); o.w = pk2(e[6], e[7]);
                    *(u32x4*)(U + (size_t)row * DFF + col0 + bj * 128) = o;
                }
            }
    }
};

struct EpiWin {
    const float* ss; const float* rope;
    bf16_t *Q, *QI, *KP, *VTP, *KIP, *KS, *VTS, *KIS; float* WI; float* out;
    DI void operator()(const f32x4 (&acc)[2][2][4][2], const Unit& u, int wr, int wc, int fr, int fq) const {
        const int q8 = (wc & 1) * 4 + fq;
        const bool smp = u.pm >= 256;
#pragma unroll
        for (int ai = 0; ai < 2; ++ai)
#pragma unroll
            for (int m = 0; m < 4; ++m) {
                const int row = u.pm * 256 + ai * 128 + wr * 64 + m * 16 + fr;
                const float rstd = row_rstd(ss, row);
                int b, pos, L; size_t rl;
                if (smp) { const int rs = row - NP; b = rs >> 6; pos = 2048 + (rs & 63); L = LS; rl = rs; } else { b = row >> 11; pos = row & 2047; L = 2048; rl = row; }
                const f32x4 cs0 = *(const f32x4*)(rope + ((size_t)pos * 32 + 4 * q8) * 2), cs1 = *(const f32x4*)(rope + ((size_t)pos * 32 + 4 * q8) * 2 + 4);
                const float cc[4] = {cs0.x, cs0.z, cs1.x, cs1.z}, sn[4] = {cs0.y, cs0.w, cs1.y, cs1.w};
#pragma unroll
                for (int bj = 0; bj < 2; ++bj) {
                    const int blk = u.pn * 4 + bj * 2 + (wc >> 1);
                    const f32x4 v0 = acc[ai][bj][m][0] * rstd, v1 = acc[ai][bj][m][1] * rstd;
                    const float a0[4] = {v0.x, v0.y, v0.z, v0.w}, a1[4] = {v1.x, v1.y, v1.z, v1.w};
                    float r1[4], r2[4];
#pragma unroll
                    for (int i = 0; i < 4; ++i) { r1[i] = a0[i] * cc[i] - a1[i] * sn[i]; r2[i] = a1[i] * cc[i] + a0[i] * sn[i]; }
                    if (blk < 16) {
                        bf16_t* p = Q + (size_t)row * 1024 + blk * 64 + 4 * q8;
                        u32x2 lo = {pk2(r1[0] * 0.125f, r1[1] * 0.125f), pk2(r1[2] * 0.125f, r1[3] * 0.125f)}, hi = {pk2(r2[0] * 0.125f, r2[1] * 0.125f), pk2(r2[2] * 0.125f, r2[3] * 0.125f)};
                        *(u32x2*)p = lo; *(u32x2*)(p + 32) = hi;
                    } else if (blk < 20) {
                        const int g = blk - 16;
                        float* po = out + (smp ? O_KS : O_KP) + rl * 256 + g * 64 + 4 * q8;
                        *(f32x4*)po = (f32x4){r1[0], r1[1], r1[2], r1[3]}; *(f32x4*)(po + 32) = (f32x4){r2[0], r2[1], r2[2], r2[3]};
                        bf16_t* p = (smp ? KS : KP) + (((size_t)b * 4 + g) * L + pos) * 64 + 4 * q8;
                        u32x2 lo = {pk2(r1[0], r1[1]), pk2(r1[2], r1[3])}, hi = {pk2(r2[0], r2[1]), pk2(r2[2], r2[3])};
                        *(u32x2*)p = lo; *(u32x2*)(p + 32) = hi;
                    } else if (blk < 24) {
                        const int g = blk - 20;
                        float* po = out + (smp ? O_VS : O_VP) + rl * 256 + g * 64 + 8 * q8;
                        *(f32x4*)po = v0; *(f32x4*)(po + 4) = v1;
                        bf16_t* p = (smp ? VTS : VTP) + (((size_t)b * 4 + g) * 64 + 8 * q8) * L + pos;
                        const unsigned w0 = pk2(a0[0], a0[1]), w1 = pk2(a0[2], a0[3]), w2 = pk2(a1[0], a1[1]), w3 = pk2(a1[2], a1[3]);
                        p[0] = (bf16_t)w0; p[(size_t)L] = (bf16_t)(w0 >> 16); p[(size_t)2 * L] = (bf16_t)w1; p[(size_t)3 * L] = (bf16_t)(w1 >> 16);
                        p[(size_t)4 * L] = (bf16_t)w2; p[(size_t)5 * L] = (bf16_t)(w2 >> 16); p[(size_t)6 * L] = (bf16_t)w3; p[(size_t)7 * L] = (bf16_t)(w3 >> 16);
                    } else if (blk < 32) {
                        bf16_t* p = QI + (size_t)row * 512 + (blk - 24) * 64 + 4 * q8;
                        u32x2 lo = {pk2(r1[0] * 0.125f, r1[1] * 0.125f), pk2(r1[2] * 0.125f, r1[3] * 0.125f)}, hi = {pk2(r2[0] * 0.125f, r2[1] * 0.125f), pk2(r2[2] * 0.125f, r2[3] * 0.125f)};
                        *(u32x2*)p = lo; *(u32x2*)(p + 32) = hi;
                    } else if (blk == 32) {
                        float* po = out + (smp ? O_KIS : O_KIP) + rl * 64 + 4 * q8;
                        *(f32x4*)po = (f32x4){r1[0], r1[1], r1[2], r1[3]}; *(f32x4*)(po + 32) = (f32x4){r2[0], r2[1], r2[2], r2[3]};
                        bf16_t* p = (smp ? KIS : KIP) + ((size_t)b * L + pos) * 64 + 4 * q8;
                        u32x2 lo = {pk2(r1[0], r1[1]), pk2(r1[2], r1[3])}, hi = {pk2(r2[0], r2[1]), pk2(r2[2], r2[3])};
                        *(u32x2*)p = lo; *(u32x2*)(p + 32) = hi;
                    } else if (blk == 33 && q8 == 0) {
                        const float s = 0.35355339059327373f;
                        float* p = WI + (size_t)row * 8;
                        *(f32x4*)p = v0 * s; *(f32x4*)(p + 4) = v1 * s;
                    }
                }
            }
    }
};

DI int win_rowmap(int n) {
    const bool roped = (n < 1280) || (n >= 1536 && n < 2112);
    if (!roped) return n;
    const int j = n & 63, base = n & ~63;
    return base + (j < 32 ? 8 * (j >> 2) + (j & 3) : 8 * ((j - 32) >> 2) + 4 + (j & 3));
}
template <bool WINMAP>
DI void transpose_item(const float* W, int K, int N, bf16_t* WT, LAS float* scr, int item, int lane, const float* gk = nullptr) {
    const int nblk = (N + 31) / 32, kb = item / nblk, nb = item % nblk, k0 = 64 * kb, n0 = 32 * nb;
    const int ncol = n0 + (lane & 31);
#pragma unroll 8
    for (int i = 0; i < 32; ++i) { const int kk = 2 * i + (lane >> 5); float v = (ncol < N) ? W[(size_t)(k0 + kk) * N + ncol] : 0.f; if (gk) v *= gk[k0 + kk]; scr[kk * 33 + (lane & 31)] = v; }
    asm volatile("s_waitcnt lgkmcnt(0)" ::: "memory");
    const int c = lane & 7;
#pragma unroll
    for (int j = 0; j < 4; ++j) {
        const int nl = (lane >> 3) + 8 * j, n = n0 + nl;
        const LAS float* s = scr + (8 * c) * 33 + nl;
        u32x4 o; o.x = pk2(s[0], s[33]); o.y = pk2(s[2 * 33], s[3 * 33]); o.z = pk2(s[4 * 33], s[5 * 33]); o.w = pk2(s[6 * 33], s[7 * 33]);
        if (n < N) { const int rowo = WINMAP ? win_rowmap(n) : n; *(u32x4*)(WT + (size_t)rowo * K + k0 + 8 * c) = o; }
    }
    asm volatile("s_waitcnt lgkmcnt(0)" ::: "memory");
}

DI void phase0(const Args& a, LAS unsigned char* lds, int part, int vb, int VG) {
    const int tid = threadIdx.x, wave = tid >> 6, lane = tid & 63, G = VG;
    LAS float* scr = (LAS float*)(lds + wave * 8448);
    unsigned char* ws = a.ws;
    const int gw = vb * 8 + wave, NGW = G * 8;
    const bool pa = part & 1, pb = part & 2, pc = part & 4;
    constexpr int I_POOL = 4 * 4 * 8, I_WIN = 16 * 67, I_WO = 16 * 32, I_UP = 16 * 128, I_DN = 64 * 32;
    constexpr int NITEMS = I_POOL + I_WIN + I_WO + 2 * I_UP + 2 * I_DN;
    for (int it = gw; it < NITEMS; it += NGW) {
        int r = it;
        if (r < I_POOL) { if (!pa) continue; const int g = r >> 5; transpose_item<false>(a.in[9] + (size_t)g * 65536, 256, 256, (bf16_t*)(ws + WS_WPOOL) + (size_t)g * 65536, scr, r & 31, lane); continue; } r -= I_POOL;
        if (r < I_WIN) { if (!pb) continue; transpose_item<true>(a.in[11], 1024, 2120, (bf16_t*)(ws + WS_WIN), scr, r, lane, a.in[6] + D); continue; } r -= I_WIN;
        if (r < I_WO) { if (!pb) continue; transpose_item<false>(a.in[12], 1024, 1024, (bf16_t*)(ws + WS_WO), scr, r, lane); continue; } r -= I_WO;
        if (r < 2 * I_UP) { const int l = r / I_UP; if (!(l ? pb : pc)) continue; transpose_item<false>(a.in[13] + (size_t)l * 4194304, 1024, 4096, (bf16_t*)(ws + (l ? WS_WUP1 : WS_WUP0)), scr, r % I_UP, lane, a.in[7] + (size_t)l * D); continue; } r -= 2 * I_UP;
        { const int l = r / I_DN; if (!(l ? pb : pc)) continue; transpose_item<false>(a.in[14] + (size_t)l * 4194304, 4096, 1024, (bf16_t*)(ws + (l ? WS_WDN1 : WS_WDN0)), scr, r % I_DN, lane); }
    }
    if (!pb) return;
    const int gt = vb * 512 + tid, NGT = G * 512;
    { u32x4* z = (u32x4*)((bf16_t*)(ws + WS_WIN) + (size_t)2120 * 1024); const int n16 = (NWIN - 2120) * 1024 * 2 / 16;
      for (int i = gt; i < n16; i += NGT) z[i] = (u32x4){0u, 0u, 0u, 0u}; }
    { float* rt = (float*)(ws + WS_ROPE);
      for (int i = gt; i < LS * 32; i += NGT) {
          const int pos = i >> 5, f = i & 31;
          double inv = 1.0; for (int k = 0; k < f; ++k) inv *= 0.7498942093324559;
          double rev = (double)pos * inv * 0.15915494309189535; rev -= __builtin_rint(rev);
          const float fr = (float)rev;
          rt[2 * i] = __builtin_amdgcn_cosf(fr); rt[2 * i + 1] = __builtin_amdgcn_sinf(fr);
      } }
    { const float* src = a.in[5]; bf16_t* dst = (bf16_t*)(ws + WS_KIS);
      for (int i = gt; i < 16 * 2048 * 8; i += NGT) {
          const int b = i >> 14, s = (i >> 3) & 2047, d8 = i & 7;
          const f32x4 v0 = *(const f32x4*)(src + (size_t)i * 8), v1 = *(const f32x4*)(src + (size_t)i * 8 + 4);
          u32x4 o = {pk2(v0.x, v0.y), pk2(v0.z, v0.w), pk2(v1.x, v1.y), pk2(v1.z, v1.w)};
          *(u32x4*)(dst + ((size_t)b * LS + s) * 64 + d8 * 8) = o;
      } }
    { const float* src = a.in[3]; bf16_t* dst = (bf16_t*)(ws + WS_KS);
      for (int i = gt; i < 16 * 2048 * 4 * 8; i += NGT) {
          const int d8 = i & 7, g = (i >> 3) & 3, s = (i >> 5) & 2047, b = i >> 16;
          const f32x4 v0 = *(const f32x4*)(src + (size_t)i * 8), v1 = *(const f32x4*)(src + (size_t)i * 8 + 4);
          u32x4 o = {pk2(v0.x, v0.y), pk2(v0.z, v0.w), pk2(v1.x, v1.y), pk2(v1.z, v1.w)};
          *(u32x4*)(dst + (((size_t)b * 4 + g) * LS + s) * 64 + d8 * 8) = o;
      } }
    { const float* src = a.in[4]; bf16_t* dst = (bf16_t*)(ws + WS_VTS);
      for (int i = gt; i < 16 * 4 * 256 * 64; i += NGT) {
          const int d = i & 63, s8 = (i >> 6) & 255, g = (i >> 14) & 3, b = i >> 16;
          const float* p = src + (((size_t)b * 2048 + s8 * 8) * 4 + g) * 64 + d;
          float v[8];
#pragma unroll
          for (int j = 0; j < 8; ++j) v[j] = p[(size_t)j * 256];
          u32x4 o = {pk2(v[0], v[1]), pk2(v[2], v[3]), pk2(v[4], v[5]), pk2(v[6], v[7])};
          *(u32x4*)(dst + (((size_t)b * 4 + g) * 64 + d) * LS + s8 * 8) = o;
      } }
}

DI void phase1(const Args& a, LAS unsigned char* lds) {
    const int tid = threadIdx.x, wave = tid >> 6, lane = tid & 63, G = gridDim.x;
    LAS bf16_t* H = (LAS bf16_t*)lds;
    const float* gmix = a.in[6];
    bf16_t* Dout = (bf16_t*)(a.ws + WS_HA);
    f32x4 gq[4];
#pragma unroll
    for (int j = 0; j < 4; ++j) gq[j] = *(const f32x4*)(gmix + 4 * lane + 256 * j);
    const int c2 = 2 * tid;
    const int win = 2 << (tid >> 7);
    for (int it = blockIdx.x; it < 2080; it += G) {
        const bool smp = it >= 2048;
        int b, t0, T; const float* xs; size_t rowbase;
        if (smp) { b = (it - 2048) >> 1; t0 = ((it - 2048) & 1) * 32; T = TS; xs = a.in[1] + (size_t)b * TS * D; rowbase = (size_t)NP + b * TS; }
        else { b = it >> 6; t0 = (it & 63) * 32; T = TP; xs = a.in[0] + (size_t)b * TP * D; rowbase = (size_t)b * TP; }
        const float* past = a.in[2] + (size_t)b * 15 * D;
        __syncthreads();
        f32x4 v[6][4];
#pragma unroll
        for (int q = 0; q < 6; ++q) {
            const int i = wave + 8 * q, t = t0 + i - 15;
            if (i < 47) {
                const float* src = (t >= 0) ? xs + (size_t)t * D : (smp ? past + (size_t)(15 + t) * D : xs);
#pragma unroll
                for (int j = 0; j < 4; ++j) v[q][j] = *(const f32x4*)(src + 4 * lane + 256 * j);
            }
        }
#pragma unroll
        for (int q = 0; q < 6; ++q) {
            const int i = wave + 8 * q, t = t0 + i - 15;
            if (i < 47) {
                float sm = 0.f;
#pragma unroll
                for (int j = 0; j < 4; ++j) sm += (v[q][j].x * v[q][j].x + v[q][j].y * v[q][j].y) + (v[q][j].z * v[q][j].z + v[q][j].w * v[q][j].w);
#pragma unroll
                for (int o = 1; o < 64; o <<= 1) sm += __shfl_xor(sm, o);
                const float rstd = __builtin_amdgcn_rsqf(sm * (1.0f / 1024.0f) + EPS);
#pragma unroll
                for (int j = 0; j < 4; ++j) {
                    f32x4 h;
                    if (t >= 0) h = v[q][j] * rstd * gq[j];
                    else if (smp) h = v[q][j];
                    else h = (f32x4){0.f, 0.f, 0.f, 0.f};
                    u32x2 o = {pk2(h.x, h.y), pk2(h.z, h.w)};
                    *(LAS u32x2*)(H + i * 1024 + 4 * lane + 256 * j) = o;
                }
            }
        }
        __syncthreads();
        auto hrow = [&](int r) -> f32x2 {
            const unsigned w = *(const LAS unsigned*)(H + (r + 15) * 1024 + c2);
            return (f32x2){__uint_as_float(w << 16), __uint_as_float(w & 0xffff0000u)};
        };
        f32x2 S = {0.f, 0.f};
        for (int j = 1; j < win; ++j) S = S + hrow(-j);
        float* pout = a.out + (smp ? O_POOLS : O_POOLP) + (size_t)b * 15 * D + c2;
#pragma unroll 8
        for (int r = 0; r < 32; ++r) {
            const f32x2 hv = hrow(r);
            S = S + hv;
            const int t = t0 + r;
            const int cnt = smp ? win : (t + 1 < win ? t + 1 : win);
            const float inv = 1.0f / (float)cnt;
            const f32x2 dv = S * inv - hv;
            *(unsigned*)(Dout + (rowbase + t) * D + c2) = pk2(dv.x, dv.y);
            if (t >= T - 15) *(f32x2*)(pout + (size_t)(t - (T - 15)) * D) = hv;
            S = S - hrow(r - win + 1);
        }
    }
}

DI unsigned fkey(float s) { s = s + 0.0f; const unsigned u = __float_as_uint(s); return (u & 0x80000000u) ? ~u : (u | 0x80000000u); }
DI unsigned row16_sum(unsigned v) {
    v += (unsigned)__builtin_amdgcn_update_dpp(0, (int)v, 0xB1, 0xf, 0xf, false);
    v += (unsigned)__builtin_amdgcn_update_dpp(0, (int)v, 0x4E, 0xf, 0xf, false);
    v += (unsigned)__builtin_amdgcn_update_dpp(0, (int)v, 0x124, 0xf, 0xf, false);
    v += (unsigned)__builtin_amdgcn_update_dpp(0, (int)v, 0x128, 0xf, 0xf, false);
    return v;
}
DI unsigned row16_max(unsigned v) {
    v = max(v, (unsigned)__builtin_amdgcn_update_dpp(0, (int)v, 0xB1, 0xf, 0xf, false));
    v = max(v, (unsigned)__builtin_amdgcn_update_dpp(0, (int)v, 0x4E, 0xf, 0xf, false));
    v = max(v, (unsigned)__builtin_amdgcn_update_dpp(0, (int)v, 0x124, 0xf, 0xf, false));
    v = max(v, (unsigned)__builtin_amdgcn_update_dpp(0, (int)v, 0x128, 0xf, 0xf, false));
    return v;
}
DI float unkey(unsigned k) { return __uint_as_float((k & 0x80000000u) ? (k & 0x7fffffffu) : ~k); }
DI unsigned count_ge(const unsigned (&kk)[66], unsigned c) {
    unsigned cnt = 0u;
#pragma unroll
    for (int t = 0; t < 66; ++t) asm volatile("v_cmp_ge_u32 vcc, %1, %2\n\tv_addc_co_u32 %0, vcc, 0, %0, vcc" : "+v"(cnt) : "v"(kk[t]), "v"(c) : "vcc");
    return cnt;
}
DI void select_write(const unsigned (&kk)[66], int nk, int hf, int j32, unsigned* mr) {
    unsigned mxk = 0u, mnk = 0xffffffffu;
#pragma unroll
    for (int t = 0; t < 66; ++t) { mxk = max(mxk, kk[t]); mnk = min(mnk, kk[t] - 1u); }
    mxk = row16_max(mxk); mnk = ~row16_max(~mnk);
    { const unsigned m0 = max((unsigned)__builtin_amdgcn_readlane((int)mxk, 0), (unsigned)__builtin_amdgcn_readlane((int)mxk, 16));
      const unsigned m1 = max((unsigned)__builtin_amdgcn_readlane((int)mxk, 32), (unsigned)__builtin_amdgcn_readlane((int)mxk, 48));
      mxk = hf ? m1 : m0;
      const unsigned n0 = min((unsigned)__builtin_amdgcn_readlane((int)mnk, 0), (unsigned)__builtin_amdgcn_readlane((int)mnk, 16));
      const unsigned n1 = min((unsigned)__builtin_amdgcn_readlane((int)mnk, 32), (unsigned)__builtin_amdgcn_readlane((int)mnk, 48));
      mnk = (hf ? n1 : n0) + 1u; }
    unsigned lo = mnk, hi = mxk + 1u;
    unsigned tau = 0u, thr = 0u; bool done = false;
    for (int it = 0; it < 80; ++it) {
        const unsigned span = hi - lo;
        unsigned c = (it < 16) ? fkey(0.5f * unkey(lo) + 0.5f * unkey(hi - 1u)) : lo + (span >> 1);
        c = max(c, lo + 1u); c = min(c, hi - 1u);
        if (done || span < 2u) c = lo;
        unsigned cnt = row16_sum(count_ge(kk, c));
        const unsigned nlo = (unsigned)__builtin_amdgcn_readlane((int)cnt, 0) + (unsigned)__builtin_amdgcn_readlane((int)cnt, 16);
        const unsigned nhi = (unsigned)__builtin_amdgcn_readlane((int)cnt, 32) + (unsigned)__builtin_amdgcn_readlane((int)cnt, 48);
        const unsigned n = hf ? nhi : nlo;
        if (!done) {
            if (span < 2u) { done = true; tau = lo; thr = 0u; }
            else if (n == 256u) { done = true; thr = c; tau = c; }
            else if (n > 256u) lo = c;
            else hi = c;
        }
        if (__ballot(!done) == 0ull) break;
    }
    done = thr != 0u;
    unsigned w[3] = {0u, 0u, 0u};
    if (__ballot(!done) == 0ull) {
#pragma unroll
        for (int t = 0; t < 66; ++t) {
            const unsigned long long bs = __ballot(kk[t] >= thr);
            const unsigned sw = hf ? (unsigned)(bs >> 32) : (unsigned)bs;
            if (j32 == (t & 31)) w[t >> 5] = sw;
        }
    } else {
        unsigned glo = 0u, ghi = 0u;
#pragma unroll
        for (int t = 0; t < 66; ++t) { const unsigned long long b = __ballot(kk[t] > tau); glo += __popc((unsigned)b); ghi += __popc((unsigned)(b >> 32)); }
        const unsigned r0 = 256u - (hf ? ghi : glo);
        unsigned tk = 0u;
        const unsigned below_mask = (1u << j32) - 1u;
#pragma unroll
        for (int t = 0; t < 66; ++t) {
            if (t < nk) {
                const bool eq = kk[t] == tau;
                const unsigned long long be = __ballot(eq);
                const unsigned e = hf ? (unsigned)(be >> 32) : (unsigned)be;
                const bool take = eq && (tk + __popc(e & below_mask) < r0);
                tk += __popc(e);
                const unsigned long long bs = __ballot((kk[t] > tau) || take);
                const unsigned sw = hf ? (unsigned)(bs >> 32) : (unsigned)bs;
                if (j32 == (t & 31)) w[t >> 5] = sw;
            }
        }
    }
    mr[j32] = w[0]; mr[32 + j32] = w[1];
    if (j32 < 2) mr[64 + j32] = w[2];
}
DI void phase_index(const Args& a, LAS unsigned char* lds) {
    const int tid = threadIdx.x, wave = __builtin_amdgcn_readfirstlane(tid >> 6), lane = tid & 63, hf = lane >> 5, j32 = lane & 31, G = gridDim.x;
    const bf16_t* QI = (const bf16_t*)(a.ws + WS_QI); const float* WI = (const float*)(a.ws + WS_WI);
    unsigned* MASK = (unsigned*)(a.ws + WS_MASK);
    LAS unsigned* lk = (LAS unsigned*)(lds + wave * 16896) + lane;
    constexpr int NIT = 32 + 2048;
    for (int base = 0, rnd = 0; base < NIT; base += G, ++rnd) {
        const int idx = (rnd & 1) ? (G - 1 - (int)blockIdx.x) : (int)blockIdx.x;
        const int pos = base + idx;
        if (pos >= NIT) continue;
        int nkt, rowbase; const bf16_t* KI;
        if (pos < 32) { const int b = pos >> 1; nkt = 66; rowbase = NP + b * 64 + (pos & 1) * 32; KI = (const bf16_t*)(a.ws + WS_KIS) + (size_t)b * LS * 64; }
        else { const int p = pos - 32, c = 31 - (p >> 6), b = (p & 63) >> 1; nkt = 2 * (c + 1); rowbase = b * 2048 + c * 64 + (p & 1) * 32; KI = (const bf16_t*)(a.ws + WS_KIP) + (size_t)b * 2048 * 64; }
        const int row0 = rowbase + wave * 4;
        unsigned* mr0 = MASK + (size_t)(row0 + hf) * MASKW; unsigned* mr1 = MASK + (size_t)(row0 + 2 + hf) * MASKW;
        if (nkt <= 8) {
            const unsigned w = (j32 < nkt) ? 0xffffffffu : 0u;
            mr0[j32] = w; mr0[32 + j32] = 0u; mr1[j32] = w; mr1[32 + j32] = 0u;
            if (j32 < 2) { mr0[64 + j32] = 0u; mr1[64 + j32] = 0u; }
            continue;
        }
        int nk = nkt; asm volatile("" : "+s"(nk));
        const int qq = 2 * (j32 >> 4) + ((j32 >> 2) & 1), hh = 4 * ((j32 >> 3) & 1) + (j32 & 3);
        bf16x8 aq[4];
        { const bf16_t* p = QI + (size_t)(row0 + qq) * 512 + hh * 64 + 8 * hf;
#pragma unroll
          for (int jj = 0; jj < 4; ++jj) aq[jj] = *(const bf16x8*)(p + 16 * jj); }
        float wv0[8], wv1[8];
        { const float* p0 = WI + (size_t)(row0 + hf) * 8; const float* p1 = WI + (size_t)(row0 + 2 + hf) * 8;
          const f32x4 x0 = *(const f32x4*)p0, x1 = *(const f32x4*)(p0 + 4), y0 = *(const f32x4*)p1, y1 = *(const f32x4*)(p1 + 4);
          wv0[0] = x0.x; wv0[1] = x0.y; wv0[2] = x0.z; wv0[3] = x0.w; wv0[4] = x1.x; wv0[5] = x1.y; wv0[6] = x1.z; wv0[7] = x1.w;
          wv1[0] = y0.x; wv1[1] = y0.y; wv1[2] = y0.z; wv1[3] = y0.w; wv1[4] = y1.x; wv1[5] = y1.y; wv1[6] = y1.z; wv1[7] = y1.w; }
        const char* kbase = (const char*)KI;
        const unsigned koff = (unsigned)(j32 * 64 + 8 * hf) * 2u;
        unsigned kk[66];
#pragma unroll
        for (int g = 0; g < 17; ++g) {
#pragma unroll
            for (int u = 0; u < 4; ++u) if (4 * g + u < 66) kk[4 * g + u] = 0u;
            if (4 * g < nk) {
                bf16x8 bt[4][4];
#pragma unroll
                for (int u = 0; u < 4; ++u) { const int tt = (4 * g + u < nk) ? 4 * g + u : nk - 1; const char* p = kbase + (size_t)tt * 4096 + koff;
#pragma unroll
                    for (int jj = 0; jj < 4; ++jj) bt[u][jj] = *(const bf16x8*)(p + 32 * jj); }
#pragma unroll
                for (int u = 0; u < 4; ++u) {
                    const int t = 4 * g + u;
                    if (t < 66) {
                        f32x16 acc;
#pragma unroll
                        for (int i = 0; i < 16; ++i) acc[i] = 0.f;
#pragma unroll
                        for (int jj = 0; jj < 4; ++jj) acc = __builtin_amdgcn_mfma_f32_32x32x16_bf16(aq[jj], bt[u][jj], acc, 0, 0, 0);
                        float s0 = 0.f, s1 = 0.f;
#pragma unroll
                        for (int i = 0; i < 8; ++i) {
                            s0 = __builtin_fmaf(__int_as_float(max(__float_as_int(acc[i]), 0)), wv0[i], s0);
                            s1 = __builtin_fmaf(__int_as_float(max(__float_as_int(acc[8 + i]), 0)), wv1[i], s1);
                        }
                        const bool live = t < nk;
                        kk[t] = live ? fkey(s0) : 0u;
                        lk[t * 64] = live ? fkey(s1) : 0u;
                    }
                }
            } else {
#pragma unroll
                for (int u = 0; u < 4; ++u) if (4 * g + u < 66) lk[(4 * g + u) * 64] = 0u;
            }
            __builtin_amdgcn_sched_barrier(0);
        }
        select_write(kk, nk, hf, j32, mr0);
#pragma unroll
        for (int t = 0; t < 66; ++t) kk[t] = lk[t * 64];
        select_write(kk, nk, hf, j32, mr1);
    }
}

DI void phase_attn(const Args& a, LAS unsigned char* lds) {
    const int tid = threadIdx.x, wave = __builtin_amdgcn_readfirstlane(tid >> 6), lane = tid & 63, hf = lane >> 5, j32 = lane & 31, G = gridDim.x;
    const bf16_t* Q = (const bf16_t*)(a.ws + WS_Q);
    const unsigned* MASK = (const unsigned*)(a.ws + WS_MASK);
    bf16_t* O = (bf16_t*)(a.ws + WS_HA);
    constexpr int NIT = 64 + 4096;
    constexpr float LOG2E = 1.4426950408889634f;
    constexpr int RS = 144, RSV = 528, KREG = 256 * RS, BUFB = KREG + 64 * RSV;
    const int th = wave >> 2, hd = wave & 3;
    const int pik = (j32 & 0x13) | ((j32 & 8) >> 1) | ((j32 & 4) << 1);
    const bf16x8 ones = {0x3f80, 0x3f80, 0x3f80, 0x3f80, 0x3f80, 0x3f80, 0x3f80, 0x3f80};
    const unsigned kread = (unsigned)(pik * RS + 16 * hf), vread = (unsigned)(KREG + j32 * RSV + 16 * hf);
    for (int base = 0, rnd = 0; base < NIT; base += G, ++rnd) {
        const int idx = (rnd & 1) ? (G - 1 - (int)blockIdx.x) : (int)blockIdx.x;
        const int pos = base + idx;
        if (pos >= NIT) continue;
        int nst, rowbase, L, g; const bf16_t *Kb, *Vt;
        if (pos < 64) { const int b = pos >> 2; g = pos & 3; nst = 33; L = LS; rowbase = NP + b * 64;
            Kb = (const bf16_t*)(a.ws + WS_KS) + ((size_t)b * 4 + g) * LS * 64; Vt = (const bf16_t*)(a.ws + WS_VTS) + ((size_t)b * 4 + g) * 64 * LS; }
        else { const int p = pos - 64, c = 31 - (p >> 7), b = (p & 127) >> 2; g = p & 3; nst = c + 1; L = 2048; rowbase = b * 2048 + c * 64;
            Kb = (const bf16_t*)(a.ws + WS_KP) + ((size_t)b * 4 + g) * 2048 * 64; Vt = (const bf16_t*)(a.ws + WS_VTP) + ((size_t)b * 4 + g) * 64 * 2048; }
        const int nbig = (nst + 3) >> 2;
        const int row = rowbase + th * 32 + j32, head = 4 * g + hd;
        bf16x8 qf[4];
        { const bf16_t* p = Q + (size_t)row * 1024 + head * 64 + 8 * hf;
#pragma unroll
          for (int jj = 0; jj < 4; ++jj) qf[jj] = *(const bf16x8*)(p + 16 * jj); }
        const unsigned* mrow = MASK + (size_t)row * MASKW;
        u32x4 kr[4], vr[4];
        auto stage_load = [&](int bs) __attribute__((always_inline)) {
#pragma unroll
            for (int i = 0; i < 4; ++i) {
                const int cid = tid + 512 * i;
                int kr_row = bs * 256 + (cid >> 3); kr_row = kr_row < L ? kr_row : L - 1;
                kr[i] = *(const u32x4*)(Kb + (size_t)kr_row * 64 + (cid & 7) * 8);
                int vcol = bs * 256 + (cid & 31) * 8; vcol = vcol < L - 8 ? vcol : L - 8;
                vr[i] = *(const u32x4*)(Vt + (size_t)(cid >> 5) * L + vcol);
            }
        };
        auto stage_store = [&](LAS unsigned char* buf) __attribute__((always_inline)) {
#pragma unroll
            for (int i = 0; i < 4; ++i) {
                const int cid = tid + 512 * i;
                *(LAS u32x4*)(buf + (cid >> 3) * RS + (cid & 7) * 16) = kr[i];
                *(LAS u32x4*)(buf + KREG + (cid >> 5) * RSV + (cid & 31) * 16) = vr[i];
            }
        };
        stage_load(0);
        f32x16 o0, o1, lacc;
#pragma unroll
        for (int i = 0; i < 16; ++i) { o0[i] = 0.f; o1[i] = 0.f; lacc[i] = 0.f; }
        float mrun = -1e30f;
        u32x4 mwa = *(const u32x4*)mrow, mwb = *(const u32x4*)(mrow + 4);
        __syncthreads();
        stage_store(lds);
        __syncthreads();
        for (int bs = 0; bs < nbig; ++bs) {
            LAS unsigned char* cur = lds + (bs & 1) * BUFB;
            const bool more = bs + 1 < nbig;
            if (more) stage_load(bs + 1);
            const unsigned mw8[8] = {mwa.x, mwa.y, mwa.z, mwa.w, mwb.x, mwb.y, mwb.z, mwb.w};
            if (more) { mwa = *(const u32x4*)(mrow + 8 * (bs + 1)); mwb = *(const u32x4*)(mrow + 8 * (bs + 1) + 4); }
            const int nv = (nst - 4 * bs) < 4 ? (nst - 4 * bs) : 4;
#pragma unroll
            for (int j = 0; j < 4; ++j) {
                if (j < nv) {
                    f32x16 sc[2];
                    {
                        bf16x8 kf[2][4];
#pragma unroll
                        for (int tt = 0; tt < 2; ++tt)
#pragma unroll
                            for (int jj = 0; jj < 4; ++jj) kf[tt][jj] = *(const LAS bf16x8*)(cur + kread + (j * 64 + tt * 32) * RS + 32 * jj);
#pragma unroll
                        for (int tt = 0; tt < 2; ++tt)
#pragma unroll
                            for (int i = 0; i < 16; ++i) sc[tt][i] = 0.f;
                        __builtin_amdgcn_s_setprio(1);
#pragma unroll
                        for (int jj = 0; jj < 4; ++jj)
#pragma unroll
                            for (int tt = 0; tt < 2; ++tt) sc[tt] = __builtin_amdgcn_mfma_f32_32x32x16_bf16(kf[tt][jj], qf[jj], sc[tt], 0, 0, 0);
                        __builtin_amdgcn_s_setprio(0);
                    }
                    float mx = __builtin_fmaxf(sc[0][0], sc[1][0]);
#pragma unroll
                    for (int i = 1; i < 16; ++i) mx = __builtin_fmaxf(__builtin_fmaxf(mx, sc[0][i]), sc[1][i]);
                    mx = xhalf_max(mx);
                    if (__ballot(mx > mrun + 8.0f) != 0ull) {
                        const float mnew = fmaxf(mrun, mx);
                        const float alpha = __builtin_amdgcn_exp2f((mrun - mnew) * LOG2E);
                        mrun = mnew;
#pragma unroll
                        for (int i = 0; i < 16; ++i) { o0[i] *= alpha; o1[i] *= alpha; lacc[i] *= alpha; }
                    }
                    const float nm = -mrun * LOG2E;
#pragma unroll
                    for (int tt = 0; tt < 2; ++tt) {
                        const unsigned mw = mw8[2 * j + tt] >> (8 * hf);
                        float p[16];
#pragma unroll
                        for (int i = 0; i < 16; ++i) {
                            const float e = __builtin_amdgcn_exp2f(__builtin_fmaf(sc[tt][i], LOG2E, nm));
                            const unsigned msk = (unsigned)__builtin_amdgcn_sbfe((int)mw, (i & 7) + 16 * (i >> 3), 1);
                            p[i] = __uint_as_float(__float_as_uint(e) & msk);
                        }
#pragma unroll
                        for (int s2 = 0; s2 < 2; ++s2) {
                            u32x4 pw = {pk2(p[8 * s2], p[8 * s2 + 1]), pk2(p[8 * s2 + 2], p[8 * s2 + 3]), pk2(p[8 * s2 + 4], p[8 * s2 + 5]), pk2(p[8 * s2 + 6], p[8 * s2 + 7])};
                            const bf16x8 pf = __builtin_bit_cast(bf16x8, pw);
                            const bf16x8 v0 = *(const LAS bf16x8*)(cur + vread + (j * 64 + tt * 32 + 16 * s2) * 2);
                            const bf16x8 v1 = *(const LAS bf16x8*)(cur + vread + 32 * RSV + (j * 64 + tt * 32 + 16 * s2) * 2);
                            o0 = __builtin_amdgcn_mfma_f32_32x32x16_bf16(v0, pf, o0, 0, 0, 0);
                            o1 = __builtin_amdgcn_mfma_f32_32x32x16_bf16(v1, pf, o1, 0, 0, 0);
                            lacc = __builtin_amdgcn_mfma_f32_32x32x16_bf16(ones, pf, lacc, 0, 0, 0);
                        }
                    }
                }
            }
            if (more) stage_store(lds + ((bs & 1) ^ 1) * BUFB);
            __syncthreads();
        }
        const float inv = 1.0f / lacc[0];
        bf16_t* op = O + (size_t)row * 1024 + head * 64 + 4 * hf;
#pragma unroll
        for (int q = 0; q < 4; ++q) {
            u32x2 x0 = {pk2(o0[4 * q] * inv, o0[4 * q + 1] * inv), pk2(o0[4 * q + 2] * inv, o0[4 * q + 3] * inv)};
            u32x2 x1 = {pk2(o1[4 * q] * inv, o1[4 * q + 1] * inv), pk2(o1[4 * q + 2] * inv, o1[4 * q + 3] * inv)};
            *(u32x2*)(op + 8 * q) = x0; *(u32x2*)(op + 32 + 8 * q) = x1;
        }
    }
}

DI void phase_final(const Args& a) {
    const int tid = threadIdx.x, wave = tid >> 6, lane = tid & 63, G = gridDim.x;
    const float* ss = (const float*)(a.ws + WS_SS1);
    const bf16_t* Xb = (const bf16_t*)(a.ws + WS_HB);
    const float* gf = a.in[8];
    f32x4 g0[2], g1[2];
#pragma unroll
    for (int j = 0; j < 2; ++j) { g0[j] = *(const f32x4*)(gf + (lane + 64 * j) * 8); g1[j] = *(const f32x4*)(gf + (lane + 64 * j) * 8 + 4); }
    for (int row = blockIdx.x * 8 + wave; row < NR; row += G * 8) {
        float s = ss[(size_t)row * 16 + (lane & 15)];
        s += __shfl_xor(s, 1); s += __shfl_xor(s, 2); s += __shfl_xor(s, 4); s += __shfl_xor(s, 8);
        const float rstd = __builtin_amdgcn_rsqf(s * (1.0f / 1024.0f) + EPS);
        const u32x4* hr = (const u32x4*)(Xb + (size_t)row * D) + lane;
        f32x4* yr = (f32x4*)(a.out + (size_t)row * D) + 2 * lane;
#pragma unroll
        for (int j = 0; j < 2; ++j) {
            const u32x4 h = hr[64 * j];
            f32x4 y0 = {__uint_as_float(h.x << 16), __uint_as_float(h.x & 0xffff0000u), __uint_as_float(h.y << 16), __uint_as_float(h.y & 0xffff0000u)};
            f32x4 y1 = {__uint_as_float(h.z << 16), __uint_as_float(h.z & 0xffff0000u), __uint_as_float(h.w << 16), __uint_as_float(h.w & 0xffff0000u)};
            yr[128 * j] = y0 * rstd * g0[j]; yr[128 * j + 1] = y1 * rstd * g1[j];
        }
    }
}

#define XB_TMO      128
#define XB_XCNT(j)  (256  + 64 * (j))
#define XB_XSUB(j)  (1280 + 64 * (j))
#define XB_XGEN(j)  (2304 + 64 * (j))
#define XB_TOP      3328
#define XB_TOPGEN   3392
#define XCD_BAR_WORDS 3456
#define XB_SPIN_CAP (1u << 20)
DI unsigned xb_ld(unsigned* p)              { return __hip_atomic_load(p, __ATOMIC_RELAXED, __HIP_MEMORY_SCOPE_AGENT); }
DI unsigned xb_add(unsigned* p, unsigned v) { return __hip_atomic_fetch_add(p, v, __ATOMIC_RELAXED, __HIP_MEMORY_SCOPE_AGENT); }
DI unsigned xb_xcc_id() { return (unsigned)__builtin_amdgcn_s_getreg((3 << 11) | 20) & 0xFu; }
#define XB_SPIN(cond, bar) do { unsigned _sp = 0; while (cond) { __builtin_amdgcn_s_sleep(1); \
    if ((++_sp & 255u) == 0u) { if (xb_ld(&(bar)[XB_TMO])) break; if (_sp > XB_SPIN_CAP) { atomicAdd(&(bar)[XB_TMO], 1u); break; } } } } while (0)
struct XcdBarrier { unsigned* bar; unsigned x; volatile LAS unsigned* st; };
DI XcdBarrier xcd_barrier_post(unsigned* bar, volatile LAS unsigned* st) {
    XcdBarrier b; b.bar = bar; b.x = xb_xcc_id(); b.st = st;
    if (threadIdx.x == 0) (void)xb_add(&bar[XB_XCNT(b.x)], 1u);
    return b;
}
DI void xcd_barrier_complete(unsigned* bar, unsigned x, unsigned& nloc, unsigned& nx) {
    const unsigned G = gridDim.x * gridDim.y * gridDim.z;
    unsigned sum, cnt, mine, sp = 0u;
    for (;;) {
        sum = 0u; cnt = 0u; mine = 0u;
#pragma unroll
        for (unsigned j = 0; j < 16; ++j) { const unsigned c = xb_ld(&bar[XB_XCNT(j)]); sum += c; cnt += (c > 0u) ? 1u : 0u; mine = (j == x) ? c : mine; }
        if (sum == G) break;
        __builtin_amdgcn_s_sleep(1);
        if ((++sp & 255u) == 0u) { if (xb_ld(&bar[XB_TMO])) break; if (sp > XB_SPIN_CAP) { atomicAdd(&bar[XB_TMO], 1u); break; } }
    }
    nloc = mine > 0u ? mine : 1u; nx = cnt > 0u ? cnt : 1u;
}
DI void xcd_barrier(const XcdBarrier& b) {
    asm volatile("s_waitcnt vmcnt(0)" ::: "memory");
    __syncthreads();
    if (threadIdx.x == 0) {
        unsigned* bar = b.bar;
        __builtin_amdgcn_s_waitcnt(0);
        unsigned nloc = b.st[0], nx = b.st[1];
        if (nloc == 0u) { xcd_barrier_complete(bar, b.x, nloc, nx); b.st[0] = nloc; b.st[1] = nx; }
        const unsigned old = xb_add(&bar[XB_XSUB(b.x)], 1u);
        const unsigned gen = old / nloc;
        if (old + 1u == (gen + 1u) * nloc) {
            __builtin_amdgcn_fence(__ATOMIC_RELEASE, "agent");
            asm volatile("s_waitcnt vmcnt(0)" ::: "memory");
            const unsigned og = xb_add(&bar[XB_TOP], 1u);
            const unsigned tg = og / nx;
            if (og + 1u == (tg + 1u) * nx) xb_add(&bar[XB_TOPGEN], 1u);
            else XB_SPIN(xb_ld(&bar[XB_TOPGEN]) == tg, bar);
            __builtin_amdgcn_fence(__ATOMIC_ACQUIRE, "agent");
            xb_add(&bar[XB_XGEN(b.x)], 1u);
            asm volatile("s_waitcnt vmcnt(0)" ::: "memory");
        } else {
            XB_SPIN(xb_ld(&bar[XB_XGEN(b.x)]) == gen, bar);
            __builtin_amdgcn_fence(__ATOMIC_ACQUIRE, "agent");
            asm volatile("s_waitcnt vmcnt(0)" ::: "memory");
        }
    }
    __syncthreads();
}

__global__ void __launch_bounds__(512, 2) fwd_kernel(Args a) {
    extern __shared__ __attribute__((aligned(16))) unsigned char lds_raw[];
    LAS unsigned char* lds = (LAS unsigned char*)lds_raw;
    cg::grid_group grid = cg::this_grid();
    volatile LAS unsigned* xst = (volatile LAS unsigned*)(lds + LDS_PHASE);
    if (threadIdx.x == 0) { xst[0] = 0u; xst[1] = 0u; }
    __syncthreads();
    const XcdBarrier xb = xcd_barrier_post((unsigned*)(a.ws + WS_BAR), xst);
    unsigned char* ws = a.ws;
    const int G = gridDim.x;
    pg8::StaticOrder S;
    float* ss0 = (float*)(ws + WS_SS0); float* ss1 = (float*)(ws + WS_SS1);
    bf16_t* HA = (bf16_t*)(ws + WS_HA); bf16_t* Xb = (bf16_t*)(ws + WS_HB); bf16_t* U = (bf16_t*)(ws + WS_U);
#ifndef PHMASK
#define PHMASK 0xfff
#endif
#ifndef PROBE_REP
#define PROBE_REP 0x0
#endif
#define PHASE(k) if (((PHMASK >> (k)) & 1) && (k) >= a.ph_lo && (k) < a.ph_hi)
#define SEAM(k) do { if ((k) >= a.ph_lo && (k) + 1 < a.ph_hi) xcd_barrier(xb); } while (0)
    const bool defer0 = (G == 256);
    PHASE(0) { phase0(a, lds, defer0 ? 1 : 7, blockIdx.x, G); phase1(a, lds); }
#if PROBE_REP & 0x1
    grid.sync(); phase0(a, lds, 7, blockIdx.x, G); phase1(a, lds);
#endif
    SEAM(0);
    PHASE(1) {
        pg8::Gemm g{HA, (const bf16_t*)(ws + WS_WPOOL), NR, 1024, 256, 1024, 256, 512};
        S.init(NR, 1024, G, blockIdx.x);
        EpiRes<true, true> E{a.in[0], a.in[1], Xb, a.in[10], ss0};
        pg8::gemm_phase(lds, g, S, E);
        if (defer0 && blockIdx.x >= 16) phase0(a, lds, 4, blockIdx.x - 16, 240);
    }
    SEAM(1);
    PHASE(2) {
        pg8::Gemm g{Xb, (const bf16_t*)(ws + WS_WUP0), NR, DFF, 1024, 1024, 1024, 0};
        S.init(NR, DFF, G, blockIdx.x);
        EpiUp E{ss0, U};
        pg8::gemm_phase(lds, g, S, E);
    }
    SEAM(2);
    PHASE(3) {
        pg8::Gemm g{U, (const bf16_t*)(ws + WS_WDN0), NR, 1024, DFF, DFF, DFF, 0};
        S.init(NR, 1024, G, blockIdx.x);
        EpiRes<false, false> E{nullptr, nullptr, Xb, nullptr, ss1};
        pg8::gemm_phase(lds, g, S, E);
        if (defer0 && blockIdx.x >= 16) phase0(a, lds, 2, blockIdx.x - 16, 240);
    }
    SEAM(3);
    PHASE(4) {
        pg8::Gemm g{Xb, (const bf16_t*)(ws + WS_WIN), NR, NWIN, 1024, 1024, 1024, 0};
        S.init(NR, NWIN, G, blockIdx.x);
        EpiWin E{ss1, (const float*)(ws + WS_ROPE), (bf16_t*)(ws + WS_Q), (bf16_t*)(ws + WS_QI), (bf16_t*)(ws + WS_KP), (bf16_t*)(ws + WS_VTP), (bf16_t*)(ws + WS_KIP),
                 (bf16_t*)(ws + WS_KS), (bf16_t*)(ws + WS_VTS), (bf16_t*)(ws + WS_KIS), (float*)(ws + WS_WI), a.out};
        pg8::gemm_phase(lds, g, S, E);
    }
    SEAM(4);
    PHASE(5) { phase_index(a, lds); }
    SEAM(5);
    PHASE(6) { phase_attn(a, lds); }
    SEAM(6);
    PHASE(7) {
        pg8::Gemm g{HA, (const bf16_t*)(ws + WS_WO), NR, 1024, 1024, 1024, 1024, 0};
        S.init(NR, 1024, G, blockIdx.x);
        EpiRes<false, false> E{nullptr, nullptr, Xb, nullptr, ss0};
        pg8::gemm_phase(lds, g, S, E);
    }
    SEAM(7);
    PHASE(8) {
        pg8::Gemm g{Xb, (const bf16_t*)(ws + WS_WUP1), NR, DFF, 1024, 1024, 1024, 0};
        S.init(NR, DFF, G, blockIdx.x);
        EpiUp E{ss0, U};
        pg8::gemm_phase(lds, g, S, E);
    }
    SEAM(8);
    PHASE(9) {
        pg8::Gemm g{U, (const bf16_t*)(ws + WS_WDN1), NR, 1024, DFF, DFF, DFF, 0};
        S.init(NR, 1024, G, blockIdx.x);
        EpiRes<false, false> E{nullptr, nullptr, Xb, nullptr, ss1};
        pg8::gemm_phase(lds, g, S, E);
    }
    SEAM(9);
    PHASE(10) { phase_final(a); }
    if (a.ph_hi > 1000) grid.sync();
}

#ifndef N_LAUNCHES
#define N_LAUNCHES 1
#endif
extern "C" void kernel_launch(void* const* d_in, const int* in_sizes, int n_in, void* d_out, int out_size, void* d_ws, size_t ws_size, hipStream_t stream) {
    static int grid = 0;
    if (grid == 0) {
        if (n_in != 15 || out_size != 107233280 || ws_size < WS_END) { fprintf(stderr, "kernel_launch: unexpected shapes (n_in %d out %d ws %zu need %zu)\n", n_in, out_size, ws_size, (size_t)WS_END); grid = -1; return; }
        int dev = 0, cus = 0, per_cu = 0;
        hipGetDevice(&dev); hipDeviceGetAttribute(&cus, hipDeviceAttributeMultiprocessorCount, dev);
        if (hipFuncSetAttribute((const void*)fwd_kernel, hipFuncAttributeMaxDynamicSharedMemorySize, LDS_BYTES) != hipSuccess) { fprintf(stderr, "kernel_launch: hipFuncSetAttribute failed\n"); grid = -1; return; }
        hipOccupancyMaxActiveBlocksPerMultiprocessor(&per_cu, (const void*)fwd_kernel, 512, LDS_BYTES);
        if (per_cu < 1) { fprintf(stderr, "kernel_launch: occupancy query says %d\n", per_cu); per_cu = 1; }
        (void)hipGetLastError();
        grid = cus;
    }
    if (grid < 0) return;
    if (hipMemsetAsync((char*)d_ws + WS_BAR, 0, XCD_BAR_WORDS * 4, stream) != hipSuccess) { fprintf(stderr, "kernel_launch: memset of the barrier words failed\n"); return; }
    Args a{};
    for (int i = 0; i < 15; ++i) a.in[i] = (const float*)d_in[i];
    a.out = (float*)d_out; a.ws = (unsigned char*)d_ws;
#if N_LAUNCHES == 1
    a.ph_lo = 0; a.ph_hi = 11;
    void* args[] = {&a};
    hipError_t e = hipLaunchCooperativeKernel((const void*)fwd_kernel, dim3(grid), dim3(512), args, LDS_BYTES, stream);
    if (e != hipSuccess) fprintf(stderr, "cooperative launch failed: %s (grid %d)\n", hipGetErrorString(e), grid);
#else
    for (int ph = 0; ph < 11; ++ph) { a.ph_lo = ph; a.ph_hi = ph + 1; hipLaunchKernelGGL(fwd_kernel, dim3(grid), dim3(512), LDS_BYTES, stream, a); }
#endif
}
```

```cpp
#include <hip/hip_runtime.h>
#include <hip/hip_cooperative_groups.h>
#include <cstdio>
#include <cstdint>
namespace cg = cooperative_groups;

#define LAS __attribute__((address_space(3)))
#define DI __device__ __forceinline__
typedef unsigned short bf16_t;
typedef short bf16x8 __attribute__((ext_vector_type(8)));
typedef float f32x2 __attribute__((ext_vector_type(2)));
typedef float f32x4 __attribute__((ext_vector_type(4)));
typedef float f32x16 __attribute__((ext_vector_type(16)));
typedef unsigned u32x2 __attribute__((ext_vector_type(2)));
typedef unsigned u32x4 __attribute__((ext_vector_type(4)));
typedef __bf16 bfv2 __attribute__((ext_vector_type(2)));

constexpr int D = 1024, NP = 65536, NS = 1024, NR = NP + NS, TP = 2048, TS = 64, LS = 2112, DFF = 4096;
constexpr int NWIN = 2304;
constexpr int MASKW = 68;
constexpr float EPS = 1e-6f;
constexpr size_t O_Y = 0, O_POOLP = 68157440, O_POOLS = 68648960, O_KP = 68894720, O_VP = 85671936, O_KIP = 102449152,
                 O_KS = 106643456, O_VS = 106905600, O_KIS = 107167744;
constexpr size_t WS_WPOOL = 0;
constexpr size_t WS_WIN = WS_WPOOL + 524288;
constexpr size_t WS_WO = WS_WIN + (size_t)NWIN * 1024 * 2;
constexpr size_t WS_WUP0 = WS_WO + 2097152;
constexpr size_t WS_WUP1 = WS_WUP0 + 8388608;
constexpr size_t WS_WDN0 = WS_WUP1 + 8388608;
constexpr size_t WS_WDN1 = WS_WDN0 + 8388608;
constexpr size_t WS_ROPE = WS_WDN1 + 8388608;
constexpr size_t WS_SS0 = WS_ROPE + 540672;
constexpr size_t WS_SS1 = WS_SS0 + (size_t)NR * 64;
constexpr size_t WS_KS = WS_SS1 + (size_t)NR * 64;
constexpr size_t WS_VTS = WS_KS + (size_t)16 * 4 * LS * 64 * 2;
constexpr size_t WS_KIS = WS_VTS + (size_t)16 * 4 * LS * 64 * 2;
constexpr size_t WS_HA = WS_KIS + (size_t)16 * LS * 64 * 2;
constexpr size_t WS_HB = WS_HA + (size_t)NR * 1024 * 2;
constexpr size_t WS_U = WS_HB + (size_t)NR * 1024 * 2;
constexpr size_t WS_BAR = WS_U + (size_t)NR * 4096 * 2;
constexpr size_t WS_END = WS_BAR + 16384;
constexpr size_t WS_Q = WS_U;
constexpr size_t WS_QI = WS_Q + (size_t)NR * 1024 * 2;
constexpr size_t WS_KP = WS_QI + (size_t)NR * 512 * 2;
constexpr size_t WS_VTP = WS_KP + (size_t)32 * 4 * 2048 * 64 * 2;
constexpr size_t WS_KIP = WS_VTP + (size_t)32 * 4 * 2048 * 64 * 2;
constexpr size_t WS_WI = WS_KIP + (size_t)32 * 2048 * 64 * 2;
constexpr size_t WS_MASK = WS_WI + (size_t)NR * 8 * 4;
constexpr size_t WS_ALIAS_END = WS_MASK + (size_t)NR * MASKW * 4;
static_assert(WS_ALIAS_END <= WS_BAR, "alias overflow");

constexpr int LDS_PHASE = 141312;
constexpr int LDS_BYTES = LDS_PHASE + 16;

struct Args {
    const float* in[15];
    float* out;
    unsigned char* ws;
    int ph_lo, ph_hi;
};

DI unsigned pk2(float lo, float hi) { f32x2 v = {lo, hi}; bfv2 b = __builtin_convertvector(v, bfv2); return __builtin_bit_cast(unsigned, b); }
DI float bf2f(bf16_t b) { return __uint_as_float(((unsigned)b) << 16); }
DI float xhalf_max(float x) {
    auto r = __builtin_amdgcn_permlane32_swap(__float_as_uint(x), __float_as_uint(x), false, false);
    return fmaxf(__uint_as_float(r[0]), __uint_as_float(r[1]));
}
DI float xhalf_sum(float x) {
    auto r = __builtin_amdgcn_permlane32_swap(__float_as_uint(x), __float_as_uint(x), false, false);
    return __uint_as_float(r[0]) + __uint_as_float(r[1]);
}

namespace pg8 {
constexpr int BM = 256, BK = 64, HALF = 128, HTB = HALF * BK * 2, STAGE_BYTES = 8 * HTB, NXCD = 8, WGM = 8;
DI int lds_byte(int r, int c) { const int st = (r >> 4) * 2 + (c >> 5), rr = r & 15, cc = c & 31, ob = rr * 64 + cc * 2; return st * 1024 + (ob ^ (((ob >> 9) & 1) << 5)); }
DI void stage_rc(int b, int& R, int& C) { const int st = b / 1024, sb = b % 1024, swz = sb ^ (((sb >> 9) & 1) << 5); R = (st >> 1) * 16 + swz / 64; C = (st & 1) * 32 + (swz % 64) / 2; }
DI int perm32(int rho) { const int n = rho >> 4, i = rho & 15; return 8 * (i >> 2) + 4 * n + (i & 3); }
struct Unit { int pm, pn; };
struct Gemm { const bf16_t* A; const bf16_t* Bt; int M, N, K, lda, ldb, a_pn_bytes; };
struct StaticOrder {
    int nM, nN, nwg, G, c;
    DI void init(int M, int N, int G_, int c_) { nM = M / BM; nN = N / BM; nwg = nM * nN; G = G_; c = c_; }
    DI bool next(int i, Unit& u) const {
        const long L = (long)i * G + c; if (L >= nwg) return false;
        int wgid = (int)L; { const int q = nwg / NXCD, r = nwg % NXCD, xcd = wgid % NXCD, off = wgid / NXCD; wgid = (xcd < r ? xcd * (q + 1) : r * (q + 1) + (xcd - r) * q) + off; }
        const int nig = WGM * nN, gid = wgid / nig, fm = gid * WGM, gsz = (nM - fm) < WGM ? (nM - fm) : WGM;
        u.pm = fm + ((wgid % nig) % gsz); u.pn = (wgid % nig) / gsz; return true;
    }
};

template <class Epi>
DI void gemm_phase(LAS unsigned char* lds, const Gemm g, const StaticOrder& S, const Epi& E) {
    const int tid = threadIdx.x, wid = __builtin_amdgcn_readfirstlane(tid >> 6), lane = tid & 63, wr = wid >> 2, wc = wid & 3, fr = lane & 15, fq = lane >> 4;
    const int K = g.K, nt = K / BK;
    unsigned voffA[2], voffB[2];
#pragma unroll
    for (int i = 0; i < 2; ++i) { int R, C; stage_rc(tid * 16 + i * 8192, R, C); const int Rb = (R & ~31) + perm32(R & 31);
        voffA[i] = (unsigned)(R * g.lda + C) * 2u; voffB[i] = (unsigned)(Rb * g.ldb + C) * 2u; }
    const size_t kstep = (size_t)(BK * 2);
    const size_t hstepA = (size_t)HALF * g.lda * 2, hstepB = (size_t)HALF * g.ldb * 2;
    const size_t tstepA = 2 * hstepA, tstepB = 2 * hstepB;
    const unsigned ldsw = (unsigned)wid * 1024u;
    const int aoff = lds_byte(wr * 64 + fr, fq * 8), boff = lds_byte(wc * 32 + fr, fq * 8);
#define PG8_SA(b, h) (((b) * 2 + (h)) * HTB)
#define PG8_SB(b, h) ((4 + (b) * 2 + (h)) * HTB)
#define PG8_STAGE(bufoff, gbase, voff) do { _Pragma("unroll") for (int _i = 0; _i < 2; ++_i) \
        __builtin_amdgcn_global_load_lds((const unsigned*)((const char*)(gbase) + (voff)[_i]), (LAS unsigned*)(lds + (bufoff) + ldsw + _i * 8192), 16, 0, 0); } while (0)
#define PG8_LDA(dst, b, h) do { _Pragma("unroll") for (int m = 0; m < 4; ++m) _Pragma("unroll") for (int k = 0; k < 2; ++k) dst[m][k] = *(const LAS bf16x8*)(lds + PG8_SA(b, h) + aoff + m * 2048 + k * 1024); } while (0)
#define PG8_LDB(dst, b, h) do { _Pragma("unroll") for (int n = 0; n < 2; ++n) _Pragma("unroll") for (int k = 0; k < 2; ++k) dst[n][k] = *(const LAS bf16x8*)(lds + PG8_SB(b, h) + boff + n * 2048 + k * 1024); } while (0)
#define PG8_MMA(ai, bj, At, Bt) do { __builtin_amdgcn_s_setprio(1); _Pragma("unroll") for (int m = 0; m < 4; ++m) _Pragma("unroll") for (int n = 0; n < 2; ++n) _Pragma("unroll") for (int k = 0; k < 2; ++k) \
        acc[ai][bj][m][n] = __builtin_amdgcn_mfma_f32_16x16x32_bf16(Bt[n][k], At[m][k], acc[ai][bj][m][n], 0, 0, 0); __builtin_amdgcn_s_setprio(0); } while (0)
#define PG8_WAIT_V(n) asm volatile("s_waitcnt vmcnt(" #n ")" ::: "memory")
#define PG8_WAIT_L(n) asm volatile("s_waitcnt lgkmcnt(" #n ")" ::: "memory")
#define PG8_BAR __builtin_amdgcn_s_barrier()
#define PG8_SCHED __builtin_amdgcn_sched_barrier(0)
    Unit cur, nxt; int ui = 0;
    if (!S.next(0, cur)) return;
    f32x4 acc[2][2][4][2];
#pragma unroll
    for (int a = 0; a < 2; ++a)
#pragma unroll
        for (int b = 0; b < 2; ++b)
#pragma unroll
            for (int m = 0; m < 4; ++m)
#pragma unroll
                for (int n = 0; n < 2; ++n) acc[a][b][m][n] = (f32x4){0.f, 0.f, 0.f, 0.f};
    bf16x8 At[4][2], B0[2][2], B1[2][2];
    const char* cA = (const char*)g.A + (size_t)cur.pm * tstepA + (size_t)cur.pn * g.a_pn_bytes; const char* cB = (const char*)g.Bt + (size_t)cur.pn * tstepB;
    PG8_STAGE(PG8_SB(0, 0), cB, voffB); PG8_STAGE(PG8_SB(0, 1), cB + hstepB, voffB); PG8_STAGE(PG8_SA(0, 0), cA, voffA); PG8_STAGE(PG8_SA(0, 1), cA + hstepA, voffA);
    if (wr == 1) PG8_BAR;
    PG8_WAIT_V(2); PG8_BAR;
    PG8_STAGE(PG8_SB(1, 0), cB + kstep, voffB); PG8_STAGE(PG8_SA(1, 0), cA + kstep, voffA); PG8_STAGE(PG8_SB(1, 1), cB + hstepB + kstep, voffB);
    PG8_WAIT_V(6); PG8_BAR;
    for (;;) {
        const bool has_next = S.next(ui + 1, nxt);
        const char* nA = has_next ? (const char*)g.A + (size_t)nxt.pm * tstepA + (size_t)nxt.pn * g.a_pn_bytes : cA; const char* nB = has_next ? (const char*)g.Bt + (size_t)nxt.pn * tstepB : cB;
#pragma unroll 1
        for (int t = 0; t < nt; t += 2) {
            const bool last = (t == nt - 2);
            const char* a1 = cA + (size_t)(t + 1) * kstep;
            const char* a2 = last ? nA : cA + (size_t)(t + 2) * kstep; const char* b2 = last ? nB : cB + (size_t)(t + 2) * kstep;
            const char* a3 = a2 + kstep; const char* b3 = b2 + kstep;
            PG8_LDB(B0, 0, 0); PG8_LDB(B1, 0, 1); PG8_SCHED; PG8_LDA(At, 0, 0); PG8_STAGE(PG8_SA(1, 1), a1 + hstepA, voffA);
            PG8_WAIT_V(8); PG8_WAIT_L(0); PG8_BAR; PG8_MMA(0, 0, At, B0); PG8_MMA(0, 1, At, B1); PG8_BAR; PG8_SCHED;
            PG8_LDA(At, 0, 1); PG8_STAGE(PG8_SB(0, 0), b2, voffB); PG8_STAGE(PG8_SB(0, 1), b2 + hstepB, voffB); PG8_STAGE(PG8_SA(0, 0), a2, voffA);
            PG8_WAIT_V(8); PG8_WAIT_L(0); PG8_BAR; PG8_MMA(1, 0, At, B0); PG8_MMA(1, 1, At, B1); PG8_BAR; PG8_SCHED;
            PG8_LDB(B0, 1, 0); PG8_LDB(B1, 1, 1); PG8_SCHED; PG8_LDA(At, 1, 0); PG8_STAGE(PG8_SA(0, 1), a2 + hstepA, voffA);
            PG8_WAIT_V(8); PG8_WAIT_L(0); PG8_BAR; PG8_MMA(0, 0, At, B0); PG8_MMA(0, 1, At, B1); PG8_BAR; PG8_SCHED;
            PG8_LDA(At, 1, 1); PG8_STAGE(PG8_SB(1, 0), b3, voffB); PG8_STAGE(PG8_SB(1, 1), b3 + hstepB, voffB); PG8_STAGE(PG8_SA(1, 0), a3, voffA);
            PG8_WAIT_V(8); PG8_WAIT_L(0); PG8_BAR; PG8_MMA(1, 0, At, B0); PG8_MMA(1, 1, At, B1); PG8_BAR; PG8_SCHED;
        }
        if (wr == 0) PG8_BAR;
        E(acc, cur, wr, wc, fr, fq);
        if (!has_next) break;
#pragma unroll
        for (int a = 0; a < 2; ++a)
#pragma unroll
            for (int b = 0; b < 2; ++b)
#pragma unroll
                for (int m = 0; m < 4; ++m)
#pragma unroll
                    for (int n = 0; n < 2; ++n) acc[a][b][m][n] = (f32x4){0.f, 0.f, 0.f, 0.f};
        cur = nxt; cA = nA; cB = nB; ++ui;
        if (wr == 1) PG8_BAR;
    }
    PG8_WAIT_V(0);
    PG8_BAR;
#undef PG8_SA
#undef PG8_SB
#undef PG8_STAGE
#undef PG8_LDA
#undef PG8_LDB
#undef PG8_MMA
#undef PG8_WAIT_V
#undef PG8_WAIT_L
#undef PG8_BAR
#undef PG8_SCHED
}
}
using pg8::Unit;

DI float row_rstd(const float* ss, int row) {
    const f32x4* p = (const f32x4*)(ss + (size_t)row * 16);
    f32x4 a = p[0], b = p[1], c = p[2], d = p[3];
    const float s = ((a.x + a.y) + (a.z + a.w)) + ((b.x + b.y) + (b.z + b.w)) + ((c.x + c.y) + (c.z + c.w)) + ((d.x + d.y) + (d.z + d.w));
    return __builtin_amdgcn_rsqf(s * (1.0f / 1024.0f) + EPS);
}

template <bool HAS_SCALE, bool IN_F32>
struct EpiRes {
    const float* xin_p; const float* xin_s; bf16_t* X; const float* colscale; float* ss;
    DI void operator()(const f32x4 (&acc)[2][2][4][2], const Unit& u, int wr, int wc, int fr, int fq) const {
        const int col0 = u.pn * 256 + wc * 32 + 8 * fq;
        float sq[2][4];
#pragma unroll
        for (int ai = 0; ai < 2; ++ai)
#pragma unroll
            for (int m = 0; m < 4; ++m) sq[ai][m] = 0.f;
#pragma unroll
        for (int bj = 0; bj < 2; ++bj) {
            const int col = col0 + bj * 128;
            f32x4 sc0, sc1;
            if (HAS_SCALE) { sc0 = *(const f32x4*)(colscale + col); sc1 = *(const f32x4*)(colscale + col + 4); }
#pragma unroll
            for (int ai = 0; ai < 2; ++ai)
#pragma unroll
                for (int m = 0; m < 4; ++m) {
                    const int row = u.pm * 256 + ai * 128 + wr * 64 + m * 16 + fr;
                    bf16_t* xb = X + (size_t)row * D + col;
                    f32x4 x0, x1;
                    if (IN_F32) {
                        const float* xr = (row < NP) ? xin_p + (size_t)row * D : xin_s + (size_t)(row - NP) * D;
                        x0 = *(const f32x4*)(xr + col); x1 = *(const f32x4*)(xr + col + 4);
                    } else {
                        const u32x4 h = *(const u32x4*)xb;
                        x0 = (f32x4){__uint_as_float(h.x << 16), __uint_as_float(h.x & 0xffff0000u), __uint_as_float(h.y << 16), __uint_as_float(h.y & 0xffff0000u)};
                        x1 = (f32x4){__uint_as_float(h.z << 16), __uint_as_float(h.z & 0xffff0000u), __uint_as_float(h.w << 16), __uint_as_float(h.w & 0xffff0000u)};
                    }
                    f32x4 y0 = acc[ai][bj][m][0], y1 = acc[ai][bj][m][1];
                    if (HAS_SCALE) { y0 = y0 * sc0; y1 = y1 * sc1; }
                    x0 = x0 + y0; x1 = x1 + y1;
                    sq[ai][m] += (x0.x * x0.x + x0.y * x0.y) + (x0.z * x0.z + x0.w * x0.w) + (x1.x * x1.x + x1.y * x1.y) + (x1.z * x1.z + x1.w * x1.w);
                    u32x4 o; o.x = pk2(x0.x, x0.y); o.y = pk2(x0.z, x0.w); o.z = pk2(x1.x, x1.y); o.w = pk2(x1.z, x1.w);
                    *(u32x4*)xb = o;
                }
        }
#pragma unroll
        for (int ai = 0; ai < 2; ++ai)
#pragma unroll
            for (int m = 0; m < 4; ++m) {
                const int row = u.pm * 256 + ai * 128 + wr * 64 + m * 16 + fr;
                float q = sq[ai][m];
                q += __shfl_xor(q, 16); q += __shfl_xor(q, 32);
                if (fq == 0) ss[(size_t)row * 16 + u.pn * 4 + wc] = q;
            }
    }
};

struct EpiUp {
    const float* ss; bf16_t* U;
    DI void operator()(const f32x4 (&acc)[2][2][4][2], const Unit& u, int wr, int wc, int fr, int fq) const {
        const int col0 = u.pn * 256 + wc * 32 + 8 * fq;
#pragma unroll
        for (int ai = 0; ai < 2; ++ai)
#pragma unroll
            for (int m = 0; m < 4; ++m) {
                const int row = u.pm * 256 + ai * 128 + wr * 64 + m * 16 + fr;
                const float rstd = row_rstd(ss, row);
#pragma unroll
                for (int bj = 0; bj < 2; ++bj) {
                    f32x4 v0 = acc[ai][bj][m][0] * rstd, v1 = acc[ai][bj][m][1] * rstd;
                    float e[8] = {v0.x, v0.y, v0.z, v0.w, v1.x, v1.y, v1.z, v1.w};
#pragma unroll
                    for (int i = 0; i < 8; ++i) { const float r = fmaxf(e[i], 0.f); e[i] = r * r; }
                    u32x4 o; o.x = pk2(e[0], e[1]); o.y = pk2(e[2], e[3]); o.z = pk2(e[4], e[5]); o.w = pk2(e[6], e[7]);
                    *(u32x4*)(U + (size_t)row * DFF + col0 + bj * 128) = o;
                }
            }
    }
};

struct EpiWin {
    const float* ss; const float* rope;
    bf16_t *Q, *QI, *KP, *VTP, *KIP, *KS, *VTS, *KIS; float* WI; float* out;
    DI void operator()(const f32x4 (&acc)[2][2][4][2], const Unit& u, int wr, int wc, int fr, int fq) const {
        const int q8 = (wc & 1) * 4 + fq;
        const bool smp = u.pm >= 256;
#pragma unroll
        for (int ai = 0; ai < 2; ++ai)
#pragma unroll
            for (int m = 0; m < 4; ++m) {
                const int row = u.pm * 256 + ai * 128 + wr * 64 + m * 16 + fr;
                const float rstd = row_rstd(ss, row);
                int b, pos, L; size_t rl;
                if (smp) { const int rs = row - NP; b = rs >> 6; pos = 2048 + (rs & 63); L = LS; rl = rs; } else { b = row >> 11; pos = row & 2047; L = 2048; rl = row; }
                const f32x4 cs0 = *(const f32x4*)(rope + ((size_t)pos * 32 + 4 * q8) * 2), cs1 = *(const f32x4*)(rope + ((size_t)pos * 32 + 4 * q8) * 2 + 4);
                const float cc[4] = {cs0.x, cs0.z, cs1.x, cs1.z}, sn[4] = {cs0.y, cs0.w, cs1.y, cs1.w};
#pragma unroll
                for (int bj = 0; bj < 2; ++bj) {
                    const int blk = u.pn * 4 + bj * 2 + (wc >> 1);
                    const f32x4 v0 = acc[ai][bj][m][0] * rstd, v1 = acc[ai][bj][m][1] * rstd;
                    const float a0[4] = {v0.x, v0.y, v0.z, v0.w}, a1[4] = {v1.x, v1.y, v1.z, v1.w};
                    float r1[4], r2[4];
#pragma unroll
                    for (int i = 0; i < 4; ++i) { r1[i] = a0[i] * cc[i] - a1[i] * sn[i]; r2[i] = a1[i] * cc[i] + a0[i] * sn[i]; }
                    if (blk < 16) {
                        bf16_t* p = Q + (size_t)row * 1024 + blk * 64 + 8 * q8;
                        u32x4 o = {pk2(r1[0] * 0.125f, r1[1] * 0.125f), pk2(r1[2] * 0.125f, r1[3] * 0.125f), pk2(r2[0] * 0.125f, r2[1] * 0.125f), pk2(r2[2] * 0.125f, r2[3] * 0.125f)};
                        *(u32x4*)p = o;
                    } else if (blk < 20) {
                        const int g = blk - 16;
                        float* po = out + (smp ? O_KS : O_KP) + rl * 256 + g * 64 + 4 * q8;
                        *(f32x4*)po = (f32x4){r1[0], r1[1], r1[2], r1[3]}; *(f32x4*)(po + 32) = (f32x4){r2[0], r2[1], r2[2], r2[3]};
                        bf16_t* p = (smp ? KS : KP) + (((size_t)b * 4 + g) * L + pos) * 64 + 8 * q8;
                        u32x4 o = {pk2(r1[0], r1[1]), pk2(r1[2], r1[3]), pk2(r2[0], r2[1]), pk2(r2[2], r2[3])};
                        *(u32x4*)p = o;
                    } else if (blk < 24) {
                        const int g = blk - 20;
                        float* po = out + (smp ? O_VS : O_VP) + rl * 256 + g * 64 + 8 * q8;
                        *(f32x4*)po = v0; *(f32x4*)(po + 4) = v1;
                        bf16_t* p = (smp ? VTS : VTP) + (((size_t)b * 4 + g) * 64 + 8 * q8) * L + pos;
                        const unsigned w0 = pk2(a0[0], a0[1]), w1 = pk2(a0[2], a0[3]), w2 = pk2(a1[0], a1[1]), w3 = pk2(a1[2], a1[3]);
                        p[0] = (bf16_t)w0; p[(size_t)L] = (bf16_t)(w0 >> 16); p[(size_t)2 * L] = (bf16_t)w1; p[(size_t)3 * L] = (bf16_t)(w1 >> 16);
                        p[(size_t)4 * L] = (bf16_t)w2; p[(size_t)5 * L] = (bf16_t)(w2 >> 16); p[(size_t)6 * L] = (bf16_t)w3; p[(size_t)7 * L] = (bf16_t)(w3 >> 16);
                    } else if (blk < 32) {
                        bf16_t* p = QI + (size_t)row * 512 + (blk - 24) * 64 + 8 * q8;
                        u32x4 o = {pk2(r1[0] * 0.125f, r1[1] * 0.125f), pk2(r1[2] * 0.125f, r1[3] * 0.125f), pk2(r2[0] * 0.125f, r2[1] * 0.125f), pk2(r2[2] * 0.125f, r2[3] * 0.125f)};
                        *(u32x4*)p = o;
                    } else if (blk == 32) {
                        float* po = out + (smp ? O_KIS : O_KIP) + rl * 64 + 4 * q8;
                        *(f32x4*)po = (f32x4){r1[0], r1[1], r1[2], r1[3]}; *(f32x4*)(po + 32) = (f32x4){r2[0], r2[1], r2[2], r2[3]};
                        bf16_t* p = (smp ? KIS : KIP) + ((size_t)b * L + pos) * 64 + 8 * q8;
                        u32x4 o = {pk2(r1[0], r1[1]), pk2(r1[2], r1[3]), pk2(r2[0], r2[1]), pk2(r2[2], r2[3])};
                        *(u32x4*)p = o;
                    } else if (blk == 33 && q8 == 0) {
                        const float s = 0.35355339059327373f;
                        float* p = WI + (size_t)row * 8;
                        *(f32x4*)p = v0 * s; *(f32x4*)(p + 4) = v1 * s;
                    }
                }
            }
    }
};

DI int win_rowmap(int n) {
    const bool roped = (n < 1280) || (n >= 1536 && n < 2112);
    if (!roped) return n;
    const int j = n & 63, base = n & ~63;
    return base + (j < 32 ? 8 * (j >> 2) + (j & 3) : 8 * ((j - 32) >> 2) + 4 + (j & 3));
}
template <bool WINMAP>
DI void transpose_item(const float* W, int K, int N, bf16_t* WT, LAS float* scr, int item, int lane, const float* gk = nullptr) {
    const int nblk = (N + 31) / 32, kb = item / nblk, nb = item % nblk, k0 = 64 * kb, n0 = 32 * nb;
    const int ncol = n0 + (lane & 31);
#pragma unroll 8
    for (int i = 0; i < 32; ++i) { const int kk = 2 * i + (lane >> 5); float v = (ncol < N) ? W[(size_t)(k0 + kk) * N + ncol] : 0.f; if (gk) v *= gk[k0 + kk]; scr[kk * 33 + (lane & 31)] = v; }
    asm volatile("s_waitcnt lgkmcnt(0)" ::: "memory");
    const int c = lane & 7;
#pragma unroll
    for (int j = 0; j < 4; ++j) {
        const int nl = (lane >> 3) + 8 * j, n = n0 + nl;
        const LAS float* s = scr + (8 * c) * 33 + nl;
        u32x4 o; o.x = pk2(s[0], s[33]); o.y = pk2(s[2 * 33], s[3 * 33]); o.z = pk2(s[4 * 33], s[5 * 33]); o.w = pk2(s[6 * 33], s[7 * 33]);
        if (n < N) { const int rowo = WINMAP ? win_rowmap(n) : n; *(u32x4*)(WT + (size_t)rowo * K + k0 + 8 * c) = o; }
    }
    asm volatile("s_waitcnt lgkmcnt(0)" ::: "memory");
}

DI void phase0(const Args& a, LAS unsigned char* lds, int part, int vb, int VG) {
    const int tid = threadIdx.x, wave = tid >> 6, lane = tid & 63, G = VG;
    LAS float* scr = (LAS float*)(lds + wave * 8448);
    unsigned char* ws = a.ws;
    const int gw = vb * 8 + wave, NGW = G * 8;
    const bool pa = part & 1, pb = part & 2, pc = part & 4;
    constexpr int I_POOL = 4 * 4 * 8, I_WIN = 16 * 67, I_WO = 16 * 32, I_UP = 16 * 128, I_DN = 64 * 32;
    constexpr int NITEMS = I_POOL + I_WIN + I_WO + 2 * I_UP + 2 * I_DN;
    for (int it = gw; it < NITEMS; it += NGW) {
        int r = it;
        if (r < I_POOL) { if (!pa) continue; const int g = r >> 5; transpose_item<false>(a.in[9] + (size_t)g * 65536, 256, 256, (bf16_t*)(ws + WS_WPOOL) + (size_t)g * 65536, scr, r & 31, lane); continue; } r -= I_POOL;
        if (r < I_WIN) { if (!pb) continue; transpose_item<true>(a.in[11], 1024, 2120, (bf16_t*)(ws + WS_WIN), scr, r, lane, a.in[6] + D); continue; } r -= I_WIN;
        if (r < I_WO) { if (!pb) continue; transpose_item<false>(a.in[12], 1024, 1024, (bf16_t*)(ws + WS_WO), scr, r, lane); continue; } r -= I_WO;
        if (r < 2 * I_UP) { const int l = r / I_UP; if (!(l ? pb : pc)) continue; transpose_item<false>(a.in[13] + (size_t)l * 4194304, 1024, 4096, (bf16_t*)(ws + (l ? WS_WUP1 : WS_WUP0)), scr, r % I_UP, lane, a.in[7] + (size_t)l * D); continue; } r -= 2 * I_UP;
        { const int l = r / I_DN; if (!(l ? pb : pc)) continue; transpose_item<false>(a.in[14] + (size_t)l * 4194304, 4096, 1024, (bf16_t*)(ws + (l ? WS_WDN1 : WS_WDN0)), scr, r % I_DN, lane); }
    }
    if (!pb) return;
    const int gt = vb * 512 + tid, NGT = G * 512;
    { u32x4* z = (u32x4*)((bf16_t*)(ws + WS_WIN) + (size_t)2120 * 1024); const int n16 = (NWIN - 2120) * 1024 * 2 / 16;
      for (int i = gt; i < n16; i += NGT) z[i] = (u32x4){0u, 0u, 0u, 0u}; }
    { float* rt = (float*)(ws + WS_ROPE);
      for (int i = gt; i < LS * 32; i += NGT) {
          const int pos = i >> 5, f = i & 31;
          double inv = 1.0; for (int k = 0; k < f; ++k) inv *= 0.7498942093324559;
          double rev = (double)pos * inv * 0.15915494309189535; rev -= __builtin_rint(rev);
          const float fr = (float)rev;
          rt[2 * i] = __builtin_amdgcn_cosf(fr); rt[2 * i + 1] = __builtin_amdgcn_sinf(fr);
      } }
    { const float* src = a.in[5]; bf16_t* dst = (bf16_t*)(ws + WS_KIS);
      for (int i = gt; i < 16 * 2048 * 8; i += NGT) {
          const int b = i >> 14, s = (i >> 3) & 2047, d8 = i & 7;
          const float* rowp = src + (size_t)(i >> 3) * 64;
          const f32x4 v0 = *(const f32x4*)(rowp + 4 * d8), v1 = *(const f32x4*)(rowp + 32 + 4 * d8);
          u32x4 o = {pk2(v0.x, v0.y), pk2(v0.z, v0.w), pk2(v1.x, v1.y), pk2(v1.z, v1.w)};
          *(u32x4*)(dst + ((size_t)b * LS + s) * 64 + d8 * 8) = o;
      } }
    { const float* src = a.in[3]; bf16_t* dst = (bf16_t*)(ws + WS_KS);
      for (int i = gt; i < 16 * 2048 * 4 * 8; i += NGT) {
          const int d8 = i & 7, g = (i >> 3) & 3, s = (i >> 5) & 2047, b = i >> 16;
          const float* rowp = src + (size_t)(i >> 3) * 64;
          const f32x4 v0 = *(const f32x4*)(rowp + 4 * d8), v1 = *(const f32x4*)(rowp + 32 + 4 * d8);
          u32x4 o = {pk2(v0.x, v0.y), pk2(v0.z, v0.w), pk2(v1.x, v1.y), pk2(v1.z, v1.w)};
          *(u32x4*)(dst + (((size_t)b * 4 + g) * LS + s) * 64 + d8 * 8) = o;
      } }
    { const float* src = a.in[4]; bf16_t* dst = (bf16_t*)(ws + WS_VTS);
      for (int i = gt; i < 16 * 4 * 256 * 64; i += NGT) {
          const int d = i & 63, s8 = (i >> 6) & 255, g = (i >> 14) & 3, b = i >> 16;
          const float* p = src + (((size_t)b * 2048 + s8 * 8) * 4 + g) * 64 + d;
          float v[8];
#pragma unroll
          for (int j = 0; j < 8; ++j) v[j] = p[(size_t)j * 256];
          u32x4 o = {pk2(v[0], v[1]), pk2(v[2], v[3]), pk2(v[4], v[5]), pk2(v[6], v[7])};
          *(u32x4*)(dst + (((size_t)b * 4 + g) * 64 + d) * LS + s8 * 8) = o;
      } }
}

DI void phase1(const Args& a, LAS unsigned char* lds) {
    const int tid = threadIdx.x, wave = tid >> 6, lane = tid & 63, G = gridDim.x;
    LAS bf16_t* H = (LAS bf16_t*)lds;
    const float* gmix = a.in[6];
    bf16_t* Dout = (bf16_t*)(a.ws + WS_HA);
    f32x4 gq[4];
#pragma unroll
    for (int j = 0; j < 4; ++j) gq[j] = *(const f32x4*)(gmix + 4 * lane + 256 * j);
    const int c2 = 2 * tid;
    const int win = 2 << (tid >> 7);
    for (int it = blockIdx.x; it < 2080; it += G) {
        const bool smp = it >= 2048;
        int b, t0, T; const float* xs; size_t rowbase;
        if (smp) { b = (it - 2048) >> 1; t0 = ((it - 2048) & 1) * 32; T = TS; xs = a.in[1] + (size_t)b * TS * D; rowbase = (size_t)NP + b * TS; }
        else { b = it >> 6; t0 = (it & 63) * 32; T = TP; xs = a.in[0] + (size_t)b * TP * D; rowbase = (size_t)b * TP; }
        const float* past = a.in[2] + (size_t)b * 15 * D;
        __syncthreads();
        f32x4 v[6][4];
#pragma unroll
        for (int q = 0; q < 6; ++q) {
            const int i = wave + 8 * q, t = t0 + i - 15;
            if (i < 47) {
                const float* src = (t >= 0) ? xs + (size_t)t * D : (smp ? past + (size_t)(15 + t) * D : xs);
#pragma unroll
                for (int j = 0; j < 4; ++j) v[q][j] = *(const f32x4*)(src + 4 * lane + 256 * j);
            }
        }
#pragma unroll
        for (int q = 0; q < 6; ++q) {
            const int i = wave + 8 * q, t = t0 + i - 15;
            if (i < 47) {
                float sm = 0.f;
#pragma unroll
                for (int j = 0; j < 4; ++j) sm += (v[q][j].x * v[q][j].x + v[q][j].y * v[q][j].y) + (v[q][j].z * v[q][j].z + v[q][j].w * v[q][j].w);
#pragma unroll
                for (int o = 1; o < 64; o <<= 1) sm += __shfl_xor(sm, o);
                const float rstd = __builtin_amdgcn_rsqf(sm * (1.0f / 1024.0f) + EPS);
#pragma unroll
                for (int j = 0; j < 4; ++j) {
                    f32x4 h;
                    if (t >= 0) h = v[q][j] * rstd * gq[j];
                    else if (smp) h = v[q][j];
                    else h = (f32x4){0.f, 0.f, 0.f, 0.f};
                    u32x2 o = {pk2(h.x, h.y), pk2(h.z, h.w)};
                    *(LAS u32x2*)(H + i * 1024 + 4 * lane + 256 * j) = o;
                }
            }
        }
        __syncthreads();
        auto hrow = [&](int r) -> f32x2 {
            const unsigned w = *(const LAS unsigned*)(H + (r + 15) * 1024 + c2);
            return (f32x2){__uint_as_float(w << 16), __uint_as_float(w & 0xffff0000u)};
        };
        f32x2 S = {0.f, 0.f};
        for (int j = 1; j < win; ++j) S = S + hrow(-j);
        float* pout = a.out + (smp ? O_POOLS : O_POOLP) + (size_t)b * 15 * D + c2;
#pragma unroll 8
        for (int r = 0; r < 32; ++r) {
            const f32x2 hv = hrow(r);
            S = S + hv;
            const int t = t0 + r;
            const int cnt = smp ? win : (t + 1 < win ? t + 1 : win);
            const float inv = 1.0f / (float)cnt;
            const f32x2 dv = S * inv - hv;
            *(unsigned*)(Dout + (rowbase + t) * D + c2) = pk2(dv.x, dv.y);
            if (t >= T - 15) *(f32x2*)(pout + (size_t)(t - (T - 15)) * D) = hv;
            S = S - hrow(r - win + 1);
        }
    }
}

DI unsigned fkey(float s) { s = s + 0.0f; const unsigned u = __float_as_uint(s); return (u & 0x80000000u) ? ~u : (u | 0x80000000u); }
DI unsigned row16_sum(unsigned v) {
    v += (unsigned)__builtin_amdgcn_update_dpp(0, (int)v, 0xB1, 0xf, 0xf, false);
    v += (unsigned)__builtin_amdgcn_update_dpp(0, (int)v, 0x4E, 0xf, 0xf, false);
    v += (unsigned)__builtin_amdgcn_update_dpp(0, (int)v, 0x124, 0xf, 0xf, false);
    v += (unsigned)__builtin_amdgcn_update_dpp(0, (int)v, 0x128, 0xf, 0xf, false);
    return v;
}
DI unsigned row16_max(unsigned v) {
    v = max(v, (unsigned)__builtin_amdgcn_update_dpp(0, (int)v, 0xB1, 0xf, 0xf, false));
    v = max(v, (unsigned)__builtin_amdgcn_update_dpp(0, (int)v, 0x4E, 0xf, 0xf, false));
    v = max(v, (unsigned)__builtin_amdgcn_update_dpp(0, (int)v, 0x124, 0xf, 0xf, false));
    v = max(v, (unsigned)__builtin_amdgcn_update_dpp(0, (int)v, 0x128, 0xf, 0xf, false));
    return v;
}
DI float unkey(unsigned k) { return __uint_as_float((k & 0x80000000u) ? (k & 0x7fffffffu) : ~k); }
DI unsigned count_ge(const unsigned (&kk)[66], unsigned c) {
    unsigned cnt = 0u;
#pragma unroll
    for (int t = 0; t < 66; ++t) asm volatile("v_cmp_ge_u32 vcc, %1, %2\n\tv_addc_co_u32 %0, vcc, 0, %0, vcc" : "+v"(cnt) : "v"(kk[t]), "v"(c) : "vcc");
    return cnt;
}
DI void select_write(const unsigned (&kk)[66], int nk, int hf, int j32, unsigned* mr) {
    unsigned mxk = 0u, mnk = 0xffffffffu;
#pragma unroll
    for (int t = 0; t < 66; ++t) { mxk = max(mxk, kk[t]); mnk = min(mnk, kk[t] - 1u); }
    mxk = row16_max(mxk); mnk = ~row16_max(~mnk);
    { const unsigned m0 = max((unsigned)__builtin_amdgcn_readlane((int)mxk, 0), (unsigned)__builtin_amdgcn_readlane((int)mxk, 16));
      const unsigned m1 = max((unsigned)__builtin_amdgcn_readlane((int)mxk, 32), (unsigned)__builtin_amdgcn_readlane((int)mxk, 48));
      mxk = hf ? m1 : m0;
      const unsigned n0 = min((unsigned)__builtin_amdgcn_readlane((int)mnk, 0), (unsigned)__builtin_amdgcn_readlane((int)mnk, 16));
      const unsigned n1 = min((unsigned)__builtin_amdgcn_readlane((int)mnk, 32), (unsigned)__builtin_amdgcn_readlane((int)mnk, 48));
      mnk = (hf ? n1 : n0) + 1u; }
    unsigned lo = mnk, hi = mxk + 1u;
    unsigned tau = 0u, thr = 0u; bool done = false;
    for (int it = 0; it < 80; ++it) {
        const unsigned span = hi - lo;
        unsigned c = (it < 16) ? fkey(0.5f * unkey(lo) + 0.5f * unkey(hi - 1u)) : lo + (span >> 1);
        c = max(c, lo + 1u); c = min(c, hi - 1u);
        if (done || span < 2u) c = lo;
        unsigned cnt = row16_sum(count_ge(kk, c));
        const unsigned nlo = (unsigned)__builtin_amdgcn_readlane((int)cnt, 0) + (unsigned)__builtin_amdgcn_readlane((int)cnt, 16);
        const unsigned nhi = (unsigned)__builtin_amdgcn_readlane((int)cnt, 32) + (unsigned)__builtin_amdgcn_readlane((int)cnt, 48);
        const unsigned n = hf ? nhi : nlo;
        if (!done) {
            if (span < 2u) { done = true; tau = lo; thr = 0u; }
            else if (n == 256u) { done = true; thr = c; tau = c; }
            else if (n > 256u) lo = c;
            else hi = c;
        }
        if (__ballot(!done) == 0ull) break;
    }
    done = thr != 0u;
    unsigned w[3] = {0u, 0u, 0u};
    if (__ballot(!done) == 0ull) {
#pragma unroll
        for (int t = 0; t < 66; ++t) {
            const unsigned long long bs = __ballot(kk[t] >= thr);
            const unsigned sw = hf ? (unsigned)(bs >> 32) : (unsigned)bs;
            if (j32 == (t & 31)) w[t >> 5] = sw;
        }
    } else {
        unsigned glo = 0u, ghi = 0u;
#pragma unroll
        for (int t = 0; t < 66; ++t) { const unsigned long long b = __ballot(kk[t] > tau); glo += __popc((unsigned)b); ghi += __popc((unsigned)(b >> 32)); }
        const unsigned r0 = 256u - (hf ? ghi : glo);
        unsigned tk = 0u;
        const unsigned below_mask = (1u << j32) - 1u;
#pragma unroll
        for (int t = 0; t < 66; ++t) {
            if (t < nk) {
                const bool eq = kk[t] == tau;
                const unsigned long long be = __ballot(eq);
                const unsigned e = hf ? (unsigned)(be >> 32) : (unsigned)be;
                const bool take = eq && (tk + __popc(e & below_mask) < r0);
                tk += __popc(e);
                const unsigned long long bs = __ballot((kk[t] > tau) || take);
                const unsigned sw = hf ? (unsigned)(bs >> 32) : (unsigned)bs;
                if (j32 == (t & 31)) w[t >> 5] = sw;
            }
        }
    }
    mr[j32] = w[0]; mr[32 + j32] = w[1];
    if (j32 < 2) mr[64 + j32] = w[2];
}
DI void phase_index(const Args& a, LAS unsigned char* lds) {
    const int tid = threadIdx.x, wave = __builtin_amdgcn_readfirstlane(tid >> 6), lane = tid & 63, hf = lane >> 5, j32 = lane & 31, G = gridDim.x;
    const bf16_t* QI = (const bf16_t*)(a.ws + WS_QI); const float* WI = (const float*)(a.ws + WS_WI);
    unsigned* MASK = (unsigned*)(a.ws + WS_MASK);
    LAS unsigned* lk = (LAS unsigned*)(lds + wave * 16896) + lane;
    constexpr int NIT = 32 + 2048;
    for (int base = 0, rnd = 0; base < NIT; base += G, ++rnd) {
        const int idx = (rnd & 1) ? (G - 1 - (int)blockIdx.x) : (int)blockIdx.x;
        const int pos = base + idx;
        if (pos >= NIT) continue;
        int nkt, rowbase; const bf16_t* KI;
        if (pos < 32) { const int b = pos >> 1; nkt = 66; rowbase = NP + b * 64 + (pos & 1) * 32; KI = (const bf16_t*)(a.ws + WS_KIS) + (size_t)b * LS * 64; }
        else { const int p = pos - 32, c = 31 - (p >> 6), b = (p & 63) >> 1; nkt = 2 * (c + 1); rowbase = b * 2048 + c * 64 + (p & 1) * 32; KI = (const bf16_t*)(a.ws + WS_KIP) + (size_t)b * 2048 * 64; }
        const int row0 = rowbase + wave * 4;
        unsigned* mr0 = MASK + (size_t)(row0 + hf) * MASKW; unsigned* mr1 = MASK + (size_t)(row0 + 2 + hf) * MASKW;
        if (nkt <= 8) {
            const unsigned w = (j32 < nkt) ? 0xffffffffu : 0u;
            mr0[j32] = w; mr0[32 + j32] = 0u; mr1[j32] = w; mr1[32 + j32] = 0u;
            if (j32 < 2) { mr0[64 + j32] = 0u; mr1[64 + j32] = 0u; }
            continue;
        }
        int nk = nkt; asm volatile("" : "+s"(nk));
        const int qq = 2 * (j32 >> 4) + ((j32 >> 2) & 1), hh = 4 * ((j32 >> 3) & 1) + (j32 & 3);
        bf16x8 aq[4];
        { const bf16_t* p = QI + (size_t)(row0 + qq) * 512 + hh * 64 + 8 * hf;
#pragma unroll
          for (int jj = 0; jj < 4; ++jj) aq[jj] = *(const bf16x8*)(p + 16 * jj); }
        float wv0[8], wv1[8];
        { const float* p0 = WI + (size_t)(row0 + hf) * 8; const float* p1 = WI + (size_t)(row0 + 2 + hf) * 8;
          const f32x4 x0 = *(const f32x4*)p0, x1 = *(const f32x4*)(p0 + 4), y0 = *(const f32x4*)p1, y1 = *(const f32x4*)(p1 + 4);
          wv0[0] = x0.x; wv0[1] = x0.y; wv0[2] = x0.z; wv0[3] = x0.w; wv0[4] = x1.x; wv0[5] = x1.y; wv0[6] = x1.z; wv0[7] = x1.w;
          wv1[0] = y0.x; wv1[1] = y0.y; wv1[2] = y0.z; wv1[3] = y0.w; wv1[4] = y1.x; wv1[5] = y1.y; wv1[6] = y1.z; wv1[7] = y1.w; }
        const char* kbase = (const char*)KI;
        const unsigned koff = (unsigned)(j32 * 64 + 8 * hf) * 2u;
        unsigned kk[66];
#pragma unroll
        for (int g = 0; g < 17; ++g) {
#pragma unroll
            for (int u = 0; u < 4; ++u) if (4 * g + u < 66) kk[4 * g + u] = 0u;
            if (4 * g < nk) {
                bf16x8 bt[4][4];
#pragma unroll
                for (int u = 0; u < 4; ++u) { const int tt = (4 * g + u < nk) ? 4 * g + u : nk - 1; const char* p = kbase + (size_t)tt * 4096 + koff;
#pragma unroll
                    for (int jj = 0; jj < 4; ++jj) bt[u][jj] = *(const bf16x8*)(p + 32 * jj); }
#pragma unroll
                for (int u = 0; u < 4; ++u) {
                    const int t = 4 * g + u;
                    if (t < 66) {
                        f32x16 acc;
#pragma unroll
                        for (int i = 0; i < 16; ++i) acc[i] = 0.f;
#pragma unroll
                        for (int jj = 0; jj < 4; ++jj) acc = __builtin_amdgcn_mfma_f32_32x32x16_bf16(aq[jj], bt[u][jj], acc, 0, 0, 0);
                        float s0 = 0.f, s1 = 0.f;
#pragma unroll
                        for (int i = 0; i < 8; ++i) {
                            s0 = __builtin_fmaf(__int_as_float(max(__float_as_int(acc[i]), 0)), wv0[i], s0);
                            s1 = __builtin_fmaf(__int_as_float(max(__float_as_int(acc[8 + i]), 0)), wv1[i], s1);
                        }
                        const bool live = t < nk;
                        kk[t] = live ? fkey(s0) : 0u;
                        lk[t * 64] = live ? fkey(s1) : 0u;
                    }
                }
            } else {
#pragma unroll
                for (int u = 0; u < 4; ++u) if (4 * g + u < 66) lk[(4 * g + u) * 64] = 0u;
            }
            __builtin_amdgcn_sched_barrier(0);
        }
        select_write(kk, nk, hf, j32, mr0);
#pragma unroll
        for (int t = 0; t < 66; ++t) kk[t] = lk[t * 64];
        select_write(kk, nk, hf, j32, mr1);
    }
}

DI void phase_attn(const Args& a, LAS unsigned char* lds) {
    const int tid = threadIdx.x, wave = __builtin_amdgcn_readfirstlane(tid >> 6), lane = tid & 63, hf = lane >> 5, j32 = lane & 31, G = gridDim.x;
    const bf16_t* Q = (const bf16_t*)(a.ws + WS_Q);
    const unsigned* MASK = (const unsigned*)(a.ws + WS_MASK);
    bf16_t* O = (bf16_t*)(a.ws + WS_HA);
    constexpr int NIT = 64 + 4096;
    constexpr float LOG2E = 1.4426950408889634f;
    constexpr int RS = 144, RSV = 528, KREG = 256 * RS, BUFB = KREG + 64 * RSV;
    const int th = wave >> 2, hd = wave & 3;
    const int pik = (j32 & 0x13) | ((j32 & 8) >> 1) | ((j32 & 4) << 1);
    const bf16x8 ones = {0x3f80, 0x3f80, 0x3f80, 0x3f80, 0x3f80, 0x3f80, 0x3f80, 0x3f80};
    const unsigned kread = (unsigned)(pik * RS + 16 * hf), vread = (unsigned)(KREG + j32 * RSV + 16 * hf);
    for (int base = 0, rnd = 0; base < NIT; base += G, ++rnd) {
        const int idx = (rnd & 1) ? (G - 1 - (int)blockIdx.x) : (int)blockIdx.x;
        const int pos = base + idx;
        if (pos >= NIT) continue;
        int nst, rowbase, L, g; const bf16_t *Kb, *Vt;
        if (pos < 64) { const int b = pos >> 2; g = pos & 3; nst = 33; L = LS; rowbase = NP + b * 64;
            Kb = (const bf16_t*)(a.ws + WS_KS) + ((size_t)b * 4 + g) * LS * 64; Vt = (const bf16_t*)(a.ws + WS_VTS) + ((size_t)b * 4 + g) * 64 * LS; }
        else { const int p = pos - 64, c = 31 - (p >> 7), b = (p & 127) >> 2; g = p & 3; nst = c + 1; L = 2048; rowbase = b * 2048 + c * 64;
            Kb = (const bf16_t*)(a.ws + WS_KP) + ((size_t)b * 4 + g) * 2048 * 64; Vt = (const bf16_t*)(a.ws + WS_VTP) + ((size_t)b * 4 + g) * 64 * 2048; }
        const int nbig = (nst + 3) >> 2;
        const int row = rowbase + th * 32 + j32, head = 4 * g + hd;
        bf16x8 qf[4];
        { const bf16_t* p = Q + (size_t)row * 1024 + head * 64 + 8 * hf;
#pragma unroll
          for (int jj = 0; jj < 4; ++jj) qf[jj] = *(const bf16x8*)(p + 16 * jj); }
        const unsigned* mrow = MASK + (size_t)row * MASKW;
        u32x4 kr[4], vr[4];
        auto stage_load = [&](int bs) __attribute__((always_inline)) {
#pragma unroll
            for (int i = 0; i < 4; ++i) {
                const int cid = tid + 512 * i;
                int kr_row = bs * 256 + (cid >> 3); kr_row = kr_row < L ? kr_row : L - 1;
                kr[i] = *(const u32x4*)(Kb + (size_t)kr_row * 64 + (cid & 7) * 8);
                int vcol = bs * 256 + (cid & 31) * 8; vcol = vcol < L - 8 ? vcol : L - 8;
                vr[i] = *(const u32x4*)(Vt + (size_t)(cid >> 5) * L + vcol);
            }
        };
        auto stage_store = [&](LAS unsigned char* buf) __attribute__((always_inline)) {
#pragma unroll
            for (int i = 0; i < 4; ++i) {
                const int cid = tid + 512 * i;
                *(LAS u32x4*)(buf + (cid >> 3) * RS + (cid & 7) * 16) = kr[i];
                *(LAS u32x4*)(buf + KREG + (cid >> 5) * RSV + (cid & 31) * 16) = vr[i];
            }
        };
        stage_load(0);
        f32x16 o0, o1, lacc;
#pragma unroll
        for (int i = 0; i < 16; ++i) { o0[i] = 0.f; o1[i] = 0.f; lacc[i] = 0.f; }
        float mrun = -1e30f;
        u32x4 mwa = *(const u32x4*)mrow, mwb = *(const u32x4*)(mrow + 4);
        __syncthreads();
        stage_store(lds);
        __syncthreads();
        for (int bs = 0; bs < nbig; ++bs) {
            LAS unsigned char* cur = lds + (bs & 1) * BUFB;
            const bool more = bs + 1 < nbig;
            if (more) stage_load(bs + 1);
            const unsigned mw8[8] = {mwa.x, mwa.y, mwa.z, mwa.w, mwb.x, mwb.y, mwb.z, mwb.w};
            if (more) { mwa = *(const u32x4*)(mrow + 8 * (bs + 1)); mwb = *(const u32x4*)(mrow + 8 * (bs + 1) + 4); }
            const int nv = (nst - 4 * bs) < 4 ? (nst - 4 * bs) : 4;
#pragma unroll
            for (int j = 0; j < 4; ++j) {
                if (j < nv) {
                    f32x16 sc[2];
                    {
                        bf16x8 kf[2][4];
#pragma unroll
                        for (int tt = 0; tt < 2; ++tt)
#pragma unroll
                            for (int jj = 0; jj < 4; ++jj) kf[tt][jj] = *(const LAS bf16x8*)(cur + kread + (j * 64 + tt * 32) * RS + 32 * jj);
#pragma unroll
                        for (int tt = 0; tt < 2; ++tt)
#pragma unroll
                            for (int i = 0; i < 16; ++i) sc[tt][i] = 0.f;
                        __builtin_amdgcn_s_setprio(1);
#pragma unroll
                        for (int jj = 0; jj < 4; ++jj)
#pragma unroll
                            for (int tt = 0; tt < 2; ++tt) sc[tt] = __builtin_amdgcn_mfma_f32_32x32x16_bf16(kf[tt][jj], qf[jj], sc[tt], 0, 0, 0);
                        __builtin_amdgcn_s_setprio(0);
                    }
                    float mx = __builtin_fmaxf(sc[0][0], sc[1][0]);
#pragma unroll
                    for (int i = 1; i < 16; ++i) mx = __builtin_fmaxf(__builtin_fmaxf(mx, sc[0][i]), sc[1][i]);
                    mx = xhalf_max(mx);
                    if (__ballot(mx > mrun + 8.0f) != 0ull) {
                        const float mnew = fmaxf(mrun, mx);
                        const float alpha = __builtin_amdgcn_exp2f((mrun - mnew) * LOG2E);
                        mrun = mnew;
#pragma unroll
                        for (int i = 0; i < 16; ++i) { o0[i] *= alpha; o1[i] *= alpha; lacc[i] *= alpha; }
                    }
                    const float nm = -mrun * LOG2E;
#pragma unroll
                    for (int tt = 0; tt < 2; ++tt) {
                        const unsigned mw = mw8[2 * j + tt] >> (8 * hf);
                        float p[16];
#pragma unroll
                        for (int i = 0; i < 16; ++i) {
                            const float e = __builtin_amdgcn_exp2f(__builtin_fmaf(sc[tt][i], LOG2E, nm));
                            const unsigned msk = (unsigned)__builtin_amdgcn_sbfe((int)mw, (i & 7) + 16 * (i >> 3), 1);
                            p[i] = __uint_as_float(__float_as_uint(e) & msk);
                        }
#pragma unroll
                        for (int s2 = 0; s2 < 2; ++s2) {
                            u32x4 pw = {pk2(p[8 * s2], p[8 * s2 + 1]), pk2(p[8 * s2 + 2], p[8 * s2 + 3]), pk2(p[8 * s2 + 4], p[8 * s2 + 5]), pk2(p[8 * s2 + 6], p[8 * s2 + 7])};
                            const bf16x8 pf = __builtin_bit_cast(bf16x8, pw);
                            const bf16x8 v0 = *(const LAS bf16x8*)(cur + vread + (j * 64 + tt * 32 + 16 * s2) * 2);
                            const bf16x8 v1 = *(const LAS bf16x8*)(cur + vread + 32 * RSV + (j * 64 + tt * 32 + 16 * s2) * 2);
                            o0 = __builtin_amdgcn_mfma_f32_32x32x16_bf16(v0, pf, o0, 0, 0, 0);
                            o1 = __builtin_amdgcn_mfma_f32_32x32x16_bf16(v1, pf, o1, 0, 0, 0);
                            lacc = __builtin_amdgcn_mfma_f32_32x32x16_bf16(ones, pf, lacc, 0, 0, 0);
                        }
                    }
                }
            }
            if (more) stage_store(lds + ((bs & 1) ^ 1) * BUFB);
            __syncthreads();
        }
        const float inv = 1.0f / lacc[0];
        bf16_t* op = O + (size_t)row * 1024 + head * 64 + 4 * hf;
#pragma unroll
        for (int q = 0; q < 4; ++q) {
            u32x2 x0 = {pk2(o0[4 * q] * inv, o0[4 * q + 1] * inv), pk2(o0[4 * q + 2] * inv, o0[4 * q + 3] * inv)};
            u32x2 x1 = {pk2(o1[4 * q] * inv, o1[4 * q + 1] * inv), pk2(o1[4 * q + 2] * inv, o1[4 * q + 3] * inv)};
            *(u32x2*)(op + 8 * q) = x0; *(u32x2*)(op + 32 + 8 * q) = x1;
        }
    }
}

DI void phase_final(const Args& a) {
    const int tid = threadIdx.x, wave = tid >> 6, lane = tid & 63, G = gridDim.x;
    const float* ss = (const float*)(a.ws + WS_SS1);
    const bf16_t* Xb = (const bf16_t*)(a.ws + WS_HB);
    const float* gf = a.in[8];
    f32x4 g0[2], g1[2];
#pragma unroll
    for (int j = 0; j < 2; ++j) { g0[j] = *(const f32x4*)(gf + (lane + 64 * j) * 8); g1[j] = *(const f32x4*)(gf + (lane + 64 * j) * 8 + 4); }
    for (int row = blockIdx.x * 8 + wave; row < NR; row += G * 8) {
        float s = ss[(size_t)row * 16 + (lane & 15)];
        s += __shfl_xor(s, 1); s += __shfl_xor(s, 2); s += __shfl_xor(s, 4); s += __shfl_xor(s, 8);
        const float rstd = __builtin_amdgcn_rsqf(s * (1.0f / 1024.0f) + EPS);
        const u32x4* hr = (const u32x4*)(Xb + (size_t)row * D) + lane;
        f32x4* yr = (f32x4*)(a.out + (size_t)row * D) + 2 * lane;
#pragma unroll
        for (int j = 0; j < 2; ++j) {
            const u32x4 h = hr[64 * j];
            f32x4 y0 = {__uint_as_float(h.x << 16), __uint_as_float(h.x & 0xffff0000u), __uint_as_float(h.y << 16), __uint_as_float(h.y & 0xffff0000u)};
            f32x4 y1 = {__uint_as_float(h.z << 16), __uint_as_float(h.z & 0xffff0000u), __uint_as_float(h.w << 16), __uint_as_float(h.w & 0xffff0000u)};
            yr[128 * j] = y0 * rstd * g0[j]; yr[128 * j + 1] = y1 * rstd * g1[j];
        }
    }
}

#define XB_TMO      128
#define XB_XCNT(j)  (256  + 64 * (j))
#define XB_XSUB(j)  (1280 + 64 * (j))
#define XB_XGEN(j)  (2304 + 64 * (j))
#define XB_TOP      3328
#define XB_TOPGEN   3392
#define XCD_BAR_WORDS 3456
#define XB_SPIN_CAP (1u << 20)
DI unsigned xb_ld(unsigned* p)              { return __hip_atomic_load(p, __ATOMIC_RELAXED, __HIP_MEMORY_SCOPE_AGENT); }
DI unsigned xb_add(unsigned* p, unsigned v) { return __hip_atomic_fetch_add(p, v, __ATOMIC_RELAXED, __HIP_MEMORY_SCOPE_AGENT); }
DI unsigned xb_xcc_id() { return (unsigned)__builtin_amdgcn_s_getreg((3 << 11) | 20) & 0xFu; }
#define XB_SPIN(cond, bar) do { unsigned _sp = 0; while (cond) { __builtin_amdgcn_s_sleep(1); \
    if ((++_sp & 255u) == 0u) { if (xb_ld(&(bar)[XB_TMO])) break; if (_sp > XB_SPIN_CAP) { atomicAdd(&(bar)[XB_TMO], 1u); break; } } } } while (0)
struct XcdBarrier { unsigned* bar; unsigned x; volatile LAS unsigned* st; };
DI XcdBarrier xcd_barrier_post(unsigned* bar, volatile LAS unsigned* st) {
    XcdBarrier b; b.bar = bar; b.x = xb_xcc_id(); b.st = st;
    if (threadIdx.x == 0) (void)xb_add(&bar[XB_XCNT(b.x)], 1u);
    return b;
}
DI void xcd_barrier_complete(unsigned* bar, unsigned x, unsigned& nloc, unsigned& nx) {
    const unsigned G = gridDim.x * gridDim.y * gridDim.z;
    unsigned sum, cnt, mine, sp = 0u;
    for (;;) {
        sum = 0u; cnt = 0u; mine = 0u;
#pragma unroll
        for (unsigned j = 0; j < 16; ++j) { const unsigned c = xb_ld(&bar[XB_XCNT(j)]); sum += c; cnt += (c > 0u) ? 1u : 0u; mine = (j == x) ? c : mine; }
        if (sum == G) break;
        __builtin_amdgcn_s_sleep(1);
        if ((++sp & 255u) == 0u) { if (xb_ld(&bar[XB_TMO])) break; if (sp > XB_SPIN_CAP) { atomicAdd(&bar[XB_TMO], 1u); break; } }
    }
    nloc = mine > 0u ? mine : 1u; nx = cnt > 0u ? cnt : 1u;
}
DI void xcd_barrier(const XcdBarrier& b) {
    asm volatile("s_waitcnt vmcnt(0)" ::: "memory");
    __syncthreads();
    if (threadIdx.x == 0) {
        unsigned* bar = b.bar;
        __builtin_amdgcn_s_waitcnt(0);
        unsigned nloc = b.st[0], nx = b.st[1];
        if (nloc == 0u) { xcd_barrier_complete(bar, b.x, nloc, nx); b.st[0] = nloc; b.st[1] = nx; }
        const unsigned old = xb_add(&bar[XB_XSUB(b.x)], 1u);
        const unsigned gen = old / nloc;
        if (old + 1u == (gen + 1u) * nloc) {
            __builtin_amdgcn_fence(__ATOMIC_RELEASE, "agent");
            asm volatile("s_waitcnt vmcnt(0)" ::: "memory");
            const unsigned og = xb_add(&bar[XB_TOP], 1u);
            const unsigned tg = og / nx;
            if (og + 1u == (tg + 1u) * nx) xb_add(&bar[XB_TOPGEN], 1u);
            else XB_SPIN(xb_ld(&bar[XB_TOPGEN]) == tg, bar);
            __builtin_amdgcn_fence(__ATOMIC_ACQUIRE, "agent");
            xb_add(&bar[XB_XGEN(b.x)], 1u);
            asm volatile("s_waitcnt vmcnt(0)" ::: "memory");
        } else {
            XB_SPIN(xb_ld(&bar[XB_XGEN(b.x)]) == gen, bar);
            __builtin_amdgcn_fence(__ATOMIC_ACQUIRE, "agent");
            asm volatile("s_waitcnt vmcnt(0)" ::: "memory");
        }
    }
    __syncthreads();
}

__global__ void __launch_bounds__(512, 2) fwd_kernel(Args a) {
    extern __shared__ __attribute__((aligned(16))) unsigned char lds_raw[];
    LAS unsigned char* lds = (LAS unsigned char*)lds_raw;
    cg::grid_group grid = cg::this_grid();
    volatile LAS unsigned* xst = (volatile LAS unsigned*)(lds + LDS_PHASE);
    if (threadIdx.x == 0) { xst[0] = 0u; xst[1] = 0u; }
    __syncthreads();
    const XcdBarrier xb = xcd_barrier_post((unsigned*)(a.ws + WS_BAR), xst);
    unsigned char* ws = a.ws;
    const int G = gridDim.x;
    pg8::StaticOrder S;
    float* ss0 = (float*)(ws + WS_SS0); float* ss1 = (float*)(ws + WS_SS1);
    bf16_t* HA = (bf16_t*)(ws + WS_HA); bf16_t* Xb = (bf16_t*)(ws + WS_HB); bf16_t* U = (bf16_t*)(ws + WS_U);
#ifndef PHMASK
#define PHMASK 0xfff
#endif
#ifndef PROBE_REP
#define PROBE_REP 0x0
#endif
#define PHASE(k) if (((PHMASK >> (k)) & 1) && (k) >= a.ph_lo && (k) < a.ph_hi)
#define SEAM(k) do { if ((k) >= a.ph_lo && (k) + 1 < a.ph_hi) xcd_barrier(xb); } while (0)
    const bool defer0 = (G == 256);
    PHASE(0) { phase0(a, lds, defer0 ? 1 : 7, blockIdx.x, G); phase1(a, lds); }
#if PROBE_REP & 0x1
    grid.sync(); phase0(a, lds, 7, blockIdx.x, G); phase1(a, lds);
#endif
    SEAM(0);
    PHASE(1) {
        pg8::Gemm g{HA, (const bf16_t*)(ws + WS_WPOOL), NR, 1024, 256, 1024, 256, 512};
        S.init(NR, 1024, G, blockIdx.x);
        EpiRes<true, true> E{a.in[0], a.in[1], Xb, a.in[10], ss0};
        pg8::gemm_phase(lds, g, S, E);
        if (defer0 && blockIdx.x >= 16) phase0(a, lds, 4, blockIdx.x - 16, 240);
    }
    SEAM(1);
    PHASE(2) {
        pg8::Gemm g{Xb, (const bf16_t*)(ws + WS_WUP0), NR, DFF, 1024, 1024, 1024, 0};
        S.init(NR, DFF, G, blockIdx.x);
        EpiUp E{ss0, U};
        pg8::gemm_phase(lds, g, S, E);
    }
    SEAM(2);
    PHASE(3) {
        pg8::Gemm g{U, (const bf16_t*)(ws + WS_WDN0), NR, 1024, DFF, DFF, DFF, 0};
        S.init(NR, 1024, G, blockIdx.x);
        EpiRes<false, false> E{nullptr, nullptr, Xb, nullptr, ss1};
        pg8::gemm_phase(lds, g, S, E);
        if (defer0 && blockIdx.x >= 16) phase0(a, lds, 2, blockIdx.x - 16, 240);
    }
    SEAM(3);
    PHASE(4) {
        pg8::Gemm g{Xb, (const bf16_t*)(ws + WS_WIN), NR, NWIN, 1024, 1024, 1024, 0};
        S.init(NR, NWIN, G, blockIdx.x);
        EpiWin E{ss1, (const float*)(ws + WS_ROPE), (bf16_t*)(ws + WS_Q), (bf16_t*)(ws + WS_QI), (bf16_t*)(ws + WS_KP), (bf16_t*)(ws + WS_VTP), (bf16_t*)(ws + WS_KIP),
                 (bf16_t*)(ws + WS_KS), (bf16_t*)(ws + WS_VTS), (bf16_t*)(ws + WS_KIS), (float*)(ws + WS_WI), a.out};
        pg8::gemm_phase(lds, g, S, E);
    }
    SEAM(4);
    PHASE(5) { phase_index(a, lds); }
    SEAM(5);
    PHASE(6) { phase_attn(a, lds); }
    SEAM(6);
    PHASE(7) {
        pg8::Gemm g{HA, (const bf16_t*)(ws + WS_WO), NR, 1024, 1024, 1024, 1024, 0};
        S.init(NR, 1024, G, blockIdx.x);
        EpiRes<false, false> E{nullptr, nullptr, Xb, nullptr, ss0};
        pg8::gemm_phase(lds, g, S, E);
    }
    SEAM(7);
    PHASE(8) {
        pg8::Gemm g{Xb, (const bf16_t*)(ws + WS_WUP1), NR, DFF, 1024, 1024, 1024, 0};
        S.init(NR, DFF, G, blockIdx.x);
        EpiUp E{ss0, U};
        pg8::gemm_phase(lds, g, S, E);
    }
    SEAM(8);
    PHASE(9) {
        pg8::Gemm g{U, (const bf16_t*)(ws + WS_WDN1), NR, 1024, DFF, DFF, DFF, 0};
        S.init(NR, 1024, G, blockIdx.x);
        EpiRes<false, false> E{nullptr, nullptr, Xb, nullptr, ss1};
        pg8::gemm_phase(lds, g, S, E);
    }
    SEAM(9);
    PHASE(10) { phase_final(a); }
    if (a.ph_hi > 1000) grid.sync();
}

#ifndef N_LAUNCHES
#define N_LAUNCHES 1
#endif
extern "C" void kernel_launch(void* const* d_in, const int* in_sizes, int n_in, void* d_out, int out_size, void* d_ws, size_t ws_size, hipStream_t stream) {
    static int grid = 0;
    if (grid == 0) {
        if (n_in != 15 || out_size != 107233280 || ws_size < WS_END) { fprintf(stderr, "kernel_launch: unexpected shapes (n_in %d out %d ws %zu need %zu)\n", n_in, out_size, ws_size, (size_t)WS_END); grid = -1; return; }
        int dev = 0, cus = 0, per_cu = 0;
        hipGetDevice(&dev); hipDeviceGetAttribute(&cus, hipDeviceAttributeMultiprocessorCount, dev);
        if (hipFuncSetAttribute((const void*)fwd_kernel, hipFuncAttributeMaxDynamicSharedMemorySize, LDS_BYTES) != hipSuccess) { fprintf(stderr, "kernel_launch: hipFuncSetAttribute failed\n"); grid = -1; return; }
        hipOccupancyMaxActiveBlocksPerMultiprocessor(&per_cu, (const void*)fwd_kernel, 512, LDS_BYTES);
        if (per_cu < 1) { fprintf(stderr, "kernel_launch: occupancy query says %d\n", per_cu); per_cu = 1; }
        (void)hipGetLastError();
        grid = cus;
    }
    if (grid < 0) return;
    if (hipMemsetAsync((char*)d_ws + WS_BAR, 0, XCD_BAR_WORDS * 4, stream) != hipSuccess) { fprintf(stderr, "kernel_launch: memset of the barrier words failed\n"); return; }
    Args a{};
    for (int i = 0; i < 15; ++i) a.in[i] = (const float*)d_in[i];
    a.out = (float*)d_out; a.ws = (unsigned char*)d_ws;
#if N_LAUNCHES == 1
    a.ph_lo = 0; a.ph_hi = 11;
    void* args[] = {&a};
    hipError_t e = hipLaunchCooperativeKernel((const void*)fwd_kernel, dim3(grid), dim3(512), args, LDS_BYTES, stream);
    if (e != hipSuccess) fprintf(stderr, "cooperative launch failed: %s (grid %d)\n", hipGetErrorString(e), grid);
#else
    for (int ph = 0; ph < 11; ++ph) { a.ph_lo = ph; a.ph_hi = ph + 1; hipLaunchKernelGGL(fwd_kernel, dim3(grid), dim3(512), LDS_BYTES, stream, a); }
#endif
}
```

```cpp
#include <hip/hip_runtime.h>
#include <hip/hip_cooperative_groups.h>
#include <cstdio>
#include <cstdint>
namespace cg = cooperative_groups;

#define LAS __attribute__((address_space(3)))
#define DI __device__ __forceinline__
typedef unsigned short bf16_t;
typedef short bf16x8 __attribute__((ext_vector_type(8)));
typedef float f32x2 __attribute__((ext_vector_type(2)));
typedef float f32x4 __attribute__((ext_vector_type(4)));
typedef float f32x16 __attribute__((ext_vector_type(16)));
typedef unsigned u32x2 __attribute__((ext_vector_type(2)));
typedef unsigned u32x4 __attribute__((ext_vector_type(4)));
typedef __bf16 bfv2 __attribute__((ext_vector_type(2)));

constexpr int D = 1024, NP = 65536, NS = 1024, NR = NP + NS, TP = 2048, TS = 64, LS = 2112, DFF = 4096;
constexpr int NWIN = 2304;
constexpr int MASKW = 68;
constexpr float EPS = 1e-6f;
constexpr size_t O_Y = 0, O_POOLP = 68157440, O_POOLS = 68648960, O_KP = 68894720, O_VP = 85671936, O_KIP = 102449152,
                 O_KS = 106643456, O_VS = 106905600, O_KIS = 107167744;
constexpr size_t WS_WPOOL = 0;
constexpr size_t WS_WIN = WS_WPOOL + 524288;
constexpr size_t WS_WO = WS_WIN + (size_t)NWIN * 1024 * 2;
constexpr size_t WS_WUP0 = WS_WO + 2097152;
constexpr size_t WS_WUP1 = WS_WUP0 + 8388608;
constexpr size_t WS_WDN0 = WS_WUP1 + 8388608;
constexpr size_t WS_WDN1 = WS_WDN0 + 8388608;
constexpr size_t WS_ROPE = WS_WDN1 + 8388608;
constexpr size_t WS_SS0 = WS_ROPE + 540672;
constexpr size_t WS_SS1 = WS_SS0 + (size_t)NR * 64;
constexpr size_t WS_KS = WS_SS1 + (size_t)NR * 64;
constexpr size_t WS_VTS = WS_KS + (size_t)16 * 4 * LS * 64 * 2;
constexpr size_t WS_KIS = WS_VTS + (size_t)16 * 4 * LS * 64 * 2;
constexpr size_t WS_HA = WS_KIS + (size_t)16 * LS * 64 * 2;
constexpr size_t WS_HB = WS_HA + (size_t)NR * 1024 * 2;
constexpr size_t WS_U = WS_HB + (size_t)NR * 1024 * 2;
constexpr size_t WS_BAR = WS_U + (size_t)NR * 4096 * 2;
constexpr size_t WS_END = WS_BAR + 16384;
constexpr size_t WS_Q = WS_U;
constexpr size_t WS_QI = WS_Q + (size_t)NR * 1024 * 2;
constexpr size_t WS_KP = WS_QI + (size_t)NR * 512 * 2;
constexpr size_t WS_VTP = WS_KP + (size_t)32 * 4 * 2048 * 64 * 2;
constexpr size_t WS_KIP = WS_VTP + (size_t)32 * 4 * 2048 * 64 * 2;
constexpr size_t WS_WI = WS_KIP + (size_t)32 * 2048 * 64 * 2;
constexpr size_t WS_MASK = WS_WI + (size_t)NR * 8 * 4;
constexpr size_t WS_ALIAS_END = WS_MASK + (size_t)NR * MASKW * 4;
static_assert(WS_ALIAS_END <= WS_BAR, "alias overflow");

constexpr int LDS_PHASE = 141312;
constexpr int LDS_BYTES = LDS_PHASE + 16;

struct Args {
    const float* in[15];
    float* out;
    unsigned char* ws;
    int ph_lo, ph_hi;
};

DI unsigned pk2(float lo, float hi) { f32x2 v = {lo, hi}; bfv2 b = __builtin_convertvector(v, bfv2); return __builtin_bit_cast(unsigned, b); }
DI float bf2f(bf16_t b) { return __uint_as_float(((unsigned)b) << 16); }
DI float xhalf_max(float x) {
    auto r = __builtin_amdgcn_permlane32_swap(__float_as_uint(x), __float_as_uint(x), false, false);
    return fmaxf(__uint_as_float(r[0]), __uint_as_float(r[1]));
}
DI float xhalf_sum(float x) {
    auto r = __builtin_amdgcn_permlane32_swap(__float_as_uint(x), __float_as_uint(x), false, false);
    return __uint_as_float(r[0]) + __uint_as_float(r[1]);
}

namespace pg8 {
constexpr int BM = 256, BK = 64, HALF = 128, HTB = HALF * BK * 2, STAGE_BYTES = 8 * HTB, NXCD = 8, WGM = 8;
DI int lds_byte(int r, int c) { const int st = (r >> 4) * 2 + (c >> 5), rr = r & 15, cc = c & 31, ob = rr * 64 + cc * 2; return st * 1024 + (ob ^ (((ob >> 9) & 1) << 5)); }
DI void stage_rc(int b, int& R, int& C) { const int st = b / 1024, sb = b % 1024, swz = sb ^ (((sb >> 9) & 1) << 5); R = (st >> 1) * 16 + swz / 64; C = (st & 1) * 32 + (swz % 64) / 2; }
DI int perm32(int rho) { const int n = rho >> 4, i = rho & 15; return 8 * (i >> 2) + 4 * n + (i & 3); }
struct Unit { int pm, pn; };
struct Gemm { const bf16_t* A; const bf16_t* Bt; int M, N, K, lda, ldb, a_pn_bytes; };
struct StaticOrder {
    int nM, nN, nwg, G, c;
    DI void init(int M, int N, int G_, int c_) { nM = M / BM; nN = N / BM; nwg = nM * nN; G = G_; c = c_; }
    DI bool next(int i, Unit& u) const {
        const long L = (long)i * G + c; if (L >= nwg) return false;
        int wgid = (int)L; { const int q = nwg / NXCD, r = nwg % NXCD, xcd = wgid % NXCD, off = wgid / NXCD; wgid = (xcd < r ? xcd * (q + 1) : r * (q + 1) + (xcd - r) * q) + off; }
        const int nig = WGM * nN, gid = wgid / nig, fm = gid * WGM, gsz = (nM - fm) < WGM ? (nM - fm) : WGM;
        u.pm = fm + ((wgid % nig) % gsz); u.pn = (wgid % nig) / gsz; return true;
    }
};

template <class Epi>
DI void gemm_phase(LAS unsigned char* lds, const Gemm g, const StaticOrder& S, const Epi& E) {
    const int tid = threadIdx.x, wid = __builtin_amdgcn_readfirstlane(tid >> 6), lane = tid & 63, wr = wid >> 2, wc = wid & 3, fr = lane & 15, fq = lane >> 4;
    const int K = g.K, nt = K / BK;
    unsigned voffA[2], voffB[2];
#pragma unroll
    for (int i = 0; i < 2; ++i) { int R, C; stage_rc(tid * 16 + i * 8192, R, C); const int Rb = (R & ~31) + perm32(R & 31);
        voffA[i] = (unsigned)(R * g.lda + C) * 2u; voffB[i] = (unsigned)(Rb * g.ldb + C) * 2u; }
    const size_t kstep = (size_t)(BK * 2);
    const size_t hstepA = (size_t)HALF * g.lda * 2, hstepB = (size_t)HALF * g.ldb * 2;
    const size_t tstepA = 2 * hstepA, tstepB = 2 * hstepB;
    const unsigned ldsw = (unsigned)wid * 1024u;
    const int aoff = lds_byte(wr * 64 + fr, fq * 8), boff = lds_byte(wc * 32 + fr, fq * 8);
#define PG8_SA(b, h) (((b) * 2 + (h)) * HTB)
#define PG8_SB(b, h) ((4 + (b) * 2 + (h)) * HTB)
#define PG8_STAGE(bufoff, gbase, voff) do { _Pragma("unroll") for (int _i = 0; _i < 2; ++_i) \
        __builtin_amdgcn_global_load_lds((const unsigned*)((const char*)(gbase) + (voff)[_i]), (LAS unsigned*)(lds + (bufoff) + ldsw + _i * 8192), 16, 0, 0); } while (0)
#define PG8_LDA(dst, b, h) do { _Pragma("unroll") for (int m = 0; m < 4; ++m) _Pragma("unroll") for (int k = 0; k < 2; ++k) dst[m][k] = *(const LAS bf16x8*)(lds + PG8_SA(b, h) + aoff + m * 2048 + k * 1024); } while (0)
#define PG8_LDB(dst, b, h) do { _Pragma("unroll") for (int n = 0; n < 2; ++n) _Pragma("unroll") for (int k = 0; k < 2; ++k) dst[n][k] = *(const LAS bf16x8*)(lds + PG8_SB(b, h) + boff + n * 2048 + k * 1024); } while (0)
#define PG8_MMA(ai, bj, At, Bt) do { __builtin_amdgcn_s_setprio(1); _Pragma("unroll") for (int m = 0; m < 4; ++m) _Pragma("unroll") for (int n = 0; n < 2; ++n) _Pragma("unroll") for (int k = 0; k < 2; ++k) \
        acc[ai][bj][m][n] = __builtin_amdgcn_mfma_f32_16x16x32_bf16(Bt[n][k], At[m][k], acc[ai][bj][m][n], 0, 0, 0); __builtin_amdgcn_s_setprio(0); } while (0)
#define PG8_WAIT_V(n) asm volatile("s_waitcnt vmcnt(" #n ")" ::: "memory")
#define PG8_WAIT_L(n) asm volatile("s_waitcnt lgkmcnt(" #n ")" ::: "memory")
#define PG8_BAR __builtin_amdgcn_s_barrier()
#define PG8_SCHED __builtin_amdgcn_sched_barrier(0)
    Unit cur, nxt; int ui = 0;
    if (!S.next(0, cur)) return;
    f32x4 acc[2][2][4][2];
#pragma unroll
    for (int a = 0; a < 2; ++a)
#pragma unroll
        for (int b = 0; b < 2; ++b)
#pragma unroll
            for (int m = 0; m < 4; ++m)
#pragma unroll
                for (int n = 0; n < 2; ++n) acc[a][b][m][n] = (f32x4){0.f, 0.f, 0.f, 0.f};
    bf16x8 At[4][2], B0[2][2], B1[2][2];
    const char* cA = (const char*)g.A + (size_t)cur.pm * tstepA + (size_t)cur.pn * g.a_pn_bytes; const char* cB = (const char*)g.Bt + (size_t)cur.pn * tstepB;
    PG8_STAGE(PG8_SB(0, 0), cB, voffB); PG8_STAGE(PG8_SB(0, 1), cB + hstepB, voffB); PG8_STAGE(PG8_SA(0, 0), cA, voffA); PG8_STAGE(PG8_SA(0, 1), cA + hstepA, voffA);
    if (wr == 1) PG8_BAR;
    PG8_WAIT_V(2); PG8_BAR;
    PG8_STAGE(PG8_SB(1, 0), cB + kstep, voffB); PG8_STAGE(PG8_SA(1, 0), cA + kstep, voffA); PG8_STAGE(PG8_SB(1, 1), cB + hstepB + kstep, voffB);
    PG8_WAIT_V(6); PG8_BAR;
    for (;;) {
        const bool has_next = S.next(ui + 1, nxt);
        const char* nA = has_next ? (const char*)g.A + (size_t)nxt.pm * tstepA + (size_t)nxt.pn * g.a_pn_bytes : cA; const char* nB = has_next ? (const char*)g.Bt + (size_t)nxt.pn * tstepB : cB;
#pragma unroll 1
        for (int t = 0; t < nt; t += 2) {
            const bool last = (t == nt - 2);
            const char* a1 = cA + (size_t)(t + 1) * kstep;
            const char* a2 = last ? nA : cA + (size_t)(t + 2) * kstep; const char* b2 = last ? nB : cB + (size_t)(t + 2) * kstep;
            const char* a3 = a2 + kstep; const char* b3 = b2 + kstep;
            PG8_LDB(B0, 0, 0); PG8_LDB(B1, 0, 1); PG8_SCHED; PG8_LDA(At, 0, 0); PG8_STAGE(PG8_SA(1, 1), a1 + hstepA, voffA);
            PG8_WAIT_V(8); PG8_WAIT_L(0); PG8_BAR; PG8_MMA(0, 0, At, B0); PG8_MMA(0, 1, At, B1); PG8_BAR; PG8_SCHED;
            PG8_LDA(At, 0, 1); PG8_STAGE(PG8_SB(0, 0), b2, voffB); PG8_STAGE(PG8_SB(0, 1), b2 + hstepB, voffB); PG8_STAGE(PG8_SA(0, 0), a2, voffA);
            PG8_WAIT_V(8); PG8_WAIT_L(0); PG8_BAR; PG8_MMA(1, 0, At, B0); PG8_MMA(1, 1, At, B1); PG8_BAR; PG8_SCHED;
            PG8_LDB(B0, 1, 0); PG8_LDB(B1, 1, 1); PG8_SCHED; PG8_LDA(At, 1, 0); PG8_STAGE(PG8_SA(0, 1), a2 + hstepA, voffA);
            PG8_WAIT_V(8); PG8_WAIT_L(0); PG8_BAR; PG8_MMA(0, 0, At, B0); PG8_MMA(0, 1, At, B1); PG8_BAR; PG8_SCHED;
            PG8_LDA(At, 1, 1); PG8_STAGE(PG8_SB(1, 0), b3, voffB); PG8_STAGE(PG8_SB(1, 1), b3 + hstepB, voffB); PG8_STAGE(PG8_SA(1, 0), a3, voffA);
            PG8_WAIT_V(8); PG8_WAIT_L(0); PG8_BAR; PG8_MMA(1, 0, At, B0); PG8_MMA(1, 1, At, B1); PG8_BAR; PG8_SCHED;
        }
        if (wr == 0) PG8_BAR;
        E(acc, cur, wr, wc, fr, fq);
        if (!has_next) break;
#pragma unroll
        for (int a = 0; a < 2; ++a)
#pragma unroll
            for (int b = 0; b < 2; ++b)
#pragma unroll
                for (int m = 0; m < 4; ++m)
#pragma unroll
                    for (int n = 0; n < 2; ++n) acc[a][b][m][n] = (f32x4){0.f, 0.f, 0.f, 0.f};
        cur = nxt; cA = nA; cB = nB; ++ui;
        if (wr == 1) PG8_BAR;
    }
    PG8_WAIT_V(0);
    PG8_BAR;
#undef PG8_SA
#undef PG8_SB
#undef PG8_STAGE
#undef PG8_LDA
#undef PG8_LDB
#undef PG8_MMA
#undef PG8_WAIT_V
#undef PG8_WAIT_L
#undef PG8_BAR
#undef PG8_SCHED
}
}
using pg8::Unit;

DI float row_rstd(const float* ss, int row) {
    const f32x4* p = (const f32x4*)(ss + (size_t)row * 16);
    f32x4 a = p[0], b = p[1], c = p[2], d = p[3];
    const float s = ((a.x + a.y) + (a.z + a.w)) + ((b.x + b.y) + (b.z + b.w)) + ((c.x + c.y) + (c.z + c.w)) + ((d.x + d.y) + (d.z + d.w));
    return __builtin_amdgcn_rsqf(s * (1.0f / 1024.0f) + EPS);
}

template <bool HAS_SCALE, bool IN_F32>
struct EpiRes {
    const float* xin_p; const float* xin_s; bf16_t* X; const float* colscale; float* ss;
    DI void operator()(const f32x4 (&acc)[2][2][4][2], const Unit& u, int wr, int wc, int fr, int fq) const {
        const int col0 = u.pn * 256 + wc * 32 + 8 * fq;
        float sq[2][4];
#pragma unroll
        for (int ai = 0; ai < 2; ++ai)
#pragma unroll
            for (int m = 0; m < 4; ++m) sq[ai][m] = 0.f;
#pragma unroll
        for (int bj = 0; bj < 2; ++bj) {
            const int col = col0 + bj * 128;
            f32x4 sc0, sc1;
            if (HAS_SCALE) { sc0 = *(const f32x4*)(colscale + col); sc1 = *(const f32x4*)(colscale + col + 4); }
#pragma unroll
            for (int ai = 0; ai < 2; ++ai)
#pragma unroll
                for (int m = 0; m < 4; ++m) {
                    const int row = u.pm * 256 + ai * 128 + wr * 64 + m * 16 + fr;
                    bf16_t* xb = X + (size_t)row * D + col;
                    f32x4 x0, x1;
                    if (IN_F32) {
                        const float* xr = (row < NP) ? xin_p + (size_t)row * D : xin_s + (size_t)(row - NP) * D;
                        x0 = *(const f32x4*)(xr + col); x1 = *(const f32x4*)(xr + col + 4);
                    } else {
                        const u32x4 h = *(const u32x4*)xb;
                        x0 = (f32x4){__uint_as_float(h.x << 16), __uint_as_float(h.x & 0xffff0000u), __uint_as_float(h.y << 16), __uint_as_float(h.y & 0xffff0000u)};
                        x1 = (f32x4){__uint_as_float(h.z << 16), __uint_as_float(h.z & 0xffff0000u), __uint_as_float(h.w << 16), __uint_as_float(h.w & 0xffff0000u)};
                    }
                    f32x4 y0 = acc[ai][bj][m][0], y1 = acc[ai][bj][m][1];
                    if (HAS_SCALE) { y0 = y0 * sc0; y1 = y1 * sc1; }
                    x0 = x0 + y0; x1 = x1 + y1;
                    sq[ai][m] += (x0.x * x0.x + x0.y * x0.y) + (x0.z * x0.z + x0.w * x0.w) + (x1.x * x1.x + x1.y * x1.y) + (x1.z * x1.z + x1.w * x1.w);
                    u32x4 o; o.x = pk2(x0.x, x0.y); o.y = pk2(x0.z, x0.w); o.z = pk2(x1.x, x1.y); o.w = pk2(x1.z, x1.w);
                    *(u32x4*)xb = o;
                }
        }
#pragma unroll
        for (int ai = 0; ai < 2; ++ai)
#pragma unroll
            for (int m = 0; m < 4; ++m) {
                const int row = u.pm * 256 + ai * 128 + wr * 64 + m * 16 + fr;
                float q = sq[ai][m];
                q += __shfl_xor(q, 16); q += __shfl_xor(q, 32);
                if (fq == 0) ss[(size_t)row * 16 + u.pn * 4 + wc] = q;
            }
    }
};

struct EpiUp {
    const float* ss; bf16_t* U;
    DI void operator()(const f32x4 (&acc)[2][2][4][2], const Unit& u, int wr, int wc, int fr, int fq) const {
        const int col0 = u.pn * 256 + wc * 32 + 8 * fq;
#pragma unroll
        for (int ai = 0; ai < 2; ++ai)
#pragma unroll
            for (int m = 0; m < 4; ++m) {
                const int row = u.pm * 256 + ai * 128 + wr * 64 + m * 16 + fr;
                const float rstd = row_rstd(ss, row);
#pragma unroll
                for (int bj = 0; bj < 2; ++bj) {
                    f32x4 v0 = acc[ai][bj][m][0] * rstd, v1 = acc[ai][bj][m][1] * rstd;
                    float e[8] = {v0.x, v0.y, v0.z, v0.w, v1.x, v1.y, v1.z, v1.w};
#pragma unroll
                    for (int i = 0; i < 8; ++i) { const float r = fmaxf(e[i], 0.f); e[i] = r * r; }
                    u32x4 o; o.x = pk2(e[0], e[1]); o.y = pk2(e[2], e[3]); o.z = pk2(e[4], e[5]); o.w = pk2(e[6], e[7]);
                    *(u32x4*)(U + (size_t)row * DFF + col0 + bj * 128) = o;
                }
            }
    }
};

struct EpiWin {
    const float* ss; const float* rope;
    bf16_t *Q, *QI, *KP, *VTP, *KIP, *KS, *VTS, *KIS; float* WI; float* out;
    DI void operator()(const f32x4 (&acc)[2][2][4][2], const Unit& u, int wr, int wc, int fr, int fq) const {
        const int q8 = (wc & 1) * 4 + fq;
        const bool smp = u.pm >= 256;
#pragma unroll
        for (int ai = 0; ai < 2; ++ai)
#pragma unroll
            for (int m = 0; m < 4; ++m) {
                const int row = u.pm * 256 + ai * 128 + wr * 64 + m * 16 + fr;
                const float rstd = row_rstd(ss, row);
                int b, pos, L; size_t rl;
                if (smp) { const int rs = row - NP; b = rs >> 6; pos = 2048 + (rs & 63); L = LS; rl = rs; } else { b = row >> 11; pos = row & 2047; L = 2048; rl = row; }
                const f32x4 cs0 = *(const f32x4*)(rope + ((size_t)pos * 32 + 4 * q8) * 2), cs1 = *(const f32x4*)(rope + ((size_t)pos * 32 + 4 * q8) * 2 + 4);
                const float cc[4] = {cs0.x, cs0.z, cs1.x, cs1.z}, sn[4] = {cs0.y, cs0.w, cs1.y, cs1.w};
#pragma unroll
                for (int bj = 0; bj < 2; ++bj) {
                    const int blk = u.pn * 4 + bj * 2 + (wc >> 1);
                    const f32x4 v0 = acc[ai][bj][m][0] * rstd, v1 = acc[ai][bj][m][1] * rstd;
                    const float a0[4] = {v0.x, v0.y, v0.z, v0.w}, a1[4] = {v1.x, v1.y, v1.z, v1.w};
                    float r1[4], r2[4];
#pragma unroll
                    for (int i = 0; i < 4; ++i) { r1[i] = a0[i] * cc[i] - a1[i] * sn[i]; r2[i] = a1[i] * cc[i] + a0[i] * sn[i]; }
                    if (blk < 16) {
                        bf16_t* p = Q + (size_t)row * 1024 + blk * 64 + 8 * q8;
                        u32x4 o = {pk2(r1[0] * 0.125f, r1[1] * 0.125f), pk2(r1[2] * 0.125f, r1[3] * 0.125f), pk2(r2[0] * 0.125f, r2[1] * 0.125f), pk2(r2[2] * 0.125f, r2[3] * 0.125f)};
                        *(u32x4*)p = o;
                    } else if (blk < 20) {
                        const int g = blk - 16;
                        float* po = out + (smp ? O_KS : O_KP) + rl * 256 + g * 64 + 4 * q8;
                        *(f32x4*)po = (f32x4){r1[0], r1[1], r1[2], r1[3]}; *(f32x4*)(po + 32) = (f32x4){r2[0], r2[1], r2[2], r2[3]};
                        bf16_t* p = (smp ? KS : KP) + (((size_t)b * 4 + g) * L + pos) * 64 + 8 * q8;
                        u32x4 o = {pk2(r1[0], r1[1]), pk2(r1[2], r1[3]), pk2(r2[0], r2[1]), pk2(r2[2], r2[3])};
                        *(u32x4*)p = o;
                    } else if (blk < 24) {
                        const int g = blk - 20;
                        float* po = out + (smp ? O_VS : O_VP) + rl * 256 + g * 64 + 8 * q8;
                        *(f32x4*)po = v0; *(f32x4*)(po + 4) = v1;
                        bf16_t* p = (smp ? VTS : VTP) + (((size_t)b * 4 + g) * 64 + 8 * q8) * L + pos;
                        const unsigned w0 = pk2(a0[0], a0[1]), w1 = pk2(a0[2], a0[3]), w2 = pk2(a1[0], a1[1]), w3 = pk2(a1[2], a1[3]);
                        p[0] = (bf16_t)w0; p[(size_t)L] = (bf16_t)(w0 >> 16); p[(size_t)2 * L] = (bf16_t)w1; p[(size_t)3 * L] = (bf16_t)(w1 >> 16);
                        p[(size_t)4 * L] = (bf16_t)w2; p[(size_t)5 * L] = (bf16_t)(w2 >> 16); p[(size_t)6 * L] = (bf16_t)w3; p[(size_t)7 * L] = (bf16_t)(w3 >> 16);
                    } else if (blk < 32) {
                        bf16_t* p = QI + (size_t)row * 512 + (blk - 24) * 64 + 8 * q8;
                        u32x4 o = {pk2(r1[0] * 0.125f, r1[1] * 0.125f), pk2(r1[2] * 0.125f, r1[3] * 0.125f), pk2(r2[0] * 0.125f, r2[1] * 0.125f), pk2(r2[2] * 0.125f, r2[3] * 0.125f)};
                        *(u32x4*)p = o;
                    } else if (blk == 32) {
                        float* po = out + (smp ? O_KIS : O_KIP) + rl * 64 + 4 * q8;
                        *(f32x4*)po = (f32x4){r1[0], r1[1], r1[2], r1[3]}; *(f32x4*)(po + 32) = (f32x4){r2[0], r2[1], r2[2], r2[3]};
                        bf16_t* p = (smp ? KIS : KIP) + ((size_t)b * L + pos) * 64 + 8 * q8;
                        u32x4 o = {pk2(r1[0], r1[1]), pk2(r1[2], r1[3]), pk2(r2[0], r2[1]), pk2(r2[2], r2[3])};
                        *(u32x4*)p = o;
                    } else if (blk == 33 && q8 == 0) {
                        const float s = 0.35355339059327373f;
                        float* p = WI + (size_t)row * 8;
                        *(f32x4*)p = v0 * s; *(f32x4*)(p + 4) = v1 * s;
                    }
                }
            }
    }
};

DI int win_rowmap(int n) {
    const bool roped = (n < 1280) || (n >= 1536 && n < 2112);
    if (!roped) return n;
    const int j = n & 63, base = n & ~63;
    return base + (j < 32 ? 8 * (j >> 2) + (j & 3) : 8 * ((j - 32) >> 2) + 4 + (j & 3));
}
template <bool WINMAP>
DI void transpose_item(const float* W, int K, int N, bf16_t* WT, LAS float* scr, int item, int lane, const float* gk = nullptr) {
    const int nblk = (N + 31) / 32, kb = item / nblk, nb = item % nblk, k0 = 64 * kb, n0 = 32 * nb;
    const int ncol = n0 + (lane & 31);
#pragma unroll 8
    for (int i = 0; i < 32; ++i) { const int kk = 2 * i + (lane >> 5); float v = (ncol < N) ? W[(size_t)(k0 + kk) * N + ncol] : 0.f; if (gk) v *= gk[k0 + kk]; scr[kk * 33 + (lane & 31)] = v; }
    asm volatile("s_waitcnt lgkmcnt(0)" ::: "memory");
    const int c = lane & 7;
#pragma unroll
    for (int j = 0; j < 4; ++j) {
        const int nl = (lane >> 3) + 8 * j, n = n0 + nl;
        const LAS float* s = scr + (8 * c) * 33 + nl;
        u32x4 o; o.x = pk2(s[0], s[33]); o.y = pk2(s[2 * 33], s[3 * 33]); o.z = pk2(s[4 * 33], s[5 * 33]); o.w = pk2(s[6 * 33], s[7 * 33]);
        if (n < N) { const int rowo = WINMAP ? win_rowmap(n) : n; *(u32x4*)(WT + (size_t)rowo * K + k0 + 8 * c) = o; }
    }
    asm volatile("s_waitcnt lgkmcnt(0)" ::: "memory");
}

DI void phase0(const Args& a, LAS unsigned char* lds, int part, int vb, int VG) {
    const int tid = threadIdx.x, wave = tid >> 6, lane = tid & 63, G = VG;
    LAS float* scr = (LAS float*)(lds + wave * 8448);
    unsigned char* ws = a.ws;
    const int gw = vb * 8 + wave, NGW = G * 8;
    const bool pa = part & 1, pb = part & 2, pc = part & 4;
    constexpr int I_POOL = 4 * 4 * 8, I_WIN = 16 * 67, I_WO = 16 * 32, I_UP = 16 * 128, I_DN = 64 * 32;
    constexpr int NITEMS = I_POOL + I_WIN + I_WO + 2 * I_UP + 2 * I_DN;
    for (int it = gw; it < NITEMS; it += NGW) {
        int r = it;
        if (r < I_POOL) { if (!pa) continue; const int g = r >> 5; transpose_item<false>(a.in[9] + (size_t)g * 65536, 256, 256, (bf16_t*)(ws + WS_WPOOL) + (size_t)g * 65536, scr, r & 31, lane); continue; } r -= I_POOL;
        if (r < I_WIN) { if (!pb) continue; transpose_item<true>(a.in[11], 1024, 2120, (bf16_t*)(ws + WS_WIN), scr, r, lane, a.in[6] + D); continue; } r -= I_WIN;
        if (r < I_WO) { if (!pb) continue; transpose_item<false>(a.in[12], 1024, 1024, (bf16_t*)(ws + WS_WO), scr, r, lane); continue; } r -= I_WO;
        if (r < 2 * I_UP) { const int l = r / I_UP; if (!(l ? pb : pc)) continue; transpose_item<false>(a.in[13] + (size_t)l * 4194304, 1024, 4096, (bf16_t*)(ws + (l ? WS_WUP1 : WS_WUP0)), scr, r % I_UP, lane, a.in[7] + (size_t)l * D); continue; } r -= 2 * I_UP;
        { const int l = r / I_DN; if (!(l ? pb : pc)) continue; transpose_item<false>(a.in[14] + (size_t)l * 4194304, 4096, 1024, (bf16_t*)(ws + (l ? WS_WDN1 : WS_WDN0)), scr, r % I_DN, lane); }
    }
    if (!pb) return;
    const int gt = vb * 512 + tid, NGT = G * 512;
    { u32x4* z = (u32x4*)((bf16_t*)(ws + WS_WIN) + (size_t)2120 * 1024); const int n16 = (NWIN - 2120) * 1024 * 2 / 16;
      for (int i = gt; i < n16; i += NGT) z[i] = (u32x4){0u, 0u, 0u, 0u}; }
    { float* rt = (float*)(ws + WS_ROPE);
      for (int i = gt; i < LS * 32; i += NGT) {
          const int pos = i >> 5, f = i & 31;
          double inv = 1.0; for (int k = 0; k < f; ++k) inv *= 0.7498942093324559;
          double rev = (double)pos * inv * 0.15915494309189535; rev -= __builtin_rint(rev);
          const float fr = (float)rev;
          rt[2 * i] = __builtin_amdgcn_cosf(fr); rt[2 * i + 1] = __builtin_amdgcn_sinf(fr);
      } }
    { const float* src = a.in[5]; bf16_t* dst = (bf16_t*)(ws + WS_KIS);
      for (int i = gt; i < 16 * 2048 * 8; i += NGT) {
          const int b = i >> 14, s = (i >> 3) & 2047, d8 = i & 7;
          const float* rowp = src + (size_t)(i >> 3) * 64;
          const f32x4 v0 = *(const f32x4*)(rowp + 4 * d8), v1 = *(const f32x4*)(rowp + 32 + 4 * d8);
          u32x4 o = {pk2(v0.x, v0.y), pk2(v0.z, v0.w), pk2(v1.x, v1.y), pk2(v1.z, v1.w)};
          *(u32x4*)(dst + ((size_t)b * LS + s) * 64 + d8 * 8) = o;
      } }
    { const float* src = a.in[3]; bf16_t* dst = (bf16_t*)(ws + WS_KS);
      for (int i = gt; i < 16 * 2048 * 4 * 8; i += NGT) {
          const int d8 = i & 7, g = (i >> 3) & 3, s = (i >> 5) & 2047, b = i >> 16;
          const float* rowp = src + (size_t)(i >> 3) * 64;
          const f32x4 v0 = *(const f32x4*)(rowp + 4 * d8), v1 = *(const f32x4*)(rowp + 32 + 4 * d8);
          u32x4 o = {pk2(v0.x, v0.y), pk2(v0.z, v0.w), pk2(v1.x, v1.y), pk2(v1.z, v1.w)};
          *(u32x4*)(dst + (((size_t)b * 4 + g) * LS + s) * 64 + d8 * 8) = o;
      } }
    { const float* src = a.in[4]; bf16_t* dst = (bf16_t*)(ws + WS_VTS);
      for (int i = gt; i < 16 * 4 * 256 * 64; i += NGT) {
          const int d = i & 63, s8 = (i >> 6) & 255, g = (i >> 14) & 3, b = i >> 16;
          const float* p = src + (((size_t)b * 2048 + s8 * 8) * 4 + g) * 64 + d;
          float v[8];
#pragma unroll
          for (int j = 0; j < 8; ++j) v[j] = p[(size_t)j * 256];
          u32x4 o = {pk2(v[0], v[1]), pk2(v[2], v[3]), pk2(v[4], v[5]), pk2(v[6], v[7])};
          *(u32x4*)(dst + (((size_t)b * 4 + g) * 64 + d) * LS + s8 * 8) = o;
      } }
}

DI void phase1(const Args& a, LAS unsigned char* lds) {
    const int tid = threadIdx.x, wave = tid >> 6, lane = tid & 63, G = gridDim.x;
    LAS bf16_t* H = (LAS bf16_t*)lds;
    const float* gmix = a.in[6];
    bf16_t* Dout = (bf16_t*)(a.ws + WS_HA);
    f32x4 gq[4];
#pragma unroll
    for (int j = 0; j < 4; ++j) gq[j] = *(const f32x4*)(gmix + 4 * lane + 256 * j);
    const int c2 = 2 * tid;
    const int win = 2 << (tid >> 7);
    for (int it = blockIdx.x; it < 2080; it += G) {
        const bool smp = it >= 2048;
        int b, t0, T; const float* xs; size_t rowbase;
        if (smp) { b = (it - 2048) >> 1; t0 = ((it - 2048) & 1) * 32; T = TS; xs = a.in[1] + (size_t)b * TS * D; rowbase = (size_t)NP + b * TS; }
        else { b = it >> 6; t0 = (it & 63) * 32; T = TP; xs = a.in[0] + (size_t)b * TP * D; rowbase = (size_t)b * TP; }
        const float* past = a.in[2] + (size_t)b * 15 * D;
        __syncthreads();
        f32x4 v[6][4];
#pragma unroll
        for (int q = 0; q < 6; ++q) {
            const int i = wave + 8 * q, t = t0 + i - 15;
            if (i < 47) {
                const float* src = (t >= 0) ? xs + (size_t)t * D : (smp ? past + (size_t)(15 + t) * D : xs);
#pragma unroll
                for (int j = 0; j < 4; ++j) v[q][j] = *(const f32x4*)(src + 4 * lane + 256 * j);
            }
        }
#pragma unroll
        for (int q = 0; q < 6; ++q) {
            const int i = wave + 8 * q, t = t0 + i - 15;
            if (i < 47) {
                float sm = 0.f;
#pragma unroll
                for (int j = 0; j < 4; ++j) sm += (v[q][j].x * v[q][j].x + v[q][j].y * v[q][j].y) + (v[q][j].z * v[q][j].z + v[q][j].w * v[q][j].w);
#pragma unroll
                for (int o = 1; o < 64; o <<= 1) sm += __shfl_xor(sm, o);
                const float rstd = __builtin_amdgcn_rsqf(sm * (1.0f / 1024.0f) + EPS);
#pragma unroll
                for (int j = 0; j < 4; ++j) {
                    f32x4 h;
                    if (t >= 0) h = v[q][j] * rstd * gq[j];
                    else if (smp) h = v[q][j];
                    else h = (f32x4){0.f, 0.f, 0.f, 0.f};
                    u32x2 o = {pk2(h.x, h.y), pk2(h.z, h.w)};
                    *(LAS u32x2*)(H + i * 1024 + 4 * lane + 256 * j) = o;
                }
            }
        }
        __syncthreads();
        auto hrow = [&](int r) -> f32x2 {
            const unsigned w = *(const LAS unsigned*)(H + (r + 15) * 1024 + c2);
            return (f32x2){__uint_as_float(w << 16), __uint_as_float(w & 0xffff0000u)};
        };
        f32x2 S = {0.f, 0.f};
        for (int j = 1; j < win; ++j) S = S + hrow(-j);
        float* pout = a.out + (smp ? O_POOLS : O_POOLP) + (size_t)b * 15 * D + c2;
#pragma unroll 8
        for (int r = 0; r < 32; ++r) {
            const f32x2 hv = hrow(r);
            S = S + hv;
            const int t = t0 + r;
            const int cnt = smp ? win : (t + 1 < win ? t + 1 : win);
            const float inv = 1.0f / (float)cnt;
            const f32x2 dv = S * inv - hv;
            *(unsigned*)(Dout + (rowbase + t) * D + c2) = pk2(dv.x, dv.y);
            if (t >= T - 15) *(f32x2*)(pout + (size_t)(t - (T - 15)) * D) = hv;
            S = S - hrow(r - win + 1);
        }
    }
}

DI unsigned fkey(float s) { s = s + 0.0f; const unsigned u = __float_as_uint(s); return (u & 0x80000000u) ? ~u : (u | 0x80000000u); }
DI unsigned row16_sum(unsigned v) {
    v += (unsigned)__builtin_amdgcn_update_dpp(0, (int)v, 0xB1, 0xf, 0xf, false);
    v += (unsigned)__builtin_amdgcn_update_dpp(0, (int)v, 0x4E, 0xf, 0xf, false);
    v += (unsigned)__builtin_amdgcn_update_dpp(0, (int)v, 0x124, 0xf, 0xf, false);
    v += (unsigned)__builtin_amdgcn_update_dpp(0, (int)v, 0x128, 0xf, 0xf, false);
    return v;
}
DI unsigned row16_max(unsigned v) {
    v = max(v, (unsigned)__builtin_amdgcn_update_dpp(0, (int)v, 0xB1, 0xf, 0xf, false));
    v = max(v, (unsigned)__builtin_amdgcn_update_dpp(0, (int)v, 0x4E, 0xf, 0xf, false));
    v = max(v, (unsigned)__builtin_amdgcn_update_dpp(0, (int)v, 0x124, 0xf, 0xf, false));
    v = max(v, (unsigned)__builtin_amdgcn_update_dpp(0, (int)v, 0x128, 0xf, 0xf, false));
    return v;
}
DI float unkey(unsigned k) { return __uint_as_float((k & 0x80000000u) ? (k & 0x7fffffffu) : ~k); }
DI unsigned count_ge(const unsigned (&kk)[66], unsigned c) {
    unsigned cnt = 0u;
#pragma unroll
    for (int t = 0; t < 66; ++t) asm volatile("v_cmp_ge_u32 vcc, %1, %2\n\tv_addc_co_u32 %0, vcc, 0, %0, vcc" : "+v"(cnt) : "v"(kk[t]), "v"(c) : "vcc");
    return cnt;
}
DI void select_write(const unsigned (&kk)[66], int nk, int hf, int j32, unsigned* mr) {
    unsigned mxk = 0u, mnk = 0xffffffffu;
#pragma unroll
    for (int t = 0; t < 66; ++t) { mxk = max(mxk, kk[t]); mnk = min(mnk, kk[t] - 1u); }
    mxk = row16_max(mxk); mnk = ~row16_max(~mnk);
    { const unsigned m0 = max((unsigned)__builtin_amdgcn_readlane((int)mxk, 0), (unsigned)__builtin_amdgcn_readlane((int)mxk, 16));
      const unsigned m1 = max((unsigned)__builtin_amdgcn_readlane((int)mxk, 32), (unsigned)__builtin_amdgcn_readlane((int)mxk, 48));
      mxk = hf ? m1 : m0;
      const unsigned n0 = min((unsigned)__builtin_amdgcn_readlane((int)mnk, 0), (unsigned)__builtin_amdgcn_readlane((int)mnk, 16));
      const unsigned n1 = min((unsigned)__builtin_amdgcn_readlane((int)mnk, 32), (unsigned)__builtin_amdgcn_readlane((int)mnk, 48));
      mnk = (hf ? n1 : n0) + 1u; }
    unsigned lo = mnk, hi = mxk + 1u;
    unsigned tau = 0u, thr = 0u; bool done = false;
    for (int it = 0; it < 80; ++it) {
        const unsigned span = hi - lo;
        unsigned c = (it < 16) ? fkey(0.5f * unkey(lo) + 0.5f * unkey(hi - 1u)) : lo + (span >> 1);
        c = max(c, lo + 1u); c = min(c, hi - 1u);
        if (done || span < 2u) c = lo;
        unsigned cnt = row16_sum(count_ge(kk, c));
        const unsigned nlo = (unsigned)__builtin_amdgcn_readlane((int)cnt, 0) + (unsigned)__builtin_amdgcn_readlane((int)cnt, 16);
        const unsigned nhi = (unsigned)__builtin_amdgcn_readlane((int)cnt, 32) + (unsigned)__builtin_amdgcn_readlane((int)cnt, 48);
        const unsigned n = hf ? nhi : nlo;
        if (!done) {
            if (span < 2u) { done = true; tau = lo; thr = 0u; }
            else if (n == 256u) { done = true; thr = c; tau = c; }
            else if (n > 256u) lo = c;
            else hi = c;
        }
        if (__ballot(!done) == 0ull) break;
    }
    done = thr != 0u;
    unsigned w[3] = {0u, 0u, 0u};
    if (__ballot(!done) == 0ull) {
#pragma unroll
        for (int t = 0; t < 66; ++t) {
            const unsigned long long bs = __ballot(kk[t] >= thr);
            const unsigned sw = hf ? (unsigned)(bs >> 32) : (unsigned)bs;
            if (j32 == (t & 31)) w[t >> 5] = sw;
        }
    } else {
        unsigned glo = 0u, ghi = 0u;
#pragma unroll
        for (int t = 0; t < 66; ++t) { const unsigned long long b = __ballot(kk[t] > tau); glo += __popc((unsigned)b); ghi += __popc((unsigned)(b >> 32)); }
        const unsigned r0 = 256u - (hf ? ghi : glo);
        unsigned tk = 0u;
        const unsigned below_mask = (1u << j32) - 1u;
#pragma unroll
        for (int t = 0; t < 66; ++t) {
            if (t < nk) {
                const bool eq = kk[t] == tau;
                const unsigned long long be = __ballot(eq);
                const unsigned e = hf ? (unsigned)(be >> 32) : (unsigned)be;
                const bool take = eq && (tk + __popc(e & below_mask) < r0);
                tk += __popc(e);
                const unsigned long long bs = __ballot((kk[t] > tau) || take);
                const unsigned sw = hf ? (unsigned)(bs >> 32) : (unsigned)bs;
                if (j32 == (t & 31)) w[t >> 5] = sw;
            }
        }
    }
    mr[j32] = w[0]; mr[32 + j32] = w[1];
    if (j32 < 2) mr[64 + j32] = w[2];
}
DI void phase_index(const Args& a, LAS unsigned char* lds) {
    const int tid = threadIdx.x, wave = __builtin_amdgcn_readfirstlane(tid >> 6), lane = tid & 63, hf = lane >> 5, j32 = lane & 31, G = gridDim.x;
    const bf16_t* QI = (const bf16_t*)(a.ws + WS_QI); const float* WI = (const float*)(a.ws + WS_WI);
    unsigned* MASK = (unsigned*)(a.ws + WS_MASK);
    LAS unsigned* lk = (LAS unsigned*)(lds + wave * 16896) + lane;
    constexpr int NIT = 32 + 2048;
    for (int base = 0, rnd = 0; base < NIT; base += G, ++rnd) {
        const int idx = (rnd & 1) ? (G - 1 - (int)blockIdx.x) : (int)blockIdx.x;
        const int pos = base + idx;
        if (pos >= NIT) continue;
        int nkt, rowbase; const bf16_t* KI;
        if (pos < 32) { const int b = pos >> 1; nkt = 66; rowbase = NP + b * 64 + (pos & 1) * 32; KI = (const bf16_t*)(a.ws + WS_KIS) + (size_t)b * LS * 64; }
        else { const int p = pos - 32, c = 31 - (p >> 6), b = (p & 63) >> 1; nkt = 2 * (c + 1); rowbase = b * 2048 + c * 64 + (p & 1) * 32; KI = (const bf16_t*)(a.ws + WS_KIP) + (size_t)b * 2048 * 64; }
        const int row0 = rowbase + wave * 4;
        unsigned* mr0 = MASK + (size_t)(row0 + hf) * MASKW; unsigned* mr1 = MASK + (size_t)(row0 + 2 + hf) * MASKW;
        if (nkt <= 8) {
            const unsigned w = (j32 < nkt) ? 0xffffffffu : 0u;
            mr0[j32] = w; mr0[32 + j32] = 0u; mr1[j32] = w; mr1[32 + j32] = 0u;
            if (j32 < 2) { mr0[64 + j32] = 0u; mr1[64 + j32] = 0u; }
            continue;
        }
        int nk = nkt; asm volatile("" : "+s"(nk));
        const int qq = 2 * (j32 >> 4) + ((j32 >> 2) & 1), hh = 4 * ((j32 >> 3) & 1) + (j32 & 3);
        bf16x8 aq[4];
        { const bf16_t* p = QI + (size_t)(row0 + qq) * 512 + hh * 64 + 8 * hf;
#pragma unroll
          for (int jj = 0; jj < 4; ++jj) aq[jj] = *(const bf16x8*)(p + 16 * jj); }
        float wv0[8], wv1[8];
        { const float* p0 = WI + (size_t)(row0 + hf) * 8; const float* p1 = WI + (size_t)(row0 + 2 + hf) * 8;
          const f32x4 x0 = *(const f32x4*)p0, x1 = *(const f32x4*)(p0 + 4), y0 = *(const f32x4*)p1, y1 = *(const f32x4*)(p1 + 4);
          wv0[0] = x0.x; wv0[1] = x0.y; wv0[2] = x0.z; wv0[3] = x0.w; wv0[4] = x1.x; wv0[5] = x1.y; wv0[6] = x1.z; wv0[7] = x1.w;
          wv1[0] = y0.x; wv1[1] = y0.y; wv1[2] = y0.z; wv1[3] = y0.w; wv1[4] = y1.x; wv1[5] = y1.y; wv1[6] = y1.z; wv1[7] = y1.w; }
        const char* kbase = (const char*)KI;
        const unsigned koff = (unsigned)(j32 * 64 + 8 * hf) * 2u;
        unsigned kk[66];
#pragma unroll
        for (int g = 0; g < 17; ++g) {
#pragma unroll
            for (int u = 0; u < 4; ++u) if (4 * g + u < 66) kk[4 * g + u] = 0u;
            if (4 * g < nk) {
                bf16x8 bt[4][4];
#pragma unroll
                for (int u = 0; u < 4; ++u) { const int tt = (4 * g + u < nk) ? 4 * g + u : nk - 1; const char* p = kbase + (size_t)tt * 4096 + koff;
#pragma unroll
                    for (int jj = 0; jj < 4; ++jj) bt[u][jj] = *(const bf16x8*)(p + 32 * jj); }
#pragma unroll
                for (int u = 0; u < 4; ++u) {
                    const int t = 4 * g + u;
                    if (t < 66) {
                        f32x16 acc;
#pragma unroll
                        for (int i = 0; i < 16; ++i) acc[i] = 0.f;
#pragma unroll
                        for (int jj = 0; jj < 4; ++jj) acc = __builtin_amdgcn_mfma_f32_32x32x16_bf16(aq[jj], bt[u][jj], acc, 0, 0, 0);
                        float s0 = 0.f, s1 = 0.f;
#pragma unroll
                        for (int i = 0; i < 8; ++i) {
                            s0 = __builtin_fmaf(__int_as_float(max(__float_as_int(acc[i]), 0)), wv0[i], s0);
                            s1 = __builtin_fmaf(__int_as_float(max(__float_as_int(acc[8 + i]), 0)), wv1[i], s1);
                        }
                        const bool live = t < nk;
                        kk[t] = live ? fkey(s0) : 0u;
                        lk[t * 64] = live ? fkey(s1) : 0u;
                    }
                }
            } else {
#pragma unroll
                for (int u = 0; u < 4; ++u) if (4 * g + u < 66) lk[(4 * g + u) * 64] = 0u;
            }
            __builtin_amdgcn_sched_barrier(0);
        }
        select_write(kk, nk, hf, j32, mr0);
#pragma unroll
        for (int t = 0; t < 66; ++t) kk[t] = lk[t * 64];
        select_write(kk, nk, hf, j32, mr1);
    }
}

DI void phase_attn(const Args& a, LAS unsigned char* lds) {
    const int tid = threadIdx.x, wave = __builtin_amdgcn_readfirstlane(tid >> 6), lane = tid & 63, hf = lane >> 5, j32 = lane & 31, G = gridDim.x;
    const bf16_t* Q = (const bf16_t*)(a.ws + WS_Q);
    const unsigned* MASK = (const unsigned*)(a.ws + WS_MASK);
    bf16_t* O = (bf16_t*)(a.ws + WS_HA);
    constexpr int NIT = 64 + 4096;
    constexpr float LOG2E = 1.4426950408889634f;
    constexpr int RS = 144, RSV = 528, KREG = 256 * RS, BUFB = KREG + 64 * RSV;
    const int th = wave >> 2, hd = wave & 3;
    const int pik = (j32 & 0x13) | ((j32 & 8) >> 1) | ((j32 & 4) << 1);
    const bf16x8 ones = {0x3f80, 0x3f80, 0x3f80, 0x3f80, 0x3f80, 0x3f80, 0x3f80, 0x3f80};
    const unsigned kread = (unsigned)(pik * RS + 16 * hf), vread = (unsigned)(KREG + j32 * RSV + 16 * hf);
    for (int base = 0, rnd = 0; base < NIT; base += G, ++rnd) {
        const int idx = (rnd & 1) ? (G - 1 - (int)blockIdx.x) : (int)blockIdx.x;
        const int pos = base + idx;
        if (pos >= NIT) continue;
        int nst, rowbase, L, g; const bf16_t *Kb, *Vt;
        if (pos < 64) { const int b = pos >> 2; g = pos & 3; nst = 33; L = LS; rowbase = NP + b * 64;
            Kb = (const bf16_t*)(a.ws + WS_KS) + ((size_t)b * 4 + g) * LS * 64; Vt = (const bf16_t*)(a.ws + WS_VTS) + ((size_t)b * 4 + g) * 64 * LS; }
        else { const int p = pos - 64, c = 31 - (p >> 7), b = (p & 127) >> 2; g = p & 3; nst = c + 1; L = 2048; rowbase = b * 2048 + c * 64;
            Kb = (const bf16_t*)(a.ws + WS_KP) + ((size_t)b * 4 + g) * 2048 * 64; Vt = (const bf16_t*)(a.ws + WS_VTP) + ((size_t)b * 4 + g) * 64 * 2048; }
        const int nbig = (nst + 3) >> 2;
        const int row = rowbase + th * 32 + j32, head = 4 * g + hd;
        bf16x8 qf[4];
        { const bf16_t* p = Q + (size_t)row * 1024 + head * 64 + 8 * hf;
#pragma unroll
          for (int jj = 0; jj < 4; ++jj) qf[jj] = *(const bf16x8*)(p + 16 * jj); }
        const unsigned* mrow = MASK + (size_t)row * MASKW;
        u32x4 kr[4], vr[4];
        auto stage_load = [&](int bs) __attribute__((always_inline)) {
#pragma unroll
            for (int i = 0; i < 4; ++i) {
                const int cid = tid + 512 * i;
                int kr_row = bs * 256 + (cid >> 3); kr_row = kr_row < L ? kr_row : L - 1;
                kr[i] = *(const u32x4*)(Kb + (size_t)kr_row * 64 + (cid & 7) * 8);
                int vcol = bs * 256 + (cid & 31) * 8; vcol = vcol < L - 8 ? vcol : L - 8;
                vr[i] = *(const u32x4*)(Vt + (size_t)(cid >> 5) * L + vcol);
            }
        };
        auto stage_store = [&](LAS unsigned char* buf) __attribute__((always_inline)) {
#pragma unroll
            for (int i = 0; i < 4; ++i) {
                const int cid = tid + 512 * i;
                *(LAS u32x4*)(buf + (cid >> 3) * RS + (cid & 7) * 16) = kr[i];
                *(LAS u32x4*)(buf + KREG + (cid >> 5) * RSV + (cid & 31) * 16) = vr[i];
            }
        };
        stage_load(0);
        f32x16 o0, o1, lacc;
#pragma unroll
        for (int i = 0; i < 16; ++i) { o0[i] = 0.f; o1[i] = 0.f; lacc[i] = 0.f; }
        float mrun = -1e30f;
        u32x4 mwa = *(const u32x4*)mrow, mwb = *(const u32x4*)(mrow + 4);
        __syncthreads();
        stage_store(lds);
        __syncthreads();
        for (int bs = 0; bs < nbig; ++bs) {
            LAS unsigned char* cur = lds + (bs & 1) * BUFB;
            const bool more = bs + 1 < nbig;
            if (more) stage_load(bs + 1);
            const unsigned mw8[8] = {mwa.x, mwa.y, mwa.z, mwa.w, mwb.x, mwb.y, mwb.z, mwb.w};
            if (more) { mwa = *(const u32x4*)(mrow + 8 * (bs + 1)); mwb = *(const u32x4*)(mrow + 8 * (bs + 1) + 4); }
            const int nv = (nst - 4 * bs) < 4 ? (nst - 4 * bs) : 4;
#pragma unroll
            for (int j = 0; j < 4; ++j) {
                if (j < nv) {
                    f32x16 sc[2];
                    {
                        bf16x8 kf[2][4];
#pragma unroll
                        for (int tt = 0; tt < 2; ++tt)
#pragma unroll
                            for (int jj = 0; jj < 4; ++jj) kf[tt][jj] = *(const LAS bf16x8*)(cur + kread + (j * 64 + tt * 32) * RS + 32 * jj);
#pragma unroll
                        for (int tt = 0; tt < 2; ++tt)
#pragma unroll
                            for (int i = 0; i < 16; ++i) sc[tt][i] = 0.f;
                        __builtin_amdgcn_s_setprio(1);
#pragma unroll
                        for (int jj = 0; jj < 4; ++jj)
#pragma unroll
                            for (int tt = 0; tt < 2; ++tt) sc[tt] = __builtin_amdgcn_mfma_f32_32x32x16_bf16(kf[tt][jj], qf[jj], sc[tt], 0, 0, 0);
                        __builtin_amdgcn_s_setprio(0);
                    }
                    float mx = __builtin_fmaxf(sc[0][0], sc[1][0]);
#pragma unroll
                    for (int i = 1; i < 16; ++i) mx = __builtin_fmaxf(__builtin_fmaxf(mx, sc[0][i]), sc[1][i]);
                    mx = xhalf_max(mx);
                    if (__ballot(mx > mrun + 8.0f) != 0ull) {
                        const float mnew = fmaxf(mrun, mx);
                        const float alpha = __builtin_amdgcn_exp2f((mrun - mnew) * LOG2E);
                        mrun = mnew;
#pragma unroll
                        for (int i = 0; i < 16; ++i) { o0[i] *= alpha; o1[i] *= alpha; lacc[i] *= alpha; }
                    }
                    const float nm = -mrun * LOG2E;
#pragma unroll
                    for (int tt = 0; tt < 2; ++tt) {
                        const unsigned mw = mw8[2 * j + tt] >> (8 * hf);
                        float p[16];
#pragma unroll
                        for (int i = 0; i < 16; ++i) {
                            const float e = __builtin_amdgcn_exp2f(__builtin_fmaf(sc[tt][i], LOG2E, nm));
                            const unsigned msk = (unsigned)__builtin_amdgcn_sbfe((int)mw, (i & 7) + 16 * (i >> 3), 1);
                            p[i] = __uint_as_float(__float_as_uint(e) & msk);
                        }
#pragma unroll
                        for (int s2 = 0; s2 < 2; ++s2) {
                            u32x4 pw = {pk2(p[8 * s2], p[8 * s2 + 1]), pk2(p[8 * s2 + 2], p[8 * s2 + 3]), pk2(p[8 * s2 + 4], p[8 * s2 + 5]), pk2(p[8 * s2 + 6], p[8 * s2 + 7])};
                            const bf16x8 pf = __builtin_bit_cast(bf16x8, pw);
                            const bf16x8 v0 = *(const LAS bf16x8*)(cur + vread + (j * 64 + tt * 32 + 16 * s2) * 2);
                            const bf16x8 v1 = *(const LAS bf16x8*)(cur + vread + 32 * RSV + (j * 64 + tt * 32 + 16 * s2) * 2);
                            o0 = __builtin_amdgcn_mfma_f32_32x32x16_bf16(v0, pf, o0, 0, 0, 0);
                            o1 = __builtin_amdgcn_mfma_f32_32x32x16_bf16(v1, pf, o1, 0, 0, 0);
                            lacc = __builtin_amdgcn_mfma_f32_32x32x16_bf16(ones, pf, lacc, 0, 0, 0);
                        }
                    }
                }
            }
            if (more) stage_store(lds + ((bs & 1) ^ 1) * BUFB);
            __syncthreads();
        }
        const float inv = 1.0f / lacc[0];
        bf16_t* op = O + (size_t)row * 1024 + head * 64 + 4 * hf;
#pragma unroll
        for (int q = 0; q < 4; ++q) {
            u32x2 x0 = {pk2(o0[4 * q] * inv, o0[4 * q + 1] * inv), pk2(o0[4 * q + 2] * inv, o0[4 * q + 3] * inv)};
            u32x2 x1 = {pk2(o1[4 * q] * inv, o1[4 * q + 1] * inv), pk2(o1[4 * q + 2] * inv, o1[4 * q + 3] * inv)};
            *(u32x2*)(op + 8 * q) = x0; *(u32x2*)(op + 32 + 8 * q) = x1;
        }
    }
}

DI void phase_final(const Args& a) {
    const int tid = threadIdx.x, wave = tid >> 6, lane = tid & 63, G = gridDim.x;
    const float* ss = (const float*)(a.ws + WS_SS1);
    const bf16_t* Xb = (const bf16_t*)(a.ws + WS_HB);
    const float* gf = a.in[8];
    f32x4 g0[2], g1[2];
#pragma unroll
    for (int j = 0; j < 2; ++j) { g0[j] = *(const f32x4*)(gf + (lane + 64 * j) * 8); g1[j] = *(const f32x4*)(gf + (lane + 64 * j) * 8 + 4); }
    for (int row = blockIdx.x * 8 + wave; row < NR; row += G * 8) {
        float s = ss[(size_t)row * 16 + (lane & 15)];
        s += __shfl_xor(s, 1); s += __shfl_xor(s, 2); s += __shfl_xor(s, 4); s += __shfl_xor(s, 8);
        const float rstd = __builtin_amdgcn_rsqf(s * (1.0f / 1024.0f) + EPS);
        const u32x4* hr = (const u32x4*)(Xb + (size_t)row * D) + lane;
        f32x4* yr = (f32x4*)(a.out + (size_t)row * D) + 2 * lane;
#pragma unroll
        for (int j = 0; j < 2; ++j) {
            const u32x4 h = hr[64 * j];
            f32x4 y0 = {__uint_as_float(h.x << 16), __uint_as_float(h.x & 0xffff0000u), __uint_as_float(h.y << 16), __uint_as_float(h.y & 0xffff0000u)};
            f32x4 y1 = {__uint_as_float(h.z << 16), __uint_as_float(h.z & 0xffff0000u), __uint_as_float(h.w << 16), __uint_as_float(h.w & 0xffff0000u)};
            yr[128 * j] = y0 * rstd * g0[j]; yr[128 * j + 1] = y1 * rstd * g1[j];
        }
    }
}

#define XB_TMO      128
#define XB_XCNT(j)  (256  + 64 * (j))
#define XB_XSUB(j)  (1280 + 64 * (j))
#define XB_XGEN(j)  (2304 + 64 * (j))
#define XB_TOP      3328
#define XB_TOPGEN   3392
#define XCD_BAR_WORDS 3456
#define XB_SPIN_CAP (1u << 20)
DI unsigned xb_ld(unsigned* p)              { return __hip_atomic_load(p, __ATOMIC_RELAXED, __HIP_MEMORY_SCOPE_AGENT); }
DI unsigned xb_add(unsigned* p, unsigned v) { return __hip_atomic_fetch_add(p, v, __ATOMIC_RELAXED, __HIP_MEMORY_SCOPE_AGENT); }
DI unsigned xb_xcc_id() { return (unsigned)__builtin_amdgcn_s_getreg((3 << 11) | 20) & 0xFu; }
#define XB_SPIN(cond, bar) do { unsigned _sp = 0; while (cond) { \
    if ((++_sp & 255u) == 0u) { if (xb_ld(&(bar)[XB_TMO])) break; if (_sp > XB_SPIN_CAP) { atomicAdd(&(bar)[XB_TMO], 1u); break; } } } } while (0)
struct XcdBarrier { unsigned* bar; unsigned x; volatile LAS unsigned* st; };
DI XcdBarrier xcd_barrier_post(unsigned* bar, volatile LAS unsigned* st) {
    XcdBarrier b; b.bar = bar; b.x = xb_xcc_id(); b.st = st;
    if (threadIdx.x == 0) (void)xb_add(&bar[XB_XCNT(b.x)], 1u);
    return b;
}
DI void xcd_barrier_complete(unsigned* bar, unsigned x, unsigned& nloc, unsigned& nx) {
    const unsigned G = gridDim.x * gridDim.y * gridDim.z;
    unsigned sum, cnt, mine, sp = 0u;
    for (;;) {
        sum = 0u; cnt = 0u; mine = 0u;
#pragma unroll
        for (unsigned j = 0; j < 16; ++j) { const unsigned c = xb_ld(&bar[XB_XCNT(j)]); sum += c; cnt += (c > 0u) ? 1u : 0u; mine = (j == x) ? c : mine; }
        if (sum == G) break;
        __builtin_amdgcn_s_sleep(1);
        if ((++sp & 255u) == 0u) { if (xb_ld(&bar[XB_TMO])) break; if (sp > XB_SPIN_CAP) { atomicAdd(&bar[XB_TMO], 1u); break; } }
    }
    nloc = mine > 0u ? mine : 1u; nx = cnt > 0u ? cnt : 1u;
}
DI void xcd_barrier(const XcdBarrier& b) {
    asm volatile("s_waitcnt vmcnt(0)" ::: "memory");
    __syncthreads();
    if (threadIdx.x == 0) {
        unsigned* bar = b.bar;
        __builtin_amdgcn_s_waitcnt(0);
        unsigned nloc = b.st[0], nx = b.st[1];
        if (nloc == 0u) { xcd_barrier_complete(bar, b.x, nloc, nx); b.st[0] = nloc; b.st[1] = nx; }
        const unsigned old = xb_add(&bar[XB_XSUB(b.x)], 1u);
        const unsigned gen = old / nloc;
        if (old + 1u == (gen + 1u) * nloc) {
            __builtin_amdgcn_fence(__ATOMIC_RELEASE, "agent");
            asm volatile("s_waitcnt vmcnt(0)" ::: "memory");
            const unsigned og = xb_add(&bar[XB_TOP], 1u);
            const unsigned tg = og / nx;
            if (og + 1u == (tg + 1u) * nx) xb_add(&bar[XB_TOPGEN], 1u);
            else XB_SPIN(xb_ld(&bar[XB_TOPGEN]) == tg, bar);
            __builtin_amdgcn_fence(__ATOMIC_ACQUIRE, "agent");
            xb_add(&bar[XB_XGEN(b.x)], 1u);
            asm volatile("s_waitcnt vmcnt(0)" ::: "memory");
        } else {
            XB_SPIN(xb_ld(&bar[XB_XGEN(b.x)]) == gen, bar);
            __builtin_amdgcn_fence(__ATOMIC_ACQUIRE, "agent");
            asm volatile("s_waitcnt vmcnt(0)" ::: "memory");
        }
    }
    __syncthreads();
}

__global__ void __launch_bounds__(512, 2) fwd_kernel(Args a) {
    extern __shared__ __attribute__((aligned(16))) unsigned char lds_raw[];
    LAS unsigned char* lds = (LAS unsigned char*)lds_raw;
    cg::grid_group grid = cg::this_grid();
    volatile LAS unsigned* xst = (volatile LAS unsigned*)(lds + LDS_PHASE);
    if (threadIdx.x == 0) { xst[0] = 0u; xst[1] = 0u; }
    __syncthreads();
    const XcdBarrier xb = xcd_barrier_post((unsigned*)(a.ws + WS_BAR), xst);
    unsigned char* ws = a.ws;
    const int G = gridDim.x;
    pg8::StaticOrder S;
    float* ss0 = (float*)(ws + WS_SS0); float* ss1 = (float*)(ws + WS_SS1);
    bf16_t* HA = (bf16_t*)(ws + WS_HA); bf16_t* Xb = (bf16_t*)(ws + WS_HB); bf16_t* U = (bf16_t*)(ws + WS_U);
#ifndef PHMASK
#define PHMASK 0xfff
#endif
#ifndef PROBE_REP
#define PROBE_REP 0x0
#endif
#define PHASE(k) if (((PHMASK >> (k)) & 1) && (k) >= a.ph_lo && (k) < a.ph_hi)
#define SEAM(k) do { if ((k) >= a.ph_lo && (k) + 1 < a.ph_hi) xcd_barrier(xb); } while (0)
    const bool defer0 = (G == 256);
    PHASE(0) { phase0(a, lds, defer0 ? 1 : 7, blockIdx.x, G); phase1(a, lds); }
#if PROBE_REP & 0x1
    grid.sync(); phase0(a, lds, 7, blockIdx.x, G); phase1(a, lds);
#endif
    SEAM(0);
    PHASE(1) {
        pg8::Gemm g{HA, (const bf16_t*)(ws + WS_WPOOL), NR, 1024, 256, 1024, 256, 512};
        S.init(NR, 1024, G, blockIdx.x);
        EpiRes<true, true> E{a.in[0], a.in[1], Xb, a.in[10], ss0};
        pg8::gemm_phase(lds, g, S, E);
        if (defer0 && blockIdx.x >= 16) phase0(a, lds, 4, blockIdx.x - 16, 240);
    }
    SEAM(1);
    PHASE(2) {
        pg8::Gemm g{Xb, (const bf16_t*)(ws + WS_WUP0), NR, DFF, 1024, 1024, 1024, 0};
        S.init(NR, DFF, G, blockIdx.x);
        EpiUp E{ss0, U};
        pg8::gemm_phase(lds, g, S, E);
    }
    SEAM(2);
    PHASE(3) {
        pg8::Gemm g{U, (const bf16_t*)(ws + WS_WDN0), NR, 1024, DFF, DFF, DFF, 0};
        S.init(NR, 1024, G, blockIdx.x);
        EpiRes<false, false> E{nullptr, nullptr, Xb, nullptr, ss1};
        pg8::gemm_phase(lds, g, S, E);
        if (defer0 && blockIdx.x >= 16) phase0(a, lds, 2, blockIdx.x - 16, 240);
    }
    SEAM(3);
    PHASE(4) {
        pg8::Gemm g{Xb, (const bf16_t*)(ws + WS_WIN), NR, NWIN, 1024, 1024, 1024, 0};
        S.init(NR, NWIN, G, blockIdx.x);
        EpiWin E{ss1, (const float*)(ws + WS_ROPE), (bf16_t*)(ws + WS_Q), (bf16_t*)(ws + WS_QI), (bf16_t*)(ws + WS_KP), (bf16_t*)(ws + WS_VTP), (bf16_t*)(ws + WS_KIP),
                 (bf16_t*)(ws + WS_KS), (bf16_t*)(ws + WS_VTS), (bf16_t*)(ws + WS_KIS), (float*)(ws + WS_WI), a.out};
        pg8::gemm_phase(lds, g, S, E);
    }
    SEAM(4);
    PHASE(5) { phase_index(a, lds); }
    SEAM(5);
    PHASE(6) { phase_attn(a, lds); }
    SEAM(6);
    PHASE(7) {
        pg8::Gemm g{HA, (const bf16_t*)(ws + WS_WO), NR, 1024, 1024, 1024, 1024, 0};
        S.init(NR, 1024, G, blockIdx.x);
        EpiRes<false, false> E{nullptr, nullptr, Xb, nullptr, ss0};
        pg8::gemm_phase(lds, g, S, E);
    }
    SEAM(7);
    PHASE(8) {
        pg8::Gemm g{Xb, (const bf16_t*)(ws + WS_WUP1), NR, DFF, 1024, 1024, 1024, 0};
        S.init(NR, DFF, G, blockIdx.x);
        EpiUp E{ss0, U};
        pg8::gemm_phase(lds, g, S, E);
    }
    SEAM(8);
    PHASE(9) {
        pg8::Gemm g{U, (const bf16_t*)(ws + WS_WDN1), NR, 1024, DFF, DFF, DFF, 0};
        S.init(NR, 1024, G, blockIdx.x);
        EpiRes<false, false> E{nullptr, nullptr, Xb, nullptr, ss1};
        pg8::gemm_phase(lds, g, S, E);
    }
    SEAM(9);
    PHASE(10) { phase_final(a); }
    if (a.ph_hi > 1000) grid.sync();
}

#ifndef N_LAUNCHES
#define N_LAUNCHES 1
#endif
extern "C" void kernel_launch(void* const* d_in, const int* in_sizes, int n_in, void* d_out, int out_size, void* d_ws, size_t ws_size, hipStream_t stream) {
    static int grid = 0;
    if (grid == 0) {
        if (n_in != 15 || out_size != 107233280 || ws_size < WS_END) { fprintf(stderr, "kernel_launch: unexpected shapes (n_in %d out %d ws %zu need %zu)\n", n_in, out_size, ws_size, (size_t)WS_END); grid = -1; return; }
        int dev = 0, cus = 0, per_cu = 0;
        hipGetDevice(&dev); hipDeviceGetAttribute(&cus, hipDeviceAttributeMultiprocessorCount, dev);
        if (hipFuncSetAttribute((const void*)fwd_kernel, hipFuncAttributeMaxDynamicSharedMemorySize, LDS_BYTES) != hipSuccess) { fprintf(stderr, "kernel_launch: hipFuncSetAttribute failed\n"); grid = -1; return; }
        hipOccupancyMaxActiveBlocksPerMultiprocessor(&per_cu, (const void*)fwd_kernel, 512, LDS_BYTES);
        if (per_cu < 1) { fprintf(stderr, "kernel_launch: occupancy query says %d\n", per_cu); per_cu = 1; }
        (void)hipGetLastError();
        grid = cus;
    }
    if (grid < 0) return;
    if (hipMemsetAsync((char*)d_ws + WS_BAR, 0, XCD_BAR_WORDS * 4, stream) != hipSuccess) { fprintf(stderr, "kernel_launch: memset of the barrier words failed\n"); return; }
    Args a{};
    for (int i = 0; i < 15; ++i) a.in[i] = (const float*)d_in[i];
    a.out = (float*)d_out; a.ws = (unsigned char*)d_ws;
#if N_LAUNCHES == 1
    a.ph_lo = 0; a.ph_hi = 11;
    void* args[] = {&a};
    hipError_t e = hipLaunchCooperativeKernel((const void*)fwd_kernel, dim3(grid), dim3(512), args, LDS_BYTES, stream);
    if (e != hipSuccess) fprintf(stderr, "cooperative launch failed: %s (grid %d)\n", hipGetErrorString(e), grid);
#else
    for (int ph = 0; ph < 11; ++ph) { a.ph_lo = ph; a.ph_hi = ph + 1; hipLaunchKernelGGL(fwd_kernel, dim3(grid), dim3(512), LDS_BYTES, stream, a); }
#endif
}
```
